# Optimizing an MI355X kernel written in HIP

```python
import math
import jax
import jax.numpy as jnp
from jax import lax
import numpy as np

D_MODEL = 2048
BATCH = 4
SEQ = 4096
DEPTH = 1
DEC_BATCH = 8
DEC_SEQ = 32
PAST_LEN = 4096

CHUNK = 64
H_A = 8
DK_A = 128
DV_A = 128
W_A = H_A * DV_A
CONV_W = 4
CONV_CH = 2 * H_A * DK_A + W_A
H_B = 16
N_B = 64
W_B = H_B * N_B
LORA_W = 96
LORA_A = 96
LORA_G = 256
SHIFT_W = 3 * W_B + LORA_W + LORA_A + LORA_G
D_FF = 4 * D_MODEL
D_PLE = 256
N_IN = CONV_CH + 2 * H_A + W_A + SHIFT_W + 2 * D_MODEL
EPS = 1e-6
LNX_EPS = 64e-5

kernel_name = 'hybrid_gdn_rwkv7_streaming_step'

F32 = jnp.float32


def _split(x, sizes):
    idx = [int(s) for s in np.cumsum(sizes)[:-1]]
    return jnp.split(x, idx, axis=-1)


def rmsnorm(x, g, eps=EPS):
    xf = x.astype(F32)
    y = xf * lax.rsqrt(jnp.mean(xf * xf, axis=-1, keepdims=True) + eps)
    return (y * g.astype(F32)).astype(x.dtype)


def l2norm(x):
    xf = x.astype(F32)
    return xf * lax.rsqrt(jnp.sum(xf * xf, axis=-1, keepdims=True) + EPS)


def causal_conv_silu(u, buf, w):
    T = u.shape[1]
    full = jnp.concatenate([buf.astype(u.dtype), u], axis=1)
    out = full[:, 0:T] * w[0]
    for j in range(1, CONV_W):
        out = out + full[:, j:j + T] * w[j]
    return jax.nn.silu(out), full[:, T:]


def token_shift(u, prev):
    shifted = jnp.concatenate([prev[:, None].astype(u.dtype), u[:, :-1]], axis=1)
    return shifted, u[:, -1]


def gated_delta_rule(q, k, v, g, beta, s0):
    B, T, H, _ = q.shape
    c = min(CHUNK, T)
    n = -(-T // c)
    pad = n * c - T

    def blocks(a):
        a = a.astype(F32)
        a = jnp.pad(a, [(0, 0), (0, pad)] + [(0, 0)] * (a.ndim - 2))
        a = a.reshape((B, n, c) + a.shape[2:])
        return jnp.moveaxis(a, 3, 1)

    qb, kb, vb, gb, bb = blocks(q), blocks(k), blocks(v), blocks(g), blocks(beta)
    G = jnp.cumsum(gb, axis=-1)
    idx = jnp.arange(c)
    incl = idx[:, None] >= idx[None, :]
    strict = idx[:, None] > idx[None, :]
    decay = jnp.exp(jnp.where(incl, G[..., :, None] - G[..., None, :], -jnp.inf))
    kbeta = kb * bb[..., None]
    a_mat = jnp.where(strict, jnp.einsum('bhnik,bhnjk->bhnij', kbeta, kb) * decay, 0.0)
    eye = jnp.eye(c, dtype=F32)
    t_inv = lax.linalg.triangular_solve(eye + a_mat, jnp.broadcast_to(eye, a_mat.shape),
                                        left_side=True, lower=True)
    eG = jnp.exp(G)[..., None]
    u = jnp.einsum('bhnij,bhnjd->bhnid', t_inv, vb * bb[..., None])
    w = jnp.einsum('bhnij,bhnjk->bhnik', t_inv, kbeta * eG)
    qk = jnp.where(incl, jnp.einsum('bhnik,bhnjk->bhnij', qb, kb) * decay, 0.0)
    q_dec = qb * eG
    g_last = G[..., -1]
    k_dec = kb * jnp.exp(g_last[..., None] - G)[..., None]

    def step(s, xs):
        u_c, w_c, qk_c, q_c, k_c, gl = xs
        v_new = u_c - jnp.einsum('bhik,bhkd->bhid', w_c, s)
        o = jnp.einsum('bhik,bhkd->bhid', q_c, s) + jnp.einsum('bhij,bhjd->bhid', qk_c, v_new)
        s = s * jnp.exp(gl)[..., None, None] + jnp.einsum('bhik,bhid->bhkd', k_c, v_new)
        return s, o

    xs = tuple(jnp.moveaxis(a, 2, 0) for a in (u, w, qk, q_dec, k_dec, g_last))
    s, o = lax.scan(step, s0.astype(F32), xs)
    o = jnp.transpose(o, (1, 0, 3, 2, 4)).reshape(B, n * c, H, -1)[:, :T]
    return o, s


def rwkv7_recurrence(r, decay, k, v, kk, a, s0):
    def step(s, xs):
        r_t, w_t, k_t, v_t, kk_t, a_t = xs
        sa = jnp.einsum('bhvk,bhk->bhv', s, -kk_t)
        s = (s * w_t[:, :, None, :] + sa[..., None] * (kk_t * a_t)[:, :, None, :]
             + v_t[..., None] * k_t[:, :, None, :])
        return s, jnp.einsum('bhvk,bhk->bhv', s, r_t)

    xs = tuple(jnp.moveaxis(t.astype(F32), 1, 0) for t in (r, decay, k, v, kk, a))
    s, y = lax.scan(step, s0.astype(F32), xs)
    return jnp.moveaxis(y, 0, 1), s


def gdn_branch(conv_in, alpha_logit, beta_logit, gate, buf, s0, conv_w, a_log, dt_bias, norm_g):
    B, T, _ = conv_in.shape
    c_out, new_buf = causal_conv_silu(conv_in, buf, conv_w)
    q, k, v = _split(c_out, [H_A * DK_A, H_A * DK_A, W_A])
    q = l2norm(q.reshape(B, T, H_A, DK_A)) * (DK_A ** -0.5)
    k = l2norm(k.reshape(B, T, H_A, DK_A))
    v = v.reshape(B, T, H_A, DV_A)
    beta = jax.nn.sigmoid(beta_logit.astype(F32))
    g = -jnp.exp(a_log.astype(F32)) * jax.nn.softplus(alpha_logit.astype(F32) + dt_bias.astype(F32))
    o, s = gated_delta_rule(q, k, v, g, beta, s0)
    o = rmsnorm(o, norm_g) * jax.nn.silu(gate.astype(F32)).reshape(B, T, H_A, DV_A)
    return o.reshape(B, T, W_A).astype(conv_in.dtype), s, new_buf


def rwkv_branch(xb, prev, s0, mu, w0, w2, a0, a2, g2, k_k, k_a, r_k, lnx_g, lnx_b):
    B, T, _ = xb.shape
    shifted, last = token_shift(xb, prev)
    xm = xb + (shifted - xb) * mu
    r, k, v, xw, xa, xg = _split(xm, [W_B, W_B, W_B, LORA_W, LORA_A, LORA_G])
    w_log = -jax.nn.softplus(-(w0 + jnp.tanh(xw) @ w2).astype(F32)) - 0.5
    decay = jnp.exp(-jnp.exp(w_log))
    a = jax.nn.sigmoid((a0 + xa @ a2).astype(F32))
    gate = (jax.nn.sigmoid(xg) @ g2).astype(F32)

    def heads(t):
        return t.astype(F32).reshape(B, T, H_B, N_B)

    rh, vh, ah = heads(r), heads(v), heads(a)
    kk = l2norm(heads(k * k_k))
    kh = heads(k.astype(F32) * (1.0 + (a - 1.0) * k_a.astype(F32)))
    y, s = rwkv7_recurrence(rh, heads(decay), kh, vh, kk, ah, s0)
    mean = jnp.mean(y, axis=-1, keepdims=True)
    yc = y - mean
    y = yc * lax.rsqrt(jnp.mean(yc * yc, axis=-1, keepdims=True) + LNX_EPS)
    y = y.reshape(B, T, W_B) * lnx_g.astype(F32) + lnx_b.astype(F32)
    bonus = jnp.sum(rh * kh * r_k.astype(F32), axis=-1, keepdims=True) * vh
    y = (y + bonus.reshape(B, T, W_B)) * gate
    return y.astype(xb.dtype), s, last


def hybrid_layer(x, ple, s_gdn, buf_gdn, s_rwkv, shift_rwkv, lw):
    (g_mix, w_in, conv_w, a_log, dt_bias, gdn_norm_g, mu_shift, w0, w2, a0, a2, g2,
     k_k, k_a, r_k, lnx_g, lnx_b, w_up_a, w_up_b, w_o, g_mlp, w_ff1, w_ff2,
     g_ple, w_ple_gate, w_ple) = lw
    h = rmsnorm(x, g_mix)
    proj = h @ w_in
    conv_in, alpha_logit, beta_logit, gate_a, xb, gate_ma, gate_mb = _split(
        proj, [CONV_CH, H_A, H_A, W_A, SHIFT_W, D_MODEL, D_MODEL])
    o_a, s_gdn, buf_gdn = gdn_branch(conv_in, alpha_logit, beta_logit, gate_a, buf_gdn, s_gdn,
                                     conv_w, a_log, dt_bias, gdn_norm_g)
    o_b, s_rwkv, shift_rwkv = rwkv_branch(xb, shift_rwkv, s_rwkv, mu_shift, w0, w2, a0, a2, g2,
                                          k_k, k_a, r_k, lnx_g, lnx_b)
    merged = jax.nn.sigmoid(gate_ma) * (o_a @ w_up_a) + jax.nn.sigmoid(gate_mb) * (o_b @ w_up_b)
    x = x + merged @ w_o
    h = rmsnorm(x, g_mlp)
    x = x + jnp.square(jax.nn.relu(h @ w_ff1)) @ w_ff2
    x = x + jax.nn.sigmoid(rmsnorm(x, g_ple) @ w_ple_gate) * (ple @ w_ple)
    return x, s_gdn, buf_gdn, s_rwkv, shift_rwkv


def run_group(x, p, s_gdn, buf_gdn, s_rwkv, shift_rwkv, params, g_final):
    out_sg, out_buf, out_sr, out_sh = [], [], [], []
    for i in range(DEPTH):
        lw = tuple(w[i] for w in params)
        x, sg, bf, sr, sh = hybrid_layer(x, p[i], s_gdn[i], buf_gdn[i], s_rwkv[i], shift_rwkv[i], lw)
        out_sg.append(sg.astype(s_gdn.dtype))
        out_buf.append(bf.astype(buf_gdn.dtype))
        out_sr.append(sr.astype(s_rwkv.dtype))
        out_sh.append(sh.astype(shift_rwkv.dtype))
    y = rmsnorm(x, g_final)
    return y, jnp.stack(out_sg), jnp.stack(out_buf), jnp.stack(out_sr), jnp.stack(out_sh)


def setup_inputs(seed: int = 0) -> dict:
    key = jax.random.key(seed)
    ks = jax.random.split(key, 40)
    L = DEPTH

    def nrm(k, shape, scale):
        return jax.random.normal(k, shape, F32) * scale

    dt = jnp.exp(jax.random.uniform(ks[10], (L, H_A), F32, math.log(1e-3), math.log(1e-1)))
    return {
        'x_prompt': nrm(ks[0], (BATCH, SEQ, D_MODEL), 1.0),
        'x_sample': nrm(ks[1], (DEC_BATCH, DEC_SEQ, D_MODEL), 1.0),
        'p_prompt': nrm(ks[2], (DEPTH, BATCH, SEQ, D_PLE), 1.0),
        'p_sample': nrm(ks[3], (DEPTH, DEC_BATCH, DEC_SEQ, D_PLE), 1.0),
        'state_gdn': nrm(ks[4], (L, DEC_BATCH, H_A, DK_A, DV_A), 0.1),
        'cache_gdn_conv': nrm(ks[5], (L, DEC_BATCH, CONV_W - 1, CONV_CH), 1.0),
        'state_rwkv': nrm(ks[6], (L, DEC_BATCH, H_B, N_B, N_B), 0.1),
        'cache_rwkv_shift': nrm(ks[7], (L, DEC_BATCH, SHIFT_W), 1.0),
        'g_mix': 1.0 + nrm(ks[8], (L, D_MODEL), 0.02),
        'w_in': nrm(ks[9], (L, D_MODEL, N_IN), D_MODEL ** -0.5),
        'conv_w': nrm(ks[11], (L, CONV_W, CONV_CH), CONV_W ** -0.5),
        'a_log': jnp.log(jax.random.uniform(ks[12], (L, H_A), F32, 1.0, 16.0)),
        'dt_bias': dt + jnp.log(-jnp.expm1(-dt)),
        'gdn_norm_g': 1.0 + nrm(ks[13], (L, DV_A), 0.02),
        'mu_shift': jax.random.uniform(ks[14], (L, SHIFT_W), F32),
        'w0': jax.random.uniform(ks[15], (L, W_B), F32, -6.0, -1.0),
        'w2': nrm(ks[16], (L, LORA_W, W_B), 0.5 * LORA_W ** -0.5),
        'a0': nrm(ks[17], (L, W_B), 0.1),
        'a2': nrm(ks[18], (L, LORA_A, W_B), 0.5 * LORA_A ** -0.5),
        'g2': nrm(ks[19], (L, LORA_G, W_B), LORA_G ** -0.5),
        'k_k': 0.85 + nrm(ks[20], (L, W_B), 0.02),
        'k_a': 1.0 + nrm(ks[21], (L, W_B), 0.02),
        'r_k': nrm(ks[22], (L, H_B, N_B), 0.1),
        'lnx_g': 1.0 + nrm(ks[23], (L, W_B), 0.02),
        'lnx_b': nrm(ks[24], (L, W_B), 0.02),
        'w_up_a': nrm(ks[25], (L, W_A, D_MODEL), W_A ** -0.5),
        'w_up_b': nrm(ks[26], (L, W_B, D_MODEL), W_B ** -0.5),
        'w_o': nrm(ks[27], (L, D_MODEL, D_MODEL), D_MODEL ** -0.5),
        'g_mlp': 1.0 + nrm(ks[28], (L, D_MODEL), 0.02),
        'w_ff1': nrm(ks[29], (L, D_MODEL, D_FF), D_MODEL ** -0.5),
        'w_ff2': nrm(ks[30], (L, D_FF, D_MODEL), D_FF ** -0.5),
        'g_ple': 1.0 + nrm(ks[31], (L, D_MODEL), 0.02),
        'w_ple_gate': nrm(ks[32], (L, D_MODEL, D_MODEL), D_MODEL ** -0.5),
        'w_ple': nrm(ks[33], (L, D_PLE, D_MODEL), D_PLE ** -0.5),
        'g_final': 1.0 + nrm(ks[34], (D_MODEL,), 0.02),
    }


def reference(x_prompt, x_sample, p_prompt, p_sample, state_gdn, cache_gdn_conv, state_rwkv,
              cache_rwkv_shift, g_mix, w_in, conv_w, a_log, dt_bias, gdn_norm_g, mu_shift, w0, w2,
              a0, a2, g2, k_k, k_a, r_k, lnx_g, lnx_b, w_up_a, w_up_b, w_o, g_mlp, w_ff1, w_ff2,
              g_ple, w_ple_gate, w_ple, g_final):
    params = (g_mix, w_in, conv_w, a_log, dt_bias, gdn_norm_g, mu_shift, w0, w2, a0, a2, g2,
              k_k, k_a, r_k, lnx_g, lnx_b, w_up_a, w_up_b, w_o, g_mlp, w_ff1, w_ff2,
              g_ple, w_ple_gate, w_ple)
    bp = x_prompt.shape[0]
    dt_p = x_prompt.dtype
    z_sg = jnp.zeros((DEPTH, bp, H_A, DK_A, DV_A), dt_p)
    z_buf = jnp.zeros((DEPTH, bp, CONV_W - 1, CONV_CH), dt_p)
    z_sr = jnp.zeros((DEPTH, bp, H_B, N_B, N_B), dt_p)
    z_sh = jnp.zeros((DEPTH, bp, SHIFT_W), dt_p)
    y_prompt, sg_p, buf_p, sr_p, sh_p = run_group(x_prompt, p_prompt, z_sg, z_buf, z_sr, z_sh,
                                                  params, g_final)
    y_sample, sg_s, buf_s, sr_s, sh_s = run_group(x_sample, p_sample, state_gdn, cache_gdn_conv,
                                                  state_rwkv, cache_rwkv_shift, params, g_final)
    return (y_prompt, y_sample, sg_p, buf_p, sr_p, sh_p, sg_s, buf_s, sr_s, sh_s)
```

```cpp
#include <hip/hip_runtime.h>
#include <hip/hip_cooperative_groups.h>
#include <cstdio>
#include <cstdint>
namespace cg = cooperative_groups;
namespace pg8 {
#define PG8_LAS __attribute__((address_space(3)))
typedef unsigned short bf16_t;
typedef short bf16x8 __attribute__((ext_vector_type(8)));
typedef float f32x4 __attribute__((ext_vector_type(4)));
typedef unsigned u32x4 __attribute__((ext_vector_type(4)));
constexpr int BM = 256, BK = 64, HALF = 128, HTB = HALF * BK * 2  , STAGE_BYTES = 8 * HTB, NXCD = 8, WGM = 8;

__host__ __device__ __forceinline__ int lds_byte(int r, int c) { const int st = (r >> 4) * 2 + (c >> 5), rr = r & 15, cc = c & 31, ob = rr * 64 + cc * 2; return st * 1024 + (ob ^ (((ob >> 9) & 1) << 5)); }
__host__ __device__ __forceinline__ void stage_rc(int b, int& R, int& C) { const int st = b / 1024, sb = b % 1024, swz = sb ^ (((sb >> 9) & 1) << 5); R = (st >> 1) * 16 + swz / 64; C = (st & 1) * 32 + (swz % 64) / 2; }
__host__ __device__ __forceinline__ int perm32(int rho) { const int n = rho >> 4, i = rho & 15; return 8 * (i >> 2) + 4 * n + (i & 3); }

struct Unit { int pm, pn, seg; };
struct Gemm { const bf16_t* A; const bf16_t* Bt; int M, N, K; const bf16_t* A2; const bf16_t* Bt2; };

struct StaticOrder {
    int nM, nN, nwg, G, c;
    __host__ __device__ void init(int M, int N, int G_, int c_) { nM = M / BM; nN = N / BM; nwg = nM * nN; G = G_; c = c_; }
    __host__ __device__ bool next(int i, Unit& u) const {
        const long L = (long)i * G + c; if (L >= nwg) return false;
        int wgid = (int)L; { const int q = nwg / NXCD, r = nwg % NXCD, xcd = wgid % NXCD, off = wgid / NXCD; wgid = (xcd < r ? xcd * (q + 1) : r * (q + 1) + (xcd - r) * q) + off; }
        const int nig = WGM * nN, gid = wgid / nig, fm = gid * WGM, gsz = (nM - fm) < WGM ? (nM - fm) : WGM;
        u.pm = fm + ((wgid % nig) % gsz); u.pn = (wgid % nig) / gsz; u.seg = 0; return true;
    }
    __device__ __forceinline__ void a_ready(const Unit&) const {}
    __device__ __forceinline__ void done(const Unit&) const {}
};
typedef float f32x2_cv __attribute__((ext_vector_type(2)));
typedef __bf16 bf16x2_cv __attribute__((ext_vector_type(2)));
struct StaticOrder2 : StaticOrder { __host__ __device__ bool next(int i, Unit& u) const { if (!StaticOrder::next(i >> 1, u)) return false; u.seg = i & 1; return true; } };
__device__ __forceinline__ unsigned cvt_pk_bf16(float lo, float hi) { const f32x2_cv v = {lo, hi}; return __builtin_bit_cast(unsigned, __builtin_convertvector(v, bf16x2_cv)); }
typedef float f32x2 __attribute__((ext_vector_type(2)));
template <class Epi, class Sched, bool ALIGN_EPI = false, bool SP2 = false, bool TWOSEG = false>
__device__ __forceinline__ void gemm_phase(PG8_LAS unsigned char* lds, const Gemm g, const Sched& S, const Epi& E, const int tid_in) {
    int tid_ = tid_in; asm volatile("" : "+v"(tid_));
    const int tid = tid_, wid = __builtin_amdgcn_readfirstlane(tid >> 6), lane = tid & 63, wr = wid >> 2, wc = wid & 3, fr = lane & 15, fq = lane >> 4;
    const int K = g.K, nt = K / BK;
    unsigned voffA[2], voffB[2];
#pragma unroll
    for (int i = 0; i < 2; ++i) { int R, C; stage_rc(tid * 16 + i * 8192, R, C); const int Rb = Epi::PERM ? ((R & ~31) + perm32(R & 31)) : R;
        voffA[i] = (unsigned)(R * K + C) * 2u; voffB[i] = (unsigned)(Rb * K + C) * 2u; }
    const size_t kstep = (size_t)(BK * 2);
    const size_t hstep = (size_t)HALF * K * 2;
    const size_t tstep = 2 * hstep;
    const unsigned ldsw = (unsigned)wid * 1024u;
    const int aoff = lds_byte(wr * 64 + fr, fq * 8), boff = lds_byte(wc * 32 + fr, fq * 8);
#define PG8_SA(b, h) (((b) * 2 + (h)) * HTB)
#define PG8_SB(b, h) ((4 + (b) * 2 + (h)) * HTB)
#define PG8_STAGE(bufoff, gbase, voff) do { _Pragma("unroll") for (int _i = 0; _i < 2; ++_i) \
        __builtin_amdgcn_global_load_lds((const unsigned*)((const char*)(gbase) + (voff)[_i]), (PG8_LAS unsigned*)(lds + (bufoff) + ldsw + _i * 8192), 16, 0, 0); } while (0)
#define PG8_LDA(dst, b, h) do { _Pragma("unroll") for (int m = 0; m < 4; ++m) _Pragma("unroll") for (int k = 0; k < 2; ++k) dst[m][k] = *(const PG8_LAS bf16x8*)(lds + PG8_SA(b, h) + aoff + m * 2048 + k * 1024); } while (0)
#define PG8_LDB(dst, b, h) do { _Pragma("unroll") for (int n = 0; n < 2; ++n) _Pragma("unroll") for (int k = 0; k < 2; ++k) dst[n][k] = *(const PG8_LAS bf16x8*)(lds + PG8_SB(b, h) + boff + n * 2048 + k * 1024); } while (0)
#define PG8_MMA(ai, bj, At, Bt) do { __builtin_amdgcn_s_setprio(1); _Pragma("unroll") for (int m = 0; m < 4; ++m) _Pragma("unroll") for (int n = 0; n < 2; ++n) _Pragma("unroll") for (int k = 0; k < 2; ++k) \
        acc[ai][bj][m][n] = __builtin_amdgcn_mfma_f32_16x16x32_bf16(Bt[n][k], At[m][k], acc[ai][bj][m][n], 0, 0, 0); __builtin_amdgcn_s_setprio(0); } while (0)
#define PG8_WAIT_V(n) asm volatile("s_waitcnt vmcnt(" #n ")" ::: "memory")
#define PG8_WAIT_L(n) asm volatile("s_waitcnt lgkmcnt(" #n ")" ::: "memory")
#define PG8_BAR __builtin_amdgcn_s_barrier()
#define PG8_SCHED __builtin_amdgcn_sched_barrier(0)
    Unit cur, nxt; int ui = 0;
    if (!S.next(0, cur)) return;
    f32x4 acc[2][2][4][2];
#pragma unroll
    for (int a = 0; a < 2; ++a)
#pragma unroll
        for (int b = 0; b < 2; ++b)
#pragma unroll
            for (int m = 0; m < 4; ++m)
#pragma unroll
                for (int n = 0; n < 2; ++n) acc[a][b][m][n] = (f32x4){0.f, 0.f, 0.f, 0.f};
    bf16x8 At[4][2], B0[2][2], B1[2][2];
    const char* cA = (const char*)((TWOSEG && cur.seg) ? g.A2 : g.A) + (size_t)cur.pm * tstep; const char* cB = (const char*)((TWOSEG && cur.seg) ? g.Bt2 : g.Bt) + (size_t)cur.pn * tstep;
    S.a_ready(cur);
    if constexpr (SP2) {
        PG8_STAGE(PG8_SB(0, 0), cB, voffB); PG8_STAGE(PG8_SB(0, 1), cB + hstep, voffB); PG8_STAGE(PG8_SA(0, 0), cA, voffA); PG8_STAGE(PG8_SA(0, 1), cA + hstep, voffA);
        if (wr == 1) PG8_BAR;
        PG8_WAIT_V(2); PG8_BAR;
        PG8_STAGE(PG8_SB(1, 0), cB + kstep, voffB); PG8_STAGE(PG8_SA(1, 0), cA + kstep, voffA); PG8_STAGE(PG8_SB(1, 1), cB + hstep + kstep, voffB);
        PG8_WAIT_V(6); PG8_BAR;
    } else {
        PG8_STAGE(PG8_SB(0, 0), cB, voffB); PG8_STAGE(PG8_SA(0, 0), cA, voffA); PG8_STAGE(PG8_SB(0, 1), cB + hstep, voffB); PG8_STAGE(PG8_SA(0, 1), cA + hstep, voffA);
        if (wr == 1) PG8_BAR;
        PG8_WAIT_V(4); PG8_BAR;
        PG8_STAGE(PG8_SB(1, 0), cB + kstep, voffB); PG8_STAGE(PG8_SA(1, 0), cA + kstep, voffA); PG8_STAGE(PG8_SB(1, 1), cB + hstep + kstep, voffB);
        PG8_WAIT_V(6); PG8_BAR;
    }
    for (;;) {
        const bool has_next = S.next(ui + 1, nxt);
        const char* nA = has_next ? (const char*)((TWOSEG && nxt.seg) ? g.A2 : g.A) + (size_t)nxt.pm * tstep : cA; const char* nB = has_next ? (const char*)((TWOSEG && nxt.seg) ? g.Bt2 : g.Bt) + (size_t)nxt.pn * tstep : cB;
        for (int t = 0; t < nt; t += 2) {
            const bool last = (t == nt - 2);
            const char* a1 = cA + (size_t)(t + 1) * kstep;
            const char* a2 = last ? nA : cA + (size_t)(t + 2) * kstep; const char* b2 = last ? nB : cB + (size_t)(t + 2) * kstep;
            const char* a3 = a2 + kstep; const char* b3 = b2 + kstep;
            if (last && has_next) S.a_ready(nxt);
            if constexpr (SP2) {
            PG8_LDB(B0, 0, 0); PG8_LDB(B1, 0, 1); PG8_SCHED; PG8_LDA(At, 0, 0); PG8_STAGE(PG8_SA(1, 1), a1 + hstep, voffA);
            PG8_WAIT_V(8); PG8_WAIT_L(0); PG8_BAR; PG8_MMA(0, 0, At, B0); PG8_MMA(0, 1, At, B1); PG8_BAR; PG8_SCHED;
            PG8_LDA(At, 0, 1); PG8_STAGE(PG8_SB(0, 0), b2, voffB); PG8_STAGE(PG8_SB(0, 1), b2 + hstep, voffB); PG8_STAGE(PG8_SA(0, 0), a2, voffA);
            PG8_WAIT_V(8); PG8_WAIT_L(0); PG8_BAR; PG8_MMA(1, 0, At, B0); PG8_MMA(1, 1, At, B1); PG8_BAR; PG8_SCHED;
            PG8_LDB(B0, 1, 0); PG8_LDB(B1, 1, 1); PG8_SCHED; PG8_LDA(At, 1, 0); PG8_STAGE(PG8_SA(0, 1), a2 + hstep, voffA);
            PG8_WAIT_V(8); PG8_WAIT_L(0); PG8_BAR; PG8_MMA(0, 0, At, B0); PG8_MMA(0, 1, At, B1); PG8_BAR; PG8_SCHED;
            PG8_LDA(At, 1, 1); PG8_STAGE(PG8_SB(1, 0), b3, voffB); PG8_STAGE(PG8_SB(1, 1), b3 + hstep, voffB); PG8_STAGE(PG8_SA(1, 0), a3, voffA);
            PG8_WAIT_V(8); PG8_WAIT_L(0); PG8_BAR; PG8_MMA(1, 0, At, B0); PG8_MMA(1, 1, At, B1); PG8_BAR; PG8_SCHED;
            } else {
            PG8_LDB(B0, 0, 0); PG8_SCHED; PG8_LDA(At, 0, 0); PG8_STAGE(PG8_SA(1, 1), a1 + hstep, voffA);
            PG8_WAIT_L(8); PG8_BAR; PG8_WAIT_L(0); PG8_MMA(0, 0, At, B0); PG8_BAR; PG8_SCHED;
            PG8_LDB(B1, 0, 1); PG8_STAGE(PG8_SB(0, 0), b2, voffB);
            PG8_BAR; PG8_WAIT_L(0); PG8_MMA(0, 1, At, B1); PG8_BAR;
            PG8_LDA(At, 0, 1); PG8_STAGE(PG8_SA(0, 0), a2, voffA);
            PG8_BAR; PG8_WAIT_L(0); PG8_MMA(1, 0, At, B0); PG8_BAR; PG8_SCHED;
            PG8_STAGE(PG8_SB(0, 1), b2 + hstep, voffB);
            PG8_WAIT_V(6); PG8_BAR; PG8_MMA(1, 1, At, B1); PG8_BAR;
            PG8_LDB(B0, 1, 0); PG8_SCHED; PG8_LDA(At, 1, 0); PG8_STAGE(PG8_SA(0, 1), a2 + hstep, voffA);
            PG8_WAIT_L(8); PG8_BAR; PG8_WAIT_L(0); PG8_MMA(0, 0, At, B0); PG8_BAR; PG8_SCHED;
            PG8_LDB(B1, 1, 1); PG8_STAGE(PG8_SB(1, 0), b3, voffB);
            PG8_BAR; PG8_WAIT_L(0); PG8_MMA(0, 1, At, B1); PG8_BAR;
            PG8_LDA(At, 1, 1); PG8_STAGE(PG8_SA(1, 0), a3, voffA);
            PG8_BAR; PG8_WAIT_L(0); PG8_MMA(1, 0, At, B0); PG8_BAR; PG8_SCHED;
            PG8_STAGE(PG8_SB(1, 1), b3 + hstep, voffB);
            PG8_WAIT_V(6); PG8_BAR; PG8_MMA(1, 1, At, B1); PG8_BAR;
            }
        }
        if constexpr (ALIGN_EPI) { if (wr == 0) PG8_BAR; }
        if constexpr (TWOSEG) { if (cur.seg == 0) E.mid(acc, cur, wr, wc, fr, fq); else E(acc, cur, wr, wc, fr, fq); }
        else if constexpr (!Epi::AFTER_DRAIN) { E(acc, cur, wr, wc, fr, fq); S.done(cur); }
        if (!has_next) break;
        if (!(TWOSEG && cur.seg == 0))
#pragma unroll
        for (int a = 0; a < 2; ++a)
#pragma unroll
            for (int b = 0; b < 2; ++b)
#pragma unroll
                for (int m = 0; m < 4; ++m)
#pragma unroll
                    for (int n = 0; n < 2; ++n) acc[a][b][m][n] = (f32x4){0.f, 0.f, 0.f, 0.f};
        cur = nxt; cA = nA; cB = nB; ++ui;
        if constexpr (ALIGN_EPI) { if (wr == 1) PG8_BAR; }
    }
    PG8_WAIT_V(0);
    if constexpr (!ALIGN_EPI) { if (wr == 0) PG8_BAR; }
    PG8_BAR;
    if constexpr (Epi::AFTER_DRAIN) { E.fused(acc, cur, wr, wc, fr, fq, lds, wid, lane); S.done(cur); }
#undef PG8_SA
#undef PG8_SB
#undef PG8_STAGE
#undef PG8_LDA
#undef PG8_LDB
#undef PG8_MMA
#undef PG8_WAIT_V
#undef PG8_WAIT_L
#undef PG8_BAR
#undef PG8_SCHED
}
}

using pg8::bf16_t; using pg8::f32x4; using pg8::u32x4; using pg8::Unit;
#define LAS __attribute__((address_space(3)))
#define DI __device__ __forceinline__
typedef unsigned u32x2 __attribute__((ext_vector_type(2)));
typedef LAS f32x4* lds_f4p;
typedef LAS bf16_t* lbf;
typedef const LAS bf16_t* clbf;
typedef short s16x8 __attribute__((ext_vector_type(8)));
#define LDSYNC() do { asm volatile("s_waitcnt lgkmcnt(0)" ::: "memory"); __syncthreads(); } while (0)

constexpr int DM = 2048, MP = 16384, M = 16640, NAB = 6656, NC = 5120, DFF = 8192, DPLE = 256;
constexpr float EPS = 1e-6f;
constexpr size_t O_SGP = 34078720, O_BUFP = 34603008, O_SRP = 34639872, O_SHP = 34902016, O_SGS = 34916096, O_BUFS = 35964672, O_SRS = 36038400, O_SHS = 36562688, O_END = 36590848;
constexpr size_t DO_H = 0, DO_WC = 68157440, DO_WAB = 89128960, DO_AL2 = 116391936, DO_AG = 124911616;
constexpr size_t C_SS1 = 0x10000, C_SS2 = 0x30000, C_SS3 = 0x50000, C_RSO = 0x80000, C_GA = 0x110000, C_GB = 0x1A0000, C_WL2T = 0x230000, C_G2T = 0x330000;
constexpr size_t WS_PROJ = 6291456, WS_GDNS = 227803136, WS_RWKS = 330039296, SLOT = 34078720, WS_NEED = 534511616;
constexpr size_t WS_GTAIL = WS_GDNS + 67502080;
constexpr size_t GT_UPA = 0, GT_UPB = 4194304, GT_WO = 8388608, GT_PG = 16777216, GT_PLE = 25165824, GT_PB = 26214400;
constexpr int LDS_BYTES = 163840;

struct Args { const float* in[35]; float* out; unsigned char* ws; int ph_lo, ph_hi; };

struct Frame {
    LAS unsigned char* lds; int tid, lane, wave, G, bid;
    float* out; unsigned char* ws; unsigned char* dob;
};
struct KIn { DI const float* operator[](int i) const { return ((const float* const volatile __attribute__((address_space(4)))*)__builtin_amdgcn_kernarg_segment_ptr())[i]; } };

DI float bf2f(unsigned short b) { return __uint_as_float((unsigned)b << 16); }
DI void unpack8(const u32x4 w, float (&f)[8]) {
    f[0] = __uint_as_float(w.x << 16); f[1] = __uint_as_float(w.x & 0xffff0000u); f[2] = __uint_as_float(w.y << 16); f[3] = __uint_as_float(w.y & 0xffff0000u);
    f[4] = __uint_as_float(w.z << 16); f[5] = __uint_as_float(w.z & 0xffff0000u); f[6] = __uint_as_float(w.w << 16); f[7] = __uint_as_float(w.w & 0xffff0000u);
}
DI u32x4 pack8(const float (&f)[8]) { u32x4 w; w.x = pg8::cvt_pk_bf16(f[0], f[1]); w.y = pg8::cvt_pk_bf16(f[2], f[3]); w.z = pg8::cvt_pk_bf16(f[4], f[5]); w.w = pg8::cvt_pk_bf16(f[6], f[7]); return w; }
DI void ld8l(const LAS float* p, float (&f)[8]) { const f32x4 a = *(const LAS f32x4*)p, b = *(const LAS f32x4*)(p + 4); f[0] = a.x; f[1] = a.y; f[2] = a.z; f[3] = a.w; f[4] = b.x; f[5] = b.y; f[6] = b.z; f[7] = b.w; }
DI void ld8f(const float* p, float (&f)[8]) { const f32x4 a = *(const f32x4*)p, b = *(const f32x4*)(p + 4); f[0] = a.x; f[1] = a.y; f[2] = a.z; f[3] = a.w; f[4] = b.x; f[5] = b.y; f[6] = b.z; f[7] = b.w; }
DI void st8f(float* p, const float (&f)[8]) { *(f32x4*)p = (f32x4){f[0], f[1], f[2], f[3]}; *(f32x4*)(p + 4) = (f32x4){f[4], f[5], f[6], f[7]}; }
DI float sigm(float x) { return __builtin_amdgcn_rcpf(1.f + __expf(-x)); }
DI float softplus_(float x) { return x > 20.f ? x : __logf(1.f + __expf(x)); }
DI float tanh_(float x) { return 1.f - 2.f * __builtin_amdgcn_rcpf(1.f + __expf(2.f * x)); }
template <int CTRL> DI float dpp_f(float v) { return __builtin_bit_cast(float, __builtin_amdgcn_update_dpp(0, __builtin_bit_cast(int, v), CTRL, 0xF, 0xF, true)); }
DI float red4(float v) { v += dpp_f<0xB1>(v); v += dpp_f<0x4E>(v); return v; }
DI float red8(float v) { v = red4(v); v += dpp_f<0x141>(v); return v; }
DI float red16(float v) { v = red8(v); v += dpp_f<0x140>(v); return v; }
DI float wave_sum(float v) {
#pragma unroll
    for (int o = 1; o < 64; o <<= 1) v += __shfl_xor(v, o);
    return v;
}
DI int seq_base(int s) { return s < 4 ? s * 4096 : MP + (s - 4) * 32; }
DI int seq_T(int s) { return s < 4 ? 4096 : 32; }

template <class F> struct EpiT {
    static constexpr bool PERM = true, AFTER_DRAIN = false; F f;
    DI void operator()(const f32x4 (&acc)[2][2][4][2], const Unit& u, int wr, int wc, int fr, int fq) const {
#pragma unroll
        for (int ai = 0; ai < 2; ++ai) {
            typename F::L l[4][2];
#pragma unroll
            for (int m = 0; m < 4; ++m)
#pragma unroll
                for (int bj = 0; bj < 2; ++bj) f.pre(u, u.pm * 256 + ai * 128 + wr * 64 + m * 16 + fr, u.pn * 256 + bj * 128 + wc * 32 + fq * 8, l[m][bj]);
#pragma unroll
            for (int m = 0; m < 4; ++m) {
                const int row = u.pm * 256 + ai * 128 + wr * 64 + m * 16 + fr; float ss = 0.f;
#pragma unroll
                for (int bj = 0; bj < 2; ++bj) { const int col = u.pn * 256 + bj * 128 + wc * 32 + fq * 8; ss += f.apply(u, row, col, acc[ai][bj][m][0], acc[ai][bj][m][1], l[m][bj]); }
                if (F::SUMSQ) { ss += __shfl_xor(ss, 16); ss += __shfl_xor(ss, 32); if (fq == 0) unsafeAtomicAdd(f.ssq + row, ss); }
            }
            asm volatile("" ::: "memory");
        }
    }
};
template <class F> DI float apply5(const F& f, const Unit& u, int row, int col, f32x4 v0, f32x4 v1) { typename F::L l; f.pre(u, row, col, l); return f.apply(u, row, col, v0, v1, l); }
DI void v2f(const f32x4 v0, const f32x4 v1, float (&f)[8]) { f[0] = v0.x; f[1] = v0.y; f[2] = v0.z; f[3] = v0.w; f[4] = v1.x; f[5] = v1.y; f[6] = v1.z; f[7] = v1.w; }
struct LNone {};
struct FStore { static constexpr bool SUMSQ = false; float* ssq; bf16_t* O; int ld; typedef LNone L;
    DI void pre(const Unit&, int, int, L&) const {}
    DI float apply(const Unit&, int row, int col, f32x4 v0, f32x4 v1, const L&) const { float v[8]; v2f(v0, v1, v); *(u32x4*)(O + (size_t)row * ld + col) = pack8(v); return 0.f; } };
struct FLora { static constexpr bool SUMSQ = false; float* ssq; bf16_t* O0; bf16_t* O1; typedef LNone L;
    DI void pre(const Unit&, int, int, L&) const {}
    DI float apply(const Unit& u, int row, int col, f32x4 v0, f32x4 v1, const L&) const { float v[8]; v2f(v0, v1, v); bf16_t* O = u.pn < 4 ? O0 : O1; *(u32x4*)(O + (size_t)row * 1024 + (col & 1023)) = pack8(v); return 0.f; } };
struct FGates { static constexpr bool SUMSQ = false; float* ssq; const bf16_t* oraw; const float* rso; const float* normg; bf16_t* OA; bf16_t* Gma; bf16_t* Gmb;
    struct L { u32x4 o; float rs; };
    DI void pre(const Unit& u, int row, int col, L& l) const { if (u.pn < 4) { l.o = *(const u32x4*)(oraw + (size_t)row * 1024 + col); l.rs = rso[row * 8 + (col >> 7)]; } }
    DI float apply(const Unit& u, int row, int col, f32x4 v0, f32x4 v1, const L& l) const {
        float v[8], r[8]; v2f(v0, v1, v);
        if (u.pn < 4) { const int d = col & 127; float o[8], g[8]; unpack8(l.o, o); ld8f(normg + d, g); const float rs = l.rs;
#pragma unroll
            for (int j = 0; j < 8; ++j) r[j] = o[j] * rs * g[j] * v[j] * sigm(v[j]);
            *(u32x4*)(OA + (size_t)row * 1024 + col) = pack8(r);
        } else { const int c2 = col - 1024; bf16_t* G = c2 < 2048 ? Gma : Gmb;
#pragma unroll
            for (int j = 0; j < 8; ++j) r[j] = sigm(v[j]);
            *(u32x4*)(G + (size_t)row * 2048 + (c2 & 2047)) = pack8(r); }
        return 0.f; } };
struct FUpA { static constexpr bool SUMSQ = false; float* ssq; const bf16_t* Gma; float* T1; struct L { u32x4 g; };
    DI void pre(const Unit&, int row, int col, L& l) const { l.g = *(const u32x4*)(Gma + (size_t)row * 2048 + col); }
    DI float apply(const Unit&, int row, int col, f32x4 v0, f32x4 v1, const L& l) const { float v[8], g[8]; v2f(v0, v1, v); unpack8(l.g, g);
#pragma unroll
        for (int j = 0; j < 8; ++j) v[j] *= g[j];
        st8f(T1 + (size_t)row * 2048 + col, v); return 0.f; } };
struct FUpB { static constexpr bool SUMSQ = false; float* ssq; const bf16_t* Gmb; const float* T1; bf16_t* MG; struct L { u32x4 g; f32x4 t0, t1; };
    DI void pre(const Unit&, int row, int col, L& l) const { l.g = *(const u32x4*)(Gmb + (size_t)row * 2048 + col); l.t0 = *(const f32x4*)(T1 + (size_t)row * 2048 + col); l.t1 = *(const f32x4*)(T1 + (size_t)row * 2048 + col + 4); }
    DI float apply(const Unit&, int row, int col, f32x4 v0, f32x4 v1, const L& l) const { float v[8], g[8], t[8]; v2f(v0, v1, v); unpack8(l.g, g); v2f(l.t0, l.t1, t);
#pragma unroll
        for (int j = 0; j < 8; ++j) v[j] = t[j] + v[j] * g[j];
        *(u32x4*)(MG + (size_t)row * 2048 + col) = pack8(v); return 0.f; } };
struct FRes { static constexpr bool SUMSQ = true; float* ssq; const float* xp; const float* xs; bf16_t* XB; struct L { f32x4 b0, b1; };
    DI void pre(const Unit&, int row, int col, L& l) const { const float* src = row < MP ? xp + (size_t)row * 2048 + col : xs + (size_t)(row - MP) * 2048 + col; l.b0 = *(const f32x4*)src; l.b1 = *(const f32x4*)(src + 4); }
    DI float apply(const Unit&, int row, int col, f32x4 v0, f32x4 v1, const L& l) const { float v[8], b[8]; v2f(v0, v1, v); v2f(l.b0, l.b1, b); float ss = 0.f;
#pragma unroll
        for (int j = 0; j < 8; ++j) { v[j] += b[j]; ss += v[j] * v[j]; }
        *(u32x4*)(XB + (size_t)row * 2048 + col) = pack8(v); return ss; } };
struct FRes2 { static constexpr bool SUMSQ = true; float* ssq; bf16_t* XB; struct L { u32x4 b; };
    DI void pre(const Unit&, int row, int col, L& l) const { l.b = *(const u32x4*)(XB + (size_t)row * 2048 + col); }
    DI float apply(const Unit&, int row, int col, f32x4 v0, f32x4 v1, const L& l) const { float v[8], b[8]; v2f(v0, v1, v); unpack8(l.b, b); float ss = 0.f;
#pragma unroll
        for (int j = 0; j < 8; ++j) { v[j] += b[j]; ss += v[j] * v[j]; }
        *(u32x4*)(XB + (size_t)row * 2048 + col) = pack8(v); return ss; } };
struct FFf1 { static constexpr bool SUMSQ = false; float* ssq; const float* ssin; bf16_t* HID; struct L { float ss; };
    DI void pre(const Unit&, int row, int, L& l) const { l.ss = ssin[row]; }
    DI float apply(const Unit&, int row, int col, f32x4 v0, f32x4 v1, const L& l) const { float v[8]; v2f(v0, v1, v); const float rs = rsqrtf(l.ss * (1.f / 2048.f) + EPS);
#pragma unroll
        for (int j = 0; j < 8; ++j) { const float t = fmaxf(v[j] * rs, 0.f); v[j] = t * t; }
        *(u32x4*)(HID + (size_t)row * DFF + col) = pack8(v); return 0.f; } };
struct FPg { static constexpr bool SUMSQ = true; float* ssq; const float* ssin; const bf16_t* PL; bf16_t* X3; const bf16_t* XB; struct L { u32x4 b, p; float ss; };
    DI void pre(const Unit&, int row, int col, L& l) const { l.b = *(const u32x4*)(XB + (size_t)row * 2048 + col); l.p = *(const u32x4*)(PL + (size_t)row * 2048 + col); l.ss = ssin[row]; }
    DI float apply(const Unit&, int row, int col, f32x4 v0, f32x4 v1, const L& l) const { float v[8], b[8], p[8]; v2f(v0, v1, v); const float rs = rsqrtf(l.ss * (1.f / 2048.f) + EPS);
        unpack8(l.b, b); unpack8(l.p, p); float ss = 0.f;
#pragma unroll
        for (int j = 0; j < 8; ++j) { v[j] = b[j] + sigm(v[j] * rs) * p[j]; ss += v[j] * v[j]; }
        *(u32x4*)(X3 + (size_t)row * 2048 + col) = pack8(v); return ss; } };

constexpr int SG_LD = 264, SG_A = 32 * SG_LD * 2  , SG_BUF = 96 * SG_LD * 2  , SG_T = 2 * SG_BUF  ;
template <class F> DI void sample_gemm(Frame& Fr, const bf16_t* A, const bf16_t* Bt, int N, int K, const F& f, int first_bid) {
    if (Fr.bid < first_bid) return;
    const int ncg = N >> 6, nun = ((ncg + 7) >> 3) * 64, nkc = K >> 8, tid = Fr.tid, x = Fr.lane & 15, g = Fr.lane >> 4, rt = Fr.wave & 1, ct = Fr.wave >> 1;
    LAS float* T = (LAS float*)(Fr.lds + SG_T);
    const int prow = tid >> 5, pc = (tid & 31) * 8;
    for (int un = Fr.bid - first_bid; un < nun; un += Fr.G - first_bid) {
        const int rg = (un >> 3) & 7, cgp = (un >> 6) * 8 + (un & 7);
        if (cgp >= ncg) continue;
        const bf16_t* ga = A + (size_t)(MP + 32 * rg + prow) * K + pc; const bf16_t* gw = Bt + (size_t)(64 * cgp + prow) * K + pc;
        u32x4 R[4][6];
#define SG_LOAD(q, kc) do { const int k0_ = (kc) << 8; R[q][0] = *(const u32x4*)(ga + k0_); R[q][1] = *(const u32x4*)(ga + (size_t)16 * K + k0_); \
        R[q][2] = *(const u32x4*)(gw + k0_); R[q][3] = *(const u32x4*)(gw + (size_t)16 * K + k0_); R[q][4] = *(const u32x4*)(gw + (size_t)32 * K + k0_); R[q][5] = *(const u32x4*)(gw + (size_t)48 * K + k0_); } while (0)
#pragma unroll
        for (int q = 0; q < 4; ++q) if (q < nkc) SG_LOAD(q, q);
        f32x4 acc = (f32x4){0.f, 0.f, 0.f, 0.f};
        for (int kc4 = 0; kc4 < nkc; kc4 += 4) {
#pragma unroll
            for (int q = 0; q < 4; ++q) {
                const int kc = kc4 + q;
                if (kc < nkc) {
                    LAS unsigned char* buf = Fr.lds + (kc & 1) * SG_BUF; lbf As = (lbf)buf, Ws = (lbf)(buf + SG_A);
                    *(LAS u32x4*)(As + prow * SG_LD + pc) = R[q][0]; *(LAS u32x4*)(As + (prow + 16) * SG_LD + pc) = R[q][1];
                    *(LAS u32x4*)(Ws + prow * SG_LD + pc) = R[q][2]; *(LAS u32x4*)(Ws + (prow + 16) * SG_LD + pc) = R[q][3]; *(LAS u32x4*)(Ws + (prow + 32) * SG_LD + pc) = R[q][4]; *(LAS u32x4*)(Ws + (prow + 48) * SG_LD + pc) = R[q][5];
                    LDSYNC();
                    if (kc + 4 < nkc) SG_LOAD(q, kc + 4);
#pragma unroll
                    for (int ks = 0; ks < 8; ++ks) acc = __builtin_amdgcn_mfma_f32_16x16x32_bf16(*(const LAS s16x8*)(Ws + (16 * ct + x) * SG_LD + 32 * ks + 8 * g), *(const LAS s16x8*)(As + (16 * rt + x) * SG_LD + 32 * ks + 8 * g), acc, 0, 0, 0);
                }
            }
        }
#undef SG_LOAD
        *(lds_f4p)(T + (16 * rt + x) * 68 + 16 * ct + 4 * g) = acc;
        LDSYNC();
        if (tid < 256) { const int row = tid >> 3, c0 = (tid & 7) * 8; const f32x4 v0 = *(const lds_f4p)(T + row * 68 + c0), v1 = *(const lds_f4p)(T + row * 68 + c0 + 4); Unit u; u.pm = 64; u.pn = (64 * cgp) >> 8;
            float ss = apply5(f, u, MP + 32 * rg + row, 64 * cgp + c0, v0, v1);
            if (F::SUMSQ) { ss = red8(ss); if ((tid & 7) == 0) unsafeAtomicAdd(f.ssq + MP + 32 * rg + row, ss); } }
        LDSYNC();
    }
}
constexpr int SG2_LD = 136, SG2_A = 64 * SG2_LD * 2  , SG2_BUF = 192 * SG2_LD * 2  , SG2_T = 2 * SG2_BUF  ;
template <class F> DI void sample_gemm2(Frame& Fr, const bf16_t* A, const bf16_t* Bt, int N, int K, const F& f, int first_bid) {
    if (Fr.bid < first_bid) return;
    const int ncg = N >> 7, nun = ((ncg + 7) >> 3) * 32, nkc = K >> 7, tid = Fr.tid, x = Fr.lane & 15, g = Fr.lane >> 4, rt = Fr.wave & 3, cq = Fr.wave >> 2;
    LAS float* T = (LAS float*)(Fr.lds + SG2_T);
    const int prow = tid >> 4, pc = (tid & 15) * 8;
    for (int un = Fr.bid - first_bid; un < nun; un += Fr.G - first_bid) {
        const int rg = (un >> 3) & 3, cgp = (un >> 5) * 8 + (un & 7);
        if (cgp >= ncg) continue;
        const bf16_t* ga = A + (size_t)(MP + 64 * rg + prow) * K + pc; const bf16_t* gw = Bt + (size_t)(128 * cgp + prow) * K + pc;
        u32x4 R[4][6];
#define SG_LOAD(q, kc) do { const int k0_ = (kc) << 7; R[q][0] = *(const u32x4*)(ga + k0_); R[q][1] = *(const u32x4*)(ga + (size_t)32 * K + k0_); \
        R[q][2] = *(const u32x4*)(gw + k0_); R[q][3] = *(const u32x4*)(gw + (size_t)32 * K + k0_); R[q][4] = *(const u32x4*)(gw + (size_t)64 * K + k0_); R[q][5] = *(const u32x4*)(gw + (size_t)96 * K + k0_); } while (0)
#pragma unroll
        for (int q = 0; q < 4; ++q) SG_LOAD(q, q);
        f32x4 acc[4] = {(f32x4){0.f, 0.f, 0.f, 0.f}, (f32x4){0.f, 0.f, 0.f, 0.f}, (f32x4){0.f, 0.f, 0.f, 0.f}, (f32x4){0.f, 0.f, 0.f, 0.f}};
        for (int kc4 = 0; kc4 < nkc; kc4 += 4) {
#pragma unroll
            for (int q = 0; q < 4; ++q) {
                const int kc = kc4 + q;
                LAS unsigned char* buf = Fr.lds + (kc & 1) * SG2_BUF; lbf As = (lbf)buf, Ws = (lbf)(buf + SG2_A);
                *(LAS u32x4*)(As + prow * SG2_LD + pc) = R[q][0]; *(LAS u32x4*)(As + (prow + 32) * SG2_LD + pc) = R[q][1];
                *(LAS u32x4*)(Ws + prow * SG2_LD + pc) = R[q][2]; *(LAS u32x4*)(Ws + (prow + 32) * SG2_LD + pc) = R[q][3]; *(LAS u32x4*)(Ws + (prow + 64) * SG2_LD + pc) = R[q][4]; *(LAS u32x4*)(Ws + (prow + 96) * SG2_LD + pc) = R[q][5];
                LDSYNC();
                { const int kn = kc + 4 < nkc ? kc + 4 : nkc - 1; SG_LOAD(q, kn); }
#pragma unroll
                for (int ks = 0; ks < 4; ++ks) { const s16x8 af = *(const LAS s16x8*)(As + (16 * rt + x) * SG2_LD + 32 * ks + 8 * g);
#pragma unroll
                    for (int j = 0; j < 4; ++j) acc[j] = __builtin_amdgcn_mfma_f32_16x16x32_bf16(*(const LAS s16x8*)(Ws + (16 * (4 * cq + j) + x) * SG2_LD + 32 * ks + 8 * g), af, acc[j], 0, 0, 0); }
            }
        }
#undef SG_LOAD
#pragma unroll
        for (int j = 0; j < 4; ++j) *(lds_f4p)(T + (16 * rt + x) * 132 + 16 * (4 * cq + j) + 4 * g) = acc[j];
        LDSYNC();
#pragma unroll
        for (int i = 0; i < 2; ++i) { const int idx = tid + 512 * i, row = idx >> 4, c0 = (idx & 15) * 8; const f32x4 v0 = *(const lds_f4p)(T + row * 132 + c0), v1 = *(const lds_f4p)(T + row * 132 + c0 + 4); Unit u; u.pm = 64; u.pn = (128 * cgp) >> 8;
            float ss = apply5(f, u, MP + 64 * rg + row, 128 * cgp + c0, v0, v1);
            if (F::SUMSQ) { ss = red16(ss); if ((tid & 15) == 0) unsafeAtomicAdd(f.ssq + MP + 64 * rg + row, ss); } }
        LDSYNC();
    }
}
template <class F> DI void sample_gemm_any(Frame& Fr, const bf16_t* A, const bf16_t* Bt, int N, int K, const F& f, int first_bid) {
    if (N >= 4096 && (N & 127) == 0 && (K & 511) == 0) sample_gemm2(Fr, A, Bt, N, K, f, first_bid); else sample_gemm(Fr, A, Bt, N, K, f, first_bid); }
struct EpiUp2 { static constexpr bool PERM = true, AFTER_DRAIN = false; const bf16_t* Gma; const bf16_t* Gmb; bf16_t* MG;
    DI void mid(f32x4 (&acc)[2][2][4][2], const Unit& u, int wr, int wc, int fr, int fq) const {
#pragma unroll
        for (int ai = 0; ai < 2; ++ai) { u32x4 la[4][2], lb[4][2];
#pragma unroll
            for (int m = 0; m < 4; ++m)
#pragma unroll
                for (int bj = 0; bj < 2; ++bj) { const size_t o = (size_t)(u.pm * 256 + ai * 128 + wr * 64 + m * 16 + fr) * 2048 + u.pn * 256 + bj * 128 + wc * 32 + fq * 8; la[m][bj] = *(const u32x4*)(Gma + o); lb[m][bj] = *(const u32x4*)(Gmb + o); }
#pragma unroll
            for (int m = 0; m < 4; ++m)
#pragma unroll
                for (int bj = 0; bj < 2; ++bj) { float ga[8], gb[8]; unpack8(la[m][bj], ga); unpack8(lb[m][bj], gb);
#pragma unroll
                    for (int j = 0; j < 8; ++j) ga[j] *= __builtin_amdgcn_rcpf(fmaxf(gb[j], 1e-20f));
                    acc[ai][bj][m][0] *= (f32x4){ga[0], ga[1], ga[2], ga[3]}; acc[ai][bj][m][1] *= (f32x4){ga[4], ga[5], ga[6], ga[7]}; }
            asm volatile("" ::: "memory"); }
    }
    DI void operator()(const f32x4 (&acc)[2][2][4][2], const Unit& u, int wr, int wc, int fr, int fq) const {
#pragma unroll
        for (int ai = 0; ai < 2; ++ai) { u32x4 lb[4][2];
#pragma unroll
            for (int m = 0; m < 4; ++m)
#pragma unroll
                for (int bj = 0; bj < 2; ++bj) lb[m][bj] = *(const u32x4*)(Gmb + (size_t)(u.pm * 256 + ai * 128 + wr * 64 + m * 16 + fr) * 2048 + u.pn * 256 + bj * 128 + wc * 32 + fq * 8);
#pragma unroll
            for (int m = 0; m < 4; ++m)
#pragma unroll
                for (int bj = 0; bj < 2; ++bj) { float v[8], gb[8]; v2f(acc[ai][bj][m][0], acc[ai][bj][m][1], v); unpack8(lb[m][bj], gb);
#pragma unroll
                    for (int j = 0; j < 8; ++j) v[j] *= fmaxf(gb[j], 1e-20f);
                    *(u32x4*)(MG + (size_t)(u.pm * 256 + ai * 128 + wr * 64 + m * 16 + fr) * 2048 + u.pn * 256 + bj * 128 + wc * 32 + fq * 8) = pack8(v); }
            asm volatile("" ::: "memory"); }
    }
};
DI void run_gemm_up2(Frame& Fr, const bf16_t* A1, const bf16_t* B1, const bf16_t* A2, const bf16_t* B2, int Mr, int N, int K, const EpiUp2& E) {
    int Kq = K; asm volatile("" : "+s"(Kq));
    pg8::Gemm g{A1, B1, Mr, N, Kq, A2, B2}; pg8::StaticOrder2 S; S.init(Mr, N, Fr.G, Fr.bid);
    pg8::gemm_phase<EpiUp2, pg8::StaticOrder2, true, true, true>(Fr.lds, g, S, E, Fr.tid);
}
template <class F> DI void run_gemm(Frame& Fr, const bf16_t* A, const bf16_t* Bt, int Mr, int N, int K, const F& f) {
    int Kq = K; asm volatile("" : "+s"(Kq));
    pg8::Gemm g{A, Bt, Mr, N, Kq, A, Bt}; pg8::StaticOrder S; S.init(Mr, N, Fr.G, Fr.bid); EpiT<F> E{f};
    pg8::gemm_phase<EpiT<F>, pg8::StaticOrder, true, true>(Fr.lds, g, S, E, Fr.tid);
}

struct Seg { const float* src; int ldw, K, ncols, nvalid; bf16_t* dst; int ldt; const float* gsc; };
DI Seg get_seg(Frame& F, int id) {
    const KIn in{}; bf16_t* WAB = (bf16_t*)(F.ws + WS_RWKS + 2 * SLOT); bf16_t* WC = (bf16_t*)(F.dob + DO_WC); unsigned char* gt = F.ws + WS_GTAIL; Seg s;
    switch (id) {
    case 0: s = Seg{in[9], 11728, 2048, 3072, 3072, WAB, 2048, nullptr}; break;
    case 1: s = Seg{in[9] + 4112, 11728, 2048, 3520, 3520, WAB + (size_t)3072 * 2048, 2048, nullptr}; break;
    case 2: s = Seg{in[9] + 3072, 11728, 2048, 64, 16, WAB + (size_t)6592 * 2048, 2048, nullptr}; break;
    case 3: s = Seg{in[9] + 3088, 11728, 2048, 1024, 1024, WC, 2048, nullptr}; break;
    case 4: s = Seg{in[9] + 7632, 11728, 2048, 4096, 4096, WC + (size_t)1024 * 2048, 2048, nullptr}; break;
    case 5: s = Seg{in[25], 2048, 1024, 2048, 2048, (bf16_t*)(gt + GT_UPA), 1024, nullptr}; break;
    case 6: s = Seg{in[26], 2048, 1024, 2048, 2048, (bf16_t*)(gt + GT_UPB), 1024, nullptr}; break;
    case 7: s = Seg{in[27], 2048, 2048, 2048, 2048, (bf16_t*)(gt + GT_WO), 2048, nullptr}; break;
    case 8: s = Seg{in[32], 2048, 2048, 2048, 2048, (bf16_t*)(gt + GT_PG), 2048, in[31]}; break;
    case 9: s = Seg{in[33], 2048, 256, 2048, 2048, (bf16_t*)(gt + GT_PLE), 256, nullptr}; break;
    case 10: s = Seg{in[29], 8192, 2048, 8192, 8192, (bf16_t*)(F.ws + WS_RWKS + 2 * SLOT), 2048, in[28]}; break;
    default: s = Seg{in[30], 2048, 8192, 2048, 2048, (bf16_t*)(F.ws + WS_RWKS + 3 * SLOT), 8192, nullptr}; break;
    }
    return s;
}
DI void tr_load(const Seg& sg, int item, int lane, float (&r)[32]) {
    const int nblk = sg.ncols >> 5, kb = item / nblk, nb = item - kb * nblk, k0 = 64 * kb, n0 = 32 * nb, nv = sg.nvalid - n0, c4 = 4 * (lane & 7);
#pragma unroll
    for (int i = 0; i < 8; ++i) { const int kk = 8 * i + (lane >> 3); f32x4 v = (f32x4){0.f, 0.f, 0.f, 0.f}; if (c4 < nv) v = *(const f32x4*)(sg.src + (size_t)(k0 + kk) * sg.ldw + n0 + c4);
        r[4 * i] = v.x; r[4 * i + 1] = v.y; r[4 * i + 2] = v.z; r[4 * i + 3] = v.w; }
}
DI void tr_finish(const Seg& sg, int item, LAS float* scr, int lane, const float (&r)[32]) {
    const int nblk = sg.ncols >> 5, kb = item / nblk, nb = item - kb * nblk, k0 = 64 * kb, n0 = 32 * nb, c4 = 4 * (lane & 7);
#pragma unroll
    for (int i = 0; i < 8; ++i) { const int kk = 8 * i + (lane >> 3); const float gs = sg.gsc ? sg.gsc[k0 + kk] : 1.f;
#pragma unroll
        for (int q = 0; q < 4; ++q) scr[kk * 33 + c4 + q] = r[4 * i + q] * gs; }
    asm volatile("s_waitcnt lgkmcnt(0)" ::: "memory");
    const int c = lane & 7;
#pragma unroll
    for (int j = 0; j < 4; ++j) { const int nn = (lane >> 3) + 8 * j; const LAS float* s = scr + (8 * c) * 33 + nn;
        u32x4 o; o.x = pg8::cvt_pk_bf16(s[0 * 33], s[1 * 33]); o.y = pg8::cvt_pk_bf16(s[2 * 33], s[3 * 33]); o.z = pg8::cvt_pk_bf16(s[4 * 33], s[5 * 33]); o.w = pg8::cvt_pk_bf16(s[6 * 33], s[7 * 33]);
        *(u32x4*)(sg.dst + (size_t)(n0 + nn) * sg.ldt + k0 + 8 * c) = o; }
    asm volatile("s_waitcnt lgkmcnt(0)" ::: "memory");
}
DI void conv_range(Frame& F, int seg_lo, int seg_hi) {
    LAS float* scr = (LAS float*)(F.lds + F.wave * 16384);
    const int gw = F.bid * 8 + F.wave, NGW = F.G * 8; int base = 0;
    for (int id = seg_lo; id < seg_hi; ++id) { const Seg sg = get_seg(F, id); const int ni = (sg.K >> 6) * (sg.ncols >> 5);
        int first = gw - (base % NGW); if (first < 0) first += NGW;
        float ra[32], rb[32];
        if (first < ni) tr_load(sg, first, F.lane, ra);
        for (int it = first; it < ni; it += 2 * NGW) {
            if (it + NGW < ni) tr_load(sg, it + NGW, F.lane, rb);
            tr_finish(sg, it, scr, F.lane, ra);
            if (it + NGW < ni) { if (it + 2 * NGW < ni) tr_load(sg, it + 2 * NGW, F.lane, ra); tr_finish(sg, it + NGW, scr, F.lane, rb); }
        }
        base += ni; }
}

DI void ph0(Frame& F) {
    const KIn in{};
    const int gw = F.bid * 8 + F.wave, NGW = F.G * 8, gt = F.bid * 512 + F.tid, NGT = F.G * 512;
    bf16_t* H = (bf16_t*)(F.dob + DO_H);
    const bool hf_ = F.G == 256 && (F.bid & 1);
#pragma unroll 1
    for (int ps_ = 0; ps_ < 2; ++ps_) {
        if ((ps_ == 0) == hf_) {
            float gm[4][8];
#pragma unroll
            for (int j = 0; j < 4; ++j) ld8f(in[8] + 8 * (F.lane + 64 * j), gm[j]);
            for (int m = gw; m < M; m += 2 * NGW) {
                const int m2 = m + NGW; const bool two = m2 < M; const int mb_ = two ? m2 : m;
                const float* xa = m < MP ? in[0] + (size_t)m * DM : in[1] + (size_t)(m - MP) * DM; const float* xb = mb_ < MP ? in[0] + (size_t)mb_ * DM : in[1] + (size_t)(mb_ - MP) * DM;
                float va[4][8], vb[4][8]; float sa = 0.f, sb = 0.f;
#pragma unroll
                for (int j = 0; j < 4; ++j) { ld8f(xa + 8 * (F.lane + 64 * j), va[j]); ld8f(xb + 8 * (F.lane + 64 * j), vb[j]); }
#pragma unroll
                for (int j = 0; j < 4; ++j)
#pragma unroll
                    for (int e = 0; e < 8; ++e) { sa += va[j][e] * va[j][e]; sb += vb[j][e] * vb[j][e]; }
                const float rsa = rsqrtf(wave_sum(sa) * (1.f / DM) + EPS), rsb = rsqrtf(wave_sum(sb) * (1.f / DM) + EPS);
#pragma unroll
                for (int j = 0; j < 4; ++j) { float o[8];
#pragma unroll
                    for (int e = 0; e < 8; ++e) o[e] = va[j][e] * rsa * gm[j][e];
                    const u32x4 w = pack8(o); const size_t off = (size_t)m * DM + 8 * (F.lane + 64 * j);
                    *(u32x4*)(H + off) = w; *(u32x4*)((bf16_t*)(F.ws + WS_RWKS) + off) = w; }
                if (two) {
#pragma unroll
                    for (int j = 0; j < 4; ++j) { float o[8];
#pragma unroll
                        for (int e = 0; e < 8; ++e) o[e] = vb[j][e] * rsb * gm[j][e];
                        const u32x4 w = pack8(o); const size_t off = (size_t)m2 * DM + 8 * (F.lane + 64 * j);
                        *(u32x4*)(H + off) = w; *(u32x4*)((bf16_t*)(F.ws + WS_RWKS) + off) = w; } }
            }
        } else { __syncthreads(); conv_range(F, 0, 3); __syncthreads(); }
    }
    bf16_t* WL2T = (bf16_t*)(F.ws + C_WL2T); bf16_t* G2T = (bf16_t*)(F.ws + C_G2T);
    for (int i = gt; i < 2 * 1024 * 12; i += NGT) { const int mtx = i >= 12288, q = i - 12288 * mtx, n = q & 1023, kg = q >> 10; const float* src = (mtx ? in[18] : in[16]) + (size_t)(8 * kg) * 1024 + n; float f[8];
#pragma unroll
        for (int j = 0; j < 8; ++j) f[j] = src[(size_t)j * 1024];
        *(u32x4*)(WL2T + (size_t)(1024 * mtx + n) * 256 + 96 * mtx + 8 * kg) = pack8(f); }
    for (int i = gt; i < 1024 * 32; i += NGT) { const int n = i & 1023, kg = i >> 10; const float* src = in[19] + (size_t)(8 * kg) * 1024 + n; float f[8];
#pragma unroll
        for (int j = 0; j < 8; ++j) f[j] = src[(size_t)j * 1024];
        *(u32x4*)(G2T + (size_t)n * 256 + 8 * kg) = pack8(f); }
    float* ss1 = (float*)(F.ws + C_SS1); float* ss2 = (float*)(F.ws + C_SS2); float* ss3 = (float*)(F.ws + C_SS3);
    for (int i = gt; i < M; i += NGT) { ss1[i] = 0.f; ss2[i] = 0.f; ss3[i] = 0.f; }
}

DI void tb_decode(int tb, int& s, int& t0) { if (tb < 512) { s = tb >> 7; t0 = (tb & 127) * 32; } else { s = 4 + (tb - 512); t0 = 0; } }
template <int NH, int NI> DI void gdn_prep_item(Frame& F, int s, int t0) {
    const KIn in{}; const int mb = seq_base(s), T = seq_T(s);
    const bf16_t* PROJ = (const bf16_t*)(F.ws + WS_PROJ); bf16_t* GD = (bf16_t*)(F.ws + WS_GDNS);
    if (F.tid < 384) {
        const int ch = F.tid * 8, sec = F.tid >> 7;
        float w0[8], w1[8], w2[8], w3[8]; ld8f(in[10] + ch, w0); ld8f(in[10] + 3072 + ch, w1); ld8f(in[10] + 6144 + ch, w2); ld8f(in[10] + 9216 + ch, w3);
        float x0[8], x1[8], x2[8];
        {
#pragma unroll
          for (int j = 0; j < 3; ++j) { const int pos = t0 + j - 3; float (&xj)[8] = j == 0 ? x0 : j == 1 ? x1 : x2;
              if (pos >= 0) unpack8(*(const u32x4*)(PROJ + (size_t)(mb + pos) * NAB + ch), xj);
              else if (s >= 4) ld8f(in[5] + (size_t)(s - 4) * 9216 + (size_t)(3 + pos) * 3072 + ch, xj);
              else {
#pragma unroll
                  for (int e = 0; e < 8; ++e) xj[e] = 0.f; } } }
        for (int half = 0; half < NH; ++half) {
            u32x4 raw[NI];
#pragma unroll
            for (int i = 0; i < NI; ++i) raw[i] = *(const u32x4*)(PROJ + (size_t)(mb + t0 + half * NI + i) * NAB + ch);
#pragma unroll
            for (int i = 0; i < NI; ++i) {
                float x3[8], c[8]; unpack8(raw[i], x3); float ss = 0.f;
#pragma unroll
                for (int e = 0; e < 8; ++e) { float t = x0[e] * w0[e] + x1[e] * w1[e] + x2[e] * w2[e] + x3[e] * w3[e]; t = t * sigm(t); c[e] = t; ss += t * t; }
                if (sec < 2) { ss = red16(ss); const float sc = rsqrtf(ss + EPS) * (sec == 0 ? 0.08838834764831845f : 1.f);
#pragma unroll
                    for (int e = 0; e < 8; ++e) c[e] *= sc; }
                *(u32x4*)(GD + (size_t)(mb + t0 + half * NI + i) * 3072 + ch) = pack8(c);
#pragma unroll
                for (int e = 0; e < 8; ++e) { x0[e] = x1[e]; x1[e] = x2[e]; x2[e] = x3[e]; }
            }
        }
        if (t0 + NH * NI == T) { float* ob = F.out + (s < 4 ? O_BUFP + (size_t)s * 9216 : O_BUFS + (size_t)(s - 4) * 9216) + ch; st8f(ob, x0); st8f(ob + 3072, x1); st8f(ob + 6144, x2); }
    } else {
        float* ga = (float*)(F.ws + C_GA); float* gb = (float*)(F.ws + C_GB); const int idx = F.tid - 384;
#pragma unroll
        for (int r = 0; r < 2; ++r) { const int p = idx + 128 * r, tt = p >> 3, h = p & 7, m = mb + t0 + tt; if (tt >= NH * NI) continue;
            const float al = bf2f(PROJ[(size_t)m * NAB + 6592 + h]), be = bf2f(PROJ[(size_t)m * NAB + 6600 + h]);
            const float g = -__expf(in[11][h]) * softplus_(al + in[12][h]); ga[m * 8 + h] = g; gb[m * 8 + h] = sigm(be); }
    }
}
template <int NH, int NI> DI void rwkv_mix_item(Frame& F, int s, int t0) {
    const KIn in{}; const int mb = seq_base(s), T = seq_T(s);
    const bf16_t* PROJ = (const bf16_t*)(F.ws + WS_PROJ); bf16_t* AL2 = (bf16_t*)(F.dob + DO_AL2); bf16_t* AG = (bf16_t*)(F.dob + DO_AG);
    if (F.tid < 440) {
        const int i0 = F.tid * 8; float mu[8], xp[8]; ld8f(in[14] + i0, mu);
        if (t0 > 0) unpack8(*(const u32x4*)(PROJ + (size_t)(mb + t0 - 1) * NAB + 3072 + i0), xp);
        else if (s >= 4) ld8f(in[7] + (size_t)(s - 4) * 3520 + i0, xp);
        else {
#pragma unroll
            for (int e = 0; e < 8; ++e) xp[e] = 0.f; }
        for (int half = 0; half < NH; ++half) {
            u32x4 raw[NI];
#pragma unroll
            for (int i = 0; i < NI; ++i) raw[i] = *(const u32x4*)(PROJ + (size_t)(mb + t0 + half * NI + i) * NAB + 3072 + i0);
#pragma unroll
            for (int i = 0; i < NI; ++i) {
                const size_t m = (size_t)(mb + t0 + half * NI + i); float x[8], xm[8]; unpack8(raw[i], x);
#pragma unroll
                for (int e = 0; e < 8; ++e) { xm[e] = x[e] + (xp[e] - x[e]) * mu[e]; xp[e] = x[e]; }
                if (i0 < 3072) { bf16_t* dst = (bf16_t*)(F.ws + WS_RWKS + (size_t)(i0 >> 10) * SLOT); *(u32x4*)(dst + m * 1024 + (i0 & 1023)) = pack8(xm); }
                else if (i0 < 3168) {
#pragma unroll
                    for (int e = 0; e < 8; ++e) xm[e] = tanh_(xm[e]);
                    *(u32x4*)(AL2 + m * 256 + (i0 - 3072)) = pack8(xm); }
                else if (i0 < 3264) { *(u32x4*)(AL2 + m * 256 + 96 + (i0 - 3168)) = pack8(xm); }
                else {
#pragma unroll
                    for (int e = 0; e < 8; ++e) xm[e] = sigm(xm[e]);
                    *(u32x4*)(AG + m * 256 + (i0 - 3264)) = pack8(xm); }
            }
        }
        if (t0 + NH * NI == T) st8f(F.out + (s < 4 ? O_SHP + (size_t)s * 3520 : O_SHS + (size_t)(s - 4) * 3520) + i0, xp);
    } else if (F.tid < 448) {
        const int c = 192 + (F.tid - 440) * 8;
        for (int i = 0; i < NH * NI; ++i) *(u32x4*)(AL2 + (size_t)(mb + t0 + i) * 256 + c) = (u32x4){0u, 0u, 0u, 0u};
    }
}
DI void ph2a(Frame& F) {
    for (int it = F.bid; it < 1024; it += F.G) { const int tb = it >> 1; if ((it ^ (it >> 8)) & 1) rwkv_mix_item<2, 16>(F, tb >> 7, (tb & 127) * 32); else gdn_prep_item<2, 16>(F, tb >> 7, (tb & 127) * 32); }
    for (int it = F.bid; it < 256; it += F.G) { const int q = it >> 1, s = 4 + (q >> 4), t0 = (q & 15) * 2; if (it & 1) rwkv_mix_item<1, 2>(F, s, t0); else gdn_prep_item<1, 2>(F, s, t0); }
}

constexpr int L64 = 64, L128 = 128, TILE64 = 64 * L64 * 2  , TILE128 = 64 * L128 * 2  , TILE128T = 128 * L64 * 2  ;
constexpr size_t C_BONUS = 0x3C0000, C_EGL = 0x4D0000;
constexpr size_t WS_GDNI = WS_PROJ, GDNI_BLK = 73728, WS_RWKI_S = WS_PROJ + 163577856, WS_YRAW = WS_PROJ + 167772160, WS_ORAW = WS_GDNS;
constexpr int GI_W = 0, GI_Q = 16384, GI_KT = 32768, GI_UT = 49152, GI_QK = 65536;

DI u32x2 pack4(const f32x4 v) { u32x2 w; w.x = pg8::cvt_pk_bf16(v.x, v.y); w.y = pg8::cvt_pk_bf16(v.z, v.w); return w; }
DI unsigned short bf1(float v) { return (unsigned short)(pg8::cvt_pk_bf16(v, 0.f) & 0xffffu); }
DI f32x4 unpack4(const u32x2 w) { return (f32x4){__uint_as_float(w.x << 16), __uint_as_float(w.x & 0xffff0000u), __uint_as_float(w.y << 16), __uint_as_float(w.y & 0xffff0000u)}; }
DI int o64(int r, int c) { return r * 64 + ((((c >> 3) ^ ((r >> 1) & 7) ^ ((r >> 4) & 3))) << 3) + (c & 7); }
DI int o128(int r, int c) { return r * 128 + ((((c >> 3) ^ (r & 15))) << 3) + (c & 7); }
template <int KS, int NTW, bool OA, bool SP = false, bool SQ = false> DI void bmm_acc(clbf P, int ldp, clbf QT, int ldq, int mt, int nt0, int lane, f32x4 (&acc)[NTW]) {
    const int x = lane & 15, g = lane >> 4;
#pragma unroll
    for (int ks = 0; ks < KS; ++ks) {
        const int rp = 16 * mt + x; const s16x8 pf = *(const LAS s16x8*)(P + (ldp == L128 ? o128(rp, 32 * ks + 8 * g) : o64(rp, 32 * ks + 8 * g)));
#pragma unroll
        for (int j = 0; j < NTW; ++j) { const int rq = 16 * (nt0 + j) + x; const s16x8 qf = *(const LAS s16x8*)(QT + (ldq == L128 ? o128(rq, 32 * ks + 8 * g) : o64(rq, 32 * ks + 8 * g)));
            acc[j] = OA ? __builtin_amdgcn_mfma_f32_16x16x32_bf16(pf, qf, acc[j], 0, 0, 0) : __builtin_amdgcn_mfma_f32_16x16x32_bf16(qf, pf, acc[j], 0, 0, 0); }
    }
}
template <int KS, int NTW> DI void bmm_dual(clbf P, int ldp, clbf QT, int ldq, int mt, int nt0, int lane, f32x4 (&acc)[NTW], f32x4 (&acc2)[NTW]) {
    const int x = lane & 15, g = lane >> 4;
#pragma unroll
    for (int ks = 0; ks < KS; ++ks) {
        const int rp = 16 * mt + x; const s16x8 pf = *(const LAS s16x8*)(P + (ldp == L128 ? o128(rp, 32 * ks + 8 * g) : o64(rp, 32 * ks + 8 * g)));
#pragma unroll
        for (int j = 0; j < NTW; ++j) { const int rq = 16 * (nt0 + j) + x; const s16x8 qf = *(const LAS s16x8*)(QT + (ldq == L128 ? o128(rq, 32 * ks + 8 * g) : o64(rq, 32 * ks + 8 * g)));
            acc[j] = __builtin_amdgcn_mfma_f32_16x16x32_bf16(qf, pf, acc[j], 0, 0, 0); acc2[j] = __builtin_amdgcn_mfma_f32_16x16x32_bf16(pf, qf, acc2[j], 0, 0, 0); }
    }
}
DI lbf neumann64(lbf Qr0, lbf Qt0, lbf Pt0, lbf Qr1, lbf Qt1, lbf Pt1, f32x4 (&pacc)[2], f32x4 (&pacc2)[2], int mt, int nt0, int lane) {
    const int x = lane & 15, g = lane >> 4;
    { f32x4 q[2] = {(f32x4){0.f, 0.f, 0.f, 0.f}, (f32x4){0.f, 0.f, 0.f, 0.f}}, q2[2] = {(f32x4){0.f, 0.f, 0.f, 0.f}, (f32x4){0.f, 0.f, 0.f, 0.f}};
      bmm_dual<2, 2>(Qr0, L64, Qt0, L64, mt, nt0, lane, q, q2);
#pragma unroll
      for (int j = 0; j < 2; ++j) { *(LAS u32x2*)(Qr1 + o64(16 * mt + x, 16 * (nt0 + j) + 4 * g)) = pack4(q[j]); *(LAS u32x2*)(Qt1 + o64(16 * (nt0 + j) + x, 16 * mt + 4 * g)) = pack4(q2[j]); }
      LDSYNC(); }
    lbf Qr = Qr1, Qt = Qt1, Pt = Pt0, Qrn = Qr0, Qtn = Qt0, Ptn = Pt1;
#pragma unroll 1
    for (int k = 1; k <= 5; ++k) {
        if (k < 5) { f32x4 q[2] = {(f32x4){0.f, 0.f, 0.f, 0.f}, (f32x4){0.f, 0.f, 0.f, 0.f}}, q2[2] = {(f32x4){0.f, 0.f, 0.f, 0.f}, (f32x4){0.f, 0.f, 0.f, 0.f}};
            bmm_dual<2, 2>(Qr, L64, Pt, L64, mt, nt0, lane, pacc, pacc2);
            bmm_dual<2, 2>(Qr, L64, Qt, L64, mt, nt0, lane, q, q2);
#pragma unroll
            for (int j = 0; j < 2; ++j) { const int ot = o64(16 * (nt0 + j) + x, 16 * mt + 4 * g);
                *(LAS u32x2*)(Qrn + o64(16 * mt + x, 16 * (nt0 + j) + 4 * g)) = pack4(q[j]); *(LAS u32x2*)(Qtn + ot) = pack4(q2[j]); *(LAS u32x2*)(Ptn + ot) = pack4(pacc2[j]); } }
        else { bmm_acc<2, 2, false>(Qr, L64, Pt, L64, mt, nt0, lane, pacc);
#pragma unroll
            for (int j = 0; j < 2; ++j) *(LAS u32x2*)(Ptn + o64(16 * mt + x, 16 * (nt0 + j) + 4 * g)) = pack4(pacc[j]); }
        LDSYNC();
        lbf t; t = Qr; Qr = Qrn; Qrn = t; t = Qt; Qt = Qtn; Qtn = t; t = Pt; Pt = Ptn; Ptn = t;
    }
    return Pt;
}

struct RwMat { bf16_t* p[4]; int ld; };
DI RwMat rw_mats(unsigned char* ws, int s, int c, int h) { RwMat r;
    if (s < 4) { const size_t o = (size_t)(s * 4096 + 64 * c) * 1024 + 64 * h; r.ld = 1024; r.p[0] = (bf16_t*)(ws + WS_RWKS) + o; r.p[1] = (bf16_t*)(ws + WS_RWKS + SLOT) + o; r.p[2] = (bf16_t*)(ws + WS_RWKS + 3 * SLOT) + o; r.p[3] = (bf16_t*)(ws + WS_RWKS + 4 * SLOT) + o; }
    else { bf16_t* b = (bf16_t*)(ws + WS_RWKI_S + (size_t)((s - 4) * 16 + h) * 32768); r.ld = 64; r.p[0] = b; r.p[1] = b + 4096; r.p[2] = b + 8192; r.p[3] = b + 12288; }
    return r; }
constexpr int LORA_W_OFF = 14 * TILE64 + 4096;
DI void rwkv_raw_load(Frame& F, u32x4 (&raw)[7], int s, int c, int h, int tid) {
    const int m0 = seq_base(s) + 64 * c;
    const bf16_t* S0 = (const bf16_t*)(F.ws + WS_RWKS) + (size_t)(m0 + (tid >> 3)) * 1024 + 64 * h + 8 * (tid & 7);
#pragma unroll
    for (int i = 0; i < 3; ++i) raw[i] = *(const u32x4*)(S0 + (size_t)i * (SLOT / 2));
    const bf16_t* A0 = (const bf16_t*)(F.dob + DO_AL2) + (size_t)(m0 + (tid >> 5)) * 256 + 8 * (tid & 31);
#pragma unroll
    for (int i = 0; i < 4; ++i) raw[3 + i] = *(const u32x4*)(A0 + (size_t)(16 * i) * 256);
}
DI void rwkv_cprep_item(Frame& F, int s, int c, int h, u32x4 (&raw)[7], int ns, int nc) {
    int tid_ = F.tid; asm volatile("" : "+v"(tid_));
    const int tid = tid_, lane = tid_ & 63, wave = F.wave, x = lane & 15, g = lane >> 4, mt = wave & 3, nt0 = 2 * (wave >> 2);
    const int m0 = seq_base(s) + 64 * c, nvalid = s < 4 ? 64 : 32, t = tid >> 3, cg = tid & 7, ch = 64 * h + 8 * cg;
    LAS unsigned char* L = F.lds;
    lbf AT = (lbf)(L), BT = (lbf)(L + TILE64), KT = (lbf)(L + 2 * TILE64), RT = (lbf)(L + 3 * TILE64), RTR = (lbf)(L + 4 * TILE64), ATT = (lbf)(L + 5 * TILE64), BHT = (lbf)(L + 6 * TILE64), KHT = (lbf)(L + 7 * TILE64), VT = (lbf)(L + 8 * TILE64);
    lbf Qr0 = (lbf)(L + 9 * TILE64), Qt0 = (lbf)(L + 10 * TILE64), Pr0 = (lbf)(L + 11 * TILE64), AAK = (lbf)(L + 12 * TILE64), ABRT = (lbf)(L + 13 * TILE64);
    LAS float* WTOT = (LAS float*)(L + 14 * TILE64); LAS float* GAM = WTOT + 512; const LAS float* PAR = GAM + 64;
    lbf XW = (lbf)(L), XA = (lbf)(L + 2 * TILE64); LAS float* WLF = (LAS float*)(L + 4 * TILE64); LAS float* ALF = (LAS float*)(L + 6 * TILE64);
    clbf W2H = (clbf)(L + LORA_W_OFF), A2H = (clbf)(L + LORA_W_OFF + TILE128);
    { const int pc_ = tid & 31, tk_ = tid >> 5;
      if (pc_ < 24) { lbf X_ = pc_ < 12 ? XW : XA; const int c_ = 8 * (pc_ < 12 ? pc_ : pc_ - 12);
#pragma unroll
          for (int i = 0; i < 4; ++i) *(LAS u32x4*)(X_ + o128(tk_ + 16 * i, c_)) = raw[3 + i]; } }
    LDSYNC();
    { f32x4 a[2] = {(f32x4){0.f, 0.f, 0.f, 0.f}, (f32x4){0.f, 0.f, 0.f, 0.f}}, b[2] = {(f32x4){0.f, 0.f, 0.f, 0.f}, (f32x4){0.f, 0.f, 0.f, 0.f}};
      bmm_acc<3, 2, false>(XW, L128, W2H, L128, mt, nt0, lane, a); bmm_acc<3, 2, false>(XA, L128, A2H, L128, mt, nt0, lane, b);
#pragma unroll
      for (int j = 0; j < 2; ++j) { *(lds_f4p)(WLF + (16 * mt + x) * 64 + 16 * (nt0 + j) + 4 * g) = a[j]; *(lds_f4p)(ALF + (16 * mt + x) * 64 + 16 * (nt0 + j) + 4 * g) = b[j]; } }
    LDSYNC();
    float r[8], kp[8], v[8], lw[8], ka[8], kk[8];
    { u32x4 z = (u32x4){0u, 0u, 0u, 0u}; const bool ok = t < nvalid;
      float kx[8], wl[8], al[8], w0[8], a0[8], kkw[8], kaw[8];
      unpack8(ok ? raw[0] : z, r); unpack8(ok ? raw[1] : z, kx); unpack8(ok ? raw[2] : z, v); ld8l(WLF + t * 64 + 8 * cg, wl); ld8l(ALF + t * 64 + 8 * cg, al);
      if (!ok) {
#pragma unroll
          for (int e = 0; e < 8; ++e) { wl[e] = 0.f; al[e] = 0.f; } }
      ld8l(PAR + 8 * cg, w0); ld8l(PAR + 64 + 8 * cg, a0); ld8l(PAR + 128 + 8 * cg, kkw); ld8l(PAR + 192 + 8 * cg, kaw);
      float ss = 0.f;
#pragma unroll
      for (int e = 0; e < 8; ++e) { lw[e] = ok ? -0.6065306597126334f * sigm(w0[e] + wl[e]) : 0.f;     al[e] = sigm(a0[e] + al[e]); kk[e] = kx[e] * kkw[e]; ss += kk[e] * kk[e]; }
      ss = red8(ss); const float sc = rsqrtf(ss + EPS);
#pragma unroll
      for (int e = 0; e < 8; ++e) { kk[e] *= sc; kp[e] = kx[e] * (1.f + (al[e] - 1.f) * kaw[e]); ka[e] = kk[e] * al[e]; } }
    { float sb = 0.f; float rk[8]; ld8l(PAR + 256 + 8 * cg, rk);
#pragma unroll
      for (int e = 0; e < 8; ++e) sb += r[e] * kp[e] * rk[e];
      sb = red8(sb); if (cg == 0 && t < nvalid) ((float*)(F.ws + C_BONUS))[(size_t)(m0 + t) * 16 + h] = sb; }
    LAS float* LWF = (LAS float*)(L + 9 * TILE64);
    LAS float* OFFS = (LAS float*)(L + 11 * TILE64);
    { f32x4 w0_ = (f32x4){lw[0], lw[1], lw[2], lw[3]}, w1_ = (f32x4){lw[4], lw[5], lw[6], lw[7]}; *(lds_f4p)(LWF + t * 64 + 8 * cg) = w0_; *(lds_f4p)(LWF + t * 64 + 8 * cg + 4) = w1_; }
    LDSYNC();
    { const int c_ = tid & 63; float a = 0.f;
#pragma unroll
      for (int i = 0; i < 8; ++i) { a += LWF[(8 * wave + i) * 64 + c_]; LWF[(8 * wave + i) * 64 + c_] = a; }
      WTOT[wave * 64 + c_] = a; }
    LDSYNC();
    rwkv_raw_load(F, raw, ns, nc, h, tid);
    { const int c_ = tid & 63; float off = 0.f, ref = 0.f;
#pragma unroll
      for (int w = 0; w < 7; ++w) { const float q = WTOT[w * 64 + c_]; if (w < wave) off += q; if (w < 4) ref += q; }
      OFFS[wave * 64 + c_] = off;
      if (wave == 7) { const float tot = off + WTOT[7 * 64 + c_];
          OFFS[512 + c_] = ref; OFFS[576 + c_] = __expf(ref); OFFS[640 + c_] = __expf(tot - ref); GAM[c_] = __expf(tot); } }
    LDSYNC();
    float Lc[8], Lref[8], ER[8], EC[8];
    { float p_[8], o_[8]; ld8l(LWF + t * 64 + 8 * cg, p_); ld8l(OFFS + wave * 64 + 8 * cg, o_); ld8l(OFFS + 512 + 8 * cg, Lref); ld8l(OFFS + 576 + 8 * cg, ER); ld8l(OFFS + 640 + 8 * cg, EC);
#pragma unroll
      for (int e = 0; e < 8; ++e) Lc[e] = p_[e] + o_[e]; }
    { float a1[8], a2[8], a3[8], a4[8], a5[8], a6[8], a7[8], a8[8];
#pragma unroll
      for (int e = 0; e < 8; ++e) { const float E = __expf(Lc[e] - Lref[e]), eneg = __builtin_amdgcn_rcpf(E), ew = __expf(-lw[e]);
          a1[e] = -kk[e] * E * ew;                a2[e] = ka[e] * eneg; a3[e] = kp[e] * eneg; a4[e] = r[e] * E; a5[e] = a4[e] * ER[e];
          a6[e] = a1[e] * ER[e];                          a7[e] = a2[e] * EC[e]; a8[e] = a3[e] * EC[e]; }
      const int o = o64(t, 8 * cg);
      *(LAS u32x4*)(AT + o) = pack8(a1); *(LAS u32x4*)(BT + o) = pack8(a2); *(LAS u32x4*)(KT + o) = pack8(a3); *(LAS u32x4*)(RT + o) = pack8(a4); *(LAS u32x4*)(RTR + o) = pack8(a5);
#pragma unroll
      for (int e = 0; e < 8; ++e) { const int oc = o64(8 * cg + e, t); ATT[oc] = bf1(a6[e]); BHT[oc] = bf1(a7[e]); KHT[oc] = bf1(a8[e]); VT[oc] = bf1(v[e]); } }
    LDSYNC();
    f32x4 pacc[2], pacc2[2], akr[2];
    { f32x4 n[2] = {(f32x4){0.f, 0.f, 0.f, 0.f}, (f32x4){0.f, 0.f, 0.f, 0.f}}, n2[2] = {(f32x4){0.f, 0.f, 0.f, 0.f}, (f32x4){0.f, 0.f, 0.f, 0.f}};
      bmm_dual<2, 2>(AT, L64, BT, L64, mt, nt0, lane, n, n2);
#pragma unroll
      for (int j = 0; j < 2; ++j) { const int m = 16 * mt + x, nn = 16 * (nt0 + j) + 4 * g, r0 = 16 * mt + 4 * g, cc = 16 * (nt0 + j) + x;
#pragma unroll
          for (int e = 0; e < 4; ++e) { if (nn + e >= m) n[j][e] = 0.f; pacc[j][e] = n[j][e] + ((nn + e) == m ? 1.f : 0.f);
              if (cc >= r0 + e) n2[j][e] = 0.f; pacc2[j][e] = n2[j][e] + (cc == (r0 + e) ? 1.f : 0.f); }
          *(LAS u32x2*)(Qr0 + o64(m, nn)) = pack4(n[j]); *(LAS u32x2*)(Qt0 + o64(cc, r0)) = pack4(n2[j]); *(LAS u32x2*)(Pr0 + o64(cc, r0)) = pack4(pacc2[j]); } }
    { f32x4 a[2] = {(f32x4){0.f, 0.f, 0.f, 0.f}, (f32x4){0.f, 0.f, 0.f, 0.f}};
      bmm_acc<2, 2, false>(KT, L64, AT, L64, mt, nt0, lane, a);
#pragma unroll
      for (int j = 0; j < 2; ++j) { const int m = 16 * mt + x, nn = 16 * (nt0 + j) + 4 * g;
#pragma unroll
          for (int e = 0; e < 4; ++e) if (m >= nn + e) a[j][e] = 0.f;
          *(LAS u32x2*)(AAK + o64(m, nn)) = pack4(a[j]); } }
    { f32x4 a[2] = {(f32x4){0.f, 0.f, 0.f, 0.f}, (f32x4){0.f, 0.f, 0.f, 0.f}};
      bmm_acc<2, 2, true>(BT, L64, RT, L64, mt, nt0, lane, a);
      akr[0] = (f32x4){0.f, 0.f, 0.f, 0.f}; akr[1] = akr[0];
      bmm_acc<2, 2, true>(KT, L64, RT, L64, mt, nt0, lane, akr);
#pragma unroll
      for (int j = 0; j < 2; ++j) { const int jj = 16 * mt + 4 * g, tt = 16 * (nt0 + j) + x;
#pragma unroll
          for (int e = 0; e < 4; ++e) if (jj + e > tt) { a[j][e] = 0.f; akr[j][e] = 0.f; }
          *(LAS u32x2*)(ABRT + o64(tt, jj)) = pack4(a[j]); } }
    LDSYNC();
    lbf X = neumann64(Qr0, Qt0, Pr0, AT, BT, KT, pacc, pacc2, mt, nt0, lane);
    lbf W1 = RT, W2 = (X == Pr0) ? KT : Pr0;
    { f32x4 a[2] = {(f32x4){0.f, 0.f, 0.f, 0.f}, (f32x4){0.f, 0.f, 0.f, 0.f}}, b[2] = {(f32x4){0.f, 0.f, 0.f, 0.f}, (f32x4){0.f, 0.f, 0.f, 0.f}};
      bmm_acc<2, 2, false, true, false>(ATT, L64, X, L64, mt, nt0, lane, a);
      bmm_acc<2, 2, false>(AAK, L64, X, L64, mt, nt0, lane, b);
#pragma unroll
      for (int j = 0; j < 2; ++j) { const int o = o64(16 * mt + x, 16 * (nt0 + j) + 4 * g); *(LAS u32x2*)(W1 + o) = pack4(a[j]); *(LAS u32x2*)(W2 + o) = pack4(b[j]); } }
    LDSYNC();
#pragma unroll
    for (int i = 0; i < 7; ++i) asm volatile("" : "+v"(raw[i]));
    const RwMat G = rw_mats(F.ws, s, c, h);
    lbf M2T = Qr0, AKQT = Qt0;
    { f32x4 a[2] = {(f32x4){0.f, 0.f, 0.f, 0.f}, (f32x4){0.f, 0.f, 0.f, 0.f}}, b[2] = {(f32x4){0.f, 0.f, 0.f, 0.f}, (f32x4){0.f, 0.f, 0.f, 0.f}}, d[2] = {(f32x4){0.f, 0.f, 0.f, 0.f}, (f32x4){0.f, 0.f, 0.f, 0.f}};
      bmm_acc<2, 2, true, false, true>(W1, L64, BHT, L64, mt, nt0, lane, a);
      bmm_acc<2, 2, true, false, true>(W2, L64, BHT, L64, mt, nt0, lane, b);
      bmm_acc<2, 2, true>(W1, L64, ABRT, L64, mt, nt0, lane, d);
      bmm_acc<2, 2, true>(W2, L64, ABRT, L64, mt, nt0, lane, akr);
#pragma unroll
      for (int j = 0; j < 2; ++j) { const int mm = 16 * mt + 4 * g, nn = 16 * (nt0 + j) + x;
#pragma unroll
          for (int e = 0; e < 4; ++e) if (mm + e == nn) a[j][e] += GAM[nn];
          *(u32x2*)(G.p[0] + (size_t)nn * G.ld + mm) = pack4(a[j]);
          b[j] += unpack4(*(const LAS u32x2*)(KHT + o64(nn, mm))); *(LAS u32x2*)(M2T + o64(nn, mm)) = pack4(b[j]);
          d[j] += unpack4(*(const LAS u32x2*)(RTR + o64(nn, mm))); *(u32x2*)(G.p[1] + (size_t)nn * G.ld + mm) = pack4(d[j]);
          *(LAS u32x2*)(AKQT + o64(nn, mm)) = pack4(akr[j]); } }
    LDSYNC();
    { f32x4 a[2] = {(f32x4){0.f, 0.f, 0.f, 0.f}, (f32x4){0.f, 0.f, 0.f, 0.f}}, b[2] = {(f32x4){0.f, 0.f, 0.f, 0.f}, (f32x4){0.f, 0.f, 0.f, 0.f}};
      bmm_acc<2, 2, false, true, false>(VT, L64, M2T, L64, mt, nt0, lane, a);
      bmm_acc<2, 2, true, true, false>(VT, L64, AKQT, L64, mt, nt0, lane, b);
#pragma unroll
      for (int j = 0; j < 2; ++j) { *(u32x2*)(G.p[2] + (size_t)(16 * mt + x) * G.ld + 16 * (nt0 + j) + 4 * g) = pack4(a[j]);
          *(u32x2*)(G.p[3] + (size_t)(16 * (nt0 + j) + x) * G.ld + 16 * mt + 4 * g) = pack4(b[j]); } }
    LDSYNC();
}

DI int gdn_ch_index(int s, int c, int h) { return ((s < 4 ? s * 64 + c : 256 + (s - 4)) * 8 + h); }
struct GdnRaw { u32x4 p[6]; float ga, gb; };
DI void gdn_raw_load(Frame& F, GdnRaw& R, int s, int c, int h, int tid) {
    const int m0 = seq_base(s) + 64 * c; const bf16_t* GD = (const bf16_t*)(F.ws + WS_GDNS) + (size_t)(m0 + (tid >> 3)) * 3072 + 128 * h + 16 * (tid & 7);
#pragma unroll
    for (int i = 0; i < 3; ++i) { R.p[2 * i] = *(const u32x4*)(GD + 1024 * i); R.p[2 * i + 1] = *(const u32x4*)(GD + 1024 * i + 8); }
    const size_t og = (size_t)(m0 + (tid & 63)) * 8 + h; R.ga = ((const float*)(F.ws + C_GA))[og]; R.gb = ((const float*)(F.ws + C_GB))[og];
}
DI void gdn_cprep_item(Frame& F, int s, int c, int h, GdnRaw& R, int ns, int nc, int nh) {
    int tid_ = F.tid; asm volatile("" : "+v"(tid_));
    const int tid = tid_, lane = tid_ & 63, wave = F.wave, x = lane & 15, g = lane >> 4, mt = wave & 3, nt0 = 2 * (wave >> 2);
    const int m0 = seq_base(s) + 64 * c, nvalid = s < 4 ? 64 : 32, t = tid >> 3, dg = tid & 7;
    LAS unsigned char* L = F.lds;
    lbf KTm = (lbf)(L), QTm = (lbf)(L + TILE128), KBT = (lbf)(L + 2 * TILE128), VBT = (lbf)(L + 2 * TILE128 + TILE128T), KDT = (lbf)(L + 2 * TILE128 + 2 * TILE128T);
    constexpr int OFF2 = 2 * TILE128 + 3 * TILE128T;
    lbf Qr0 = (lbf)(L + OFF2), Qt0 = (lbf)(L + OFF2 + TILE64), Pr0 = (lbf)(L + OFF2 + 2 * TILE64), Qr1 = (lbf)(L + OFF2 + 3 * TILE64), Qt1 = (lbf)(L + OFF2 + 4 * TILE64), Pr1 = (lbf)(L + OFF2 + 5 * TILE64);
    LAS float* GS = (LAS float*)(L + OFF2 + 6 * TILE64);
    unsigned char* blk = F.ws + WS_GDNI + (size_t)gdn_ch_index(s, c, h) * GDNI_BLK;
    if (wave == 0) { const bool ok = lane < nvalid;
        float a = ok ? R.ga : 0.f; const float be = ok ? R.gb : 0.f;
#pragma unroll
        for (int d = 1; d < 64; d <<= 1) { const float b = __shfl_up(a, d); if (lane >= d) a += b; }
        GS[lane] = a; GS[64 + lane] = be; if (lane == 63) ((float*)(F.ws + C_EGL))[gdn_ch_index(s, c, h)] = __expf(a); }
    float q[16], k[16], v[16];
    { const u32x4 z = (u32x4){0u, 0u, 0u, 0u}; const bool ok = t < nvalid; float f[8];
      unpack8(ok ? R.p[0] : z, f);
#pragma unroll
      for (int e = 0; e < 8; ++e) q[e] = f[e];
      unpack8(ok ? R.p[1] : z, f);
#pragma unroll
      for (int e = 0; e < 8; ++e) q[8 + e] = f[e];
      unpack8(ok ? R.p[2] : z, f);
#pragma unroll
      for (int e = 0; e < 8; ++e) k[e] = f[e];
      unpack8(ok ? R.p[3] : z, f);
#pragma unroll
      for (int e = 0; e < 8; ++e) k[8 + e] = f[e];
      unpack8(ok ? R.p[4] : z, f);
#pragma unroll
      for (int e = 0; e < 8; ++e) v[e] = f[e];
      unpack8(ok ? R.p[5] : z, f);
#pragma unroll
      for (int e = 0; e < 8; ++e) v[8 + e] = f[e]; }
    LDSYNC();
    gdn_raw_load(F, R, ns, nc, nh, tid);
    u32x4 qd0, qd1; u32x2 qks[2];
    { const float Gt = GS[t], be = GS[64 + t], gl = GS[63], eG = __expf(Gt), kb = be * eG, kd = __expf(gl - Gt);
      float f0[8], f1[8];
#pragma unroll
      for (int e = 0; e < 8; ++e) { f0[e] = k[e]; f1[e] = k[8 + e]; }
      *(LAS u32x4*)(KTm + o128(t, 16 * dg)) = pack8(f0); *(LAS u32x4*)(KTm + o128(t, 16 * dg + 8)) = pack8(f1);
#pragma unroll
      for (int e = 0; e < 8; ++e) { f0[e] = q[e]; f1[e] = q[8 + e]; }
      *(LAS u32x4*)(QTm + o128(t, 16 * dg)) = pack8(f0); *(LAS u32x4*)(QTm + o128(t, 16 * dg + 8)) = pack8(f1);
#pragma unroll
      for (int e = 0; e < 8; ++e) { f0[e] = q[e] * eG; f1[e] = q[8 + e] * eG; }
      qd0 = pack8(f0); qd1 = pack8(f1);
#pragma unroll
      for (int e = 0; e < 16; ++e) { const int oc = o64(16 * dg + e, t); KBT[oc] = bf1(k[e] * kb); VBT[oc] = bf1(v[e] * be); KDT[oc] = bf1(k[e] * kd); if ((e & 3) == 3) __builtin_amdgcn_sched_barrier(0); } }
    LDSYNC();
    f32x4 pacc[2], pacc2[2];
    { f32x4 n[2] = {(f32x4){0.f, 0.f, 0.f, 0.f}, (f32x4){0.f, 0.f, 0.f, 0.f}}, n2[2] = {(f32x4){0.f, 0.f, 0.f, 0.f}, (f32x4){0.f, 0.f, 0.f, 0.f}}, qk[2] = {(f32x4){0.f, 0.f, 0.f, 0.f}, (f32x4){0.f, 0.f, 0.f, 0.f}};
      bmm_dual<4, 2>(KTm, L128, KTm, L128, mt, nt0, lane, n, n2);
      bmm_acc<4, 2, false>(QTm, L128, KTm, L128, mt, nt0, lane, qk);
#pragma unroll
      for (int j = 0; j < 2; ++j) { const int m = 16 * mt + x, nn = 16 * (nt0 + j) + 4 * g, r0 = 16 * mt + 4 * g, cc = 16 * (nt0 + j) + x; const float Gi = GS[m], bi = GS[64 + m], Gc = GS[cc];
#pragma unroll
          for (int e = 0; e < 4; ++e) { const float dec = __expf(fminf(Gi - GS[nn + e], 0.f));
              n[j][e] = (nn + e < m) ? -bi * n[j][e] * dec : 0.f; qk[j][e] = (nn + e <= m) ? qk[j][e] * dec : 0.f;
              pacc[j][e] = n[j][e] + ((nn + e) == m ? 1.f : 0.f);
              const float dec2 = __expf(fminf(GS[r0 + e] - Gc, 0.f));
              n2[j][e] = (cc < r0 + e) ? -GS[64 + r0 + e] * n2[j][e] * dec2 : 0.f; pacc2[j][e] = n2[j][e] + (cc == (r0 + e) ? 1.f : 0.f); }
          *(LAS u32x2*)(Qr0 + o64(m, nn)) = pack4(n[j]); *(LAS u32x2*)(Qt0 + o64(cc, r0)) = pack4(n2[j]); *(LAS u32x2*)(Pr0 + o64(cc, r0)) = pack4(pacc2[j]);
          qks[j] = pack4(qk[j]); } }
    LDSYNC();
    lbf X = neumann64(Qr0, Qt0, Pr0, Qr1, Qt1, Pr1, pacc, pacc2, mt, nt0, lane);
#pragma unroll
    for (int i = 0; i < 6; ++i) asm volatile("" : "+v"(R.p[i]));
    asm volatile("" : "+v"(R.ga), "+v"(R.gb));
    *(u32x4*)((bf16_t*)(blk + GI_Q) + t * 128 + 16 * dg) = qd0; *(u32x4*)((bf16_t*)(blk + GI_Q) + t * 128 + 16 * dg + 8) = qd1;
#pragma unroll
    for (int j = 0; j < 2; ++j) *(u32x2*)((bf16_t*)(blk + GI_QK) + (16 * mt + x) * 64 + 16 * (nt0 + j) + 4 * g) = qks[j];
    { const int nt4 = 4 * (wave >> 2);
      f32x4 a[4] = {(f32x4){0.f, 0.f, 0.f, 0.f}, (f32x4){0.f, 0.f, 0.f, 0.f}, (f32x4){0.f, 0.f, 0.f, 0.f}, (f32x4){0.f, 0.f, 0.f, 0.f}}, b[4] = {(f32x4){0.f, 0.f, 0.f, 0.f}, (f32x4){0.f, 0.f, 0.f, 0.f}, (f32x4){0.f, 0.f, 0.f, 0.f}, (f32x4){0.f, 0.f, 0.f, 0.f}};
      bmm_acc<2, 4, false, false, true>(X, L64, KBT, L64, mt, nt4, lane, a);
      bmm_acc<2, 4, true, false, true>(X, L64, VBT, L64, mt, nt4, lane, b);
#pragma unroll
      for (int j = 0; j < 4; ++j) { a[j] = -a[j];
          *(u32x2*)((bf16_t*)(blk + GI_W) + (16 * mt + x) * 128 + 16 * (nt4 + j) + 4 * g) = pack4(a[j]);
          *(u32x2*)((bf16_t*)(blk + GI_UT) + (16 * (nt4 + j) + x) * 64 + 16 * mt + 4 * g) = pack4(b[j]); } }
    { const int row = tid >> 2, c16 = (tid & 3) * 16;
      *(u32x4*)((bf16_t*)(blk + GI_KT) + row * 64 + c16) = *(const LAS u32x4*)(KDT + o64(row, c16)); *(u32x4*)((bf16_t*)(blk + GI_KT) + row * 64 + c16 + 8) = *(const LAS u32x4*)(KDT + o64(row, c16 + 8)); }
    LDSYNC();
}
DI void ck_decode(int ck, int& s, int& c) { if (ck < 256) { s = ck >> 6; c = ck & 63; } else { s = 4 + (ck - 256); c = 0; } }
DI void ph_cprep_gdn(Frame& F) { const int it0 = (F.bid + (F.G >> 1)) % F.G; GdnRaw R;
    if (it0 < 2112) { int s, c; ck_decode(it0 >> 3, s, c); gdn_raw_load(F, R, s, c, it0 & 7, F.tid); }
    for (int it = it0; it < 2112; it += F.G) { int s, c, ns, nc; ck_decode(it >> 3, s, c); const int nit = it + F.G < 2112 ? it + F.G : it; ck_decode(nit >> 3, ns, nc);
        gdn_cprep_item(F, s, c, it & 7, R, ns, nc, nit & 7); } }
DI void ph_cprep_rwkv(Frame& F) {
    LAS float* PAR = (LAS float*)(F.lds + 14 * TILE64) + 512 + 64; int cur_h = -1; u32x4 raw[7];
    if (F.bid < 4224) { int s, c; ck_decode(F.bid >> 4, s, c); rwkv_raw_load(F, raw, s, c, F.bid & 15, F.tid); }
    for (int it = F.bid; it < 4224; it += F.G) { int s, c, ns, nc; ck_decode(it >> 4, s, c); const int h = it & 15, nit = it + F.G < 4224 ? it + F.G : it; ck_decode(nit >> 4, ns, nc);
        if (h != cur_h) { __syncthreads();
            if (F.tid < 320) { const KIn in{}; const int p = F.tid >> 6, ch = 64 * h + (F.tid & 63); PAR[F.tid] = (p == 0 ? in[15] : p == 1 ? in[17] : p == 2 ? in[20] : p == 3 ? in[21] : in[22])[ch]; }
            { const bf16_t* WL = (const bf16_t*)(F.ws + C_WL2T);
#pragma unroll
              for (int i = 0; i < 3; ++i) { const int p = F.tid + 512 * i, mtx = p >= 768, q = p - 768 * mtx, row = q / 12, pc = q - 12 * row;
                  *(LAS u32x4*)((lbf)(F.lds + LORA_W_OFF + mtx * TILE128) + o128(row, 8 * pc)) = *(const u32x4*)(WL + (size_t)(1024 * mtx + 64 * h + row) * 256 + 96 * mtx + 8 * pc); } }
            __syncthreads();
            if (cur_h >= 0) rwkv_raw_load(F, raw, s, c, h, F.tid);
            cur_h = h; }
        rwkv_cprep_item(F, s, c, h, raw, ns, nc); } }

DI u32x4 frag_gload(const bf16_t* base, int ld, int lane) { return *(const u32x4*)(base + (size_t)(lane >> 2) * ld + 8 * (lane & 3)); }
DI s16x8 frag_gperm(const u32x4 w, int lane) { const int src = (4 * (lane & 15) + (lane >> 4)) * 4; u32x4 p;
#pragma unroll
    for (int e = 0; e < 4; ++e) p[e] = (unsigned)__builtin_amdgcn_ds_bpermute(src, (int)w[e]);
    return __builtin_bit_cast(s16x8, p); }
DI u32x2 quad_gload(const bf16_t* base, int ld, int lane) { return *(const u32x2*)(base + (size_t)(lane >> 2) * ld + 4 * (lane & 3)); }
DI u32x2 quad_gperm(const u32x2 w, int lane) { const int src = (4 * (lane & 15) + (lane >> 4)) * 4; u32x2 p; p.x = (unsigned)__builtin_amdgcn_ds_bpermute(src, (int)w.x); p.y = (unsigned)__builtin_amdgcn_ds_bpermute(src, (int)w.y); return p; }
DI s16x8 frag_gather(const bf16_t* base  , int ld, int lane) {
    const u32x4 w = *(const u32x4*)(base + (size_t)(lane >> 2) * ld + 8 * (lane & 3)); const int src = (4 * (lane & 15) + (lane >> 4)) * 4; u32x4 p;
#pragma unroll
    for (int e = 0; e < 4; ++e) p[e] = (unsigned)__builtin_amdgcn_ds_bpermute(src, (int)w[e]);
    return __builtin_bit_cast(s16x8, p);
}
DI u32x2 quad_gather(const bf16_t* base  , int ld, int lane) {
    const u32x2 w = *(const u32x2*)(base + (size_t)(lane >> 2) * ld + 4 * (lane & 3)); const int src = (4 * (lane & 15) + (lane >> 4)) * 4; u32x2 p;
    p.x = (unsigned)__builtin_amdgcn_ds_bpermute(src, (int)w.x); p.y = (unsigned)__builtin_amdgcn_ds_bpermute(src, (int)w.y); return p;
}
DI void rwkv_sample_wave(Frame& F, int s, int h, int vq, LAS unsigned char* wl) {
    const int lane = F.lane, x = lane & 15, g = lane >> 4, mb = seq_base(s); lbf Sb = (lbf)wl;
    const RwMat G = rw_mats(F.ws, s, 0, h); bf16_t* YR = (bf16_t*)(F.ws + WS_YRAW);
    u32x4 fm[4][2], fr[2][2]; u32x2 ds[4], yl[2];
#pragma unroll
    for (int j = 0; j < 4; ++j) { fm[j][0] = frag_gload(G.p[0] + (size_t)(16 * j) * G.ld, G.ld, lane); fm[j][1] = frag_gload(G.p[0] + (size_t)(16 * j) * G.ld + 32, G.ld, lane);
        ds[j] = quad_gload(G.p[2] + (size_t)(16 * vq) * G.ld + 16 * j, G.ld, lane); }
#pragma unroll
    for (int j = 0; j < 2; ++j) { fr[j][0] = frag_gload(G.p[1] + (size_t)(16 * j) * G.ld, G.ld, lane); fr[j][1] = frag_gload(G.p[1] + (size_t)(16 * j) * G.ld + 32, G.ld, lane);
        yl[j] = quad_gload(G.p[3] + (size_t)(16 * j) * G.ld + 16 * vq, G.ld, lane); }
    f32x4 S[4];
    { const float* st = KIn{}[6] + ((size_t)((s - 4) * 16 + h) * 64 + 16 * vq + x) * 64;
#pragma unroll
      for (int j = 0; j < 4; ++j) S[j] = *(const f32x4*)(st + 16 * j + 4 * g); }
#pragma unroll
    for (int j = 0; j < 4; ++j) *(LAS u32x2*)(Sb + o64(x, 16 * j + 4 * g)) = pack4(S[j]);
    asm volatile("s_waitcnt lgkmcnt(0)" ::: "memory");
    const s16x8 s0 = *(const LAS s16x8*)(Sb + o64(x, 8 * g)), s1 = *(const LAS s16x8*)(Sb + o64(x, 32 + 8 * g));
    asm volatile("s_waitcnt lgkmcnt(0)" ::: "memory");
    float* so = F.out + O_SRS + ((size_t)((s - 4) * 16 + h) * 64 + 16 * vq + x) * 64;
#pragma unroll
    for (int j = 0; j < 4; ++j) { f32x4 n = unpack4(quad_gperm(ds[j], lane));
        n = __builtin_amdgcn_mfma_f32_16x16x32_bf16(frag_gperm(fm[j][0], lane), s0, n, 0, 0, 0); n = __builtin_amdgcn_mfma_f32_16x16x32_bf16(frag_gperm(fm[j][1], lane), s1, n, 0, 0, 0);
        *(f32x4*)(so + 16 * j + 4 * g) = n; }
#pragma unroll
    for (int j = 0; j < 2; ++j) { f32x4 y = unpack4(quad_gperm(yl[j], lane));
        y = __builtin_amdgcn_mfma_f32_16x16x32_bf16(s0, frag_gperm(fr[j][0], lane), y, 0, 0, 0); y = __builtin_amdgcn_mfma_f32_16x16x32_bf16(s1, frag_gperm(fr[j][1], lane), y, 0, 0, 0);
        *(u32x2*)(YR + (size_t)(mb + 16 * j + x) * 1024 + 64 * h + 16 * vq + 4 * g) = pack4(y); }
}
DI void rwkv_cscan_block(Frame& F, int s, int h) {
    const int tid = F.tid, lane = F.lane, wave = F.wave, x = lane & 15, g = lane >> 4;
    LAS unsigned char* L = F.lds;
    constexpr int BUFR = 4 * TILE64;
    __syncthreads();
    if (wave < 4) {
        const int vq = wave; lbf Sb = (lbf)(L + 2 * BUFR + wave * (16 * L64 * 2));
        f32x4 S[4];
#pragma unroll
        for (int j = 0; j < 4; ++j) S[j] = (f32x4){0.f, 0.f, 0.f, 0.f};
        bf16_t* yr = (bf16_t*)(F.ws + WS_YRAW) + (size_t)(s * 4096 + x) * 1024 + 64 * h + 16 * vq + 4 * g;
        LDSYNC();
        for (int c = 0; c < 64; ++c) {
            LAS unsigned char* B = L + (c & 1) * BUFR; lbf MT = (lbf)B, DS = (lbf)(B + TILE64), RQ = (lbf)(B + 2 * TILE64), YL = (lbf)(B + 3 * TILE64);
#pragma unroll
            for (int j = 0; j < 4; ++j) *(LAS u32x2*)(Sb + o64(x, 16 * j + 4 * g)) = pack4(S[j]);
            asm volatile("s_waitcnt lgkmcnt(0)" ::: "memory");
            const s16x8 s0 = *(const LAS s16x8*)(Sb + o64(x, 8 * g)), s1 = *(const LAS s16x8*)(Sb + o64(x, 32 + 8 * g));
#pragma unroll
            for (int j = 0; j < 4; ++j) {
                S[j] = unpack4(*(const LAS u32x2*)(DS + o64(16 * vq + x, 16 * j + 4 * g)));
                S[j] = __builtin_amdgcn_mfma_f32_16x16x32_bf16(*(const LAS s16x8*)(MT + o64(16 * j + x, 8 * g)), s0, S[j], 0, 0, 0);
                S[j] = __builtin_amdgcn_mfma_f32_16x16x32_bf16(*(const LAS s16x8*)(MT + o64(16 * j + x, 32 + 8 * g)), s1, S[j], 0, 0, 0); }
#pragma unroll
            for (int j = 0; j < 4; ++j) { f32x4 y = unpack4(*(const LAS u32x2*)(YL + o64(16 * j + x, 16 * vq + 4 * g)));
                y = __builtin_amdgcn_mfma_f32_16x16x32_bf16(s0, *(const LAS s16x8*)(RQ + o64(16 * j + x, 8 * g)), y, 0, 0, 0);
                y = __builtin_amdgcn_mfma_f32_16x16x32_bf16(s1, *(const LAS s16x8*)(RQ + o64(16 * j + x, 32 + 8 * g)), y, 0, 0, 0);
                *(u32x2*)(yr + (size_t)(64 * c + 16 * j) * 1024) = pack4(y); }
            LDSYNC();
        }
        float* so = F.out + O_SRP + ((size_t)(s * 16 + h) * 64 + 16 * vq + x) * 64;
#pragma unroll
        for (int j = 0; j < 4; ++j) *(f32x4*)(so + 16 * j + 4 * g) = S[j];
    } else {
        const int ht = tid - 256;
        const unsigned char* gsrc[8]; int lo[8];
#pragma unroll
        for (int i = 0; i < 8; ++i) { const int p = ht + 256 * i, q = p & 511, row = q >> 3, pc = q & 7, m = i >> 1;
            gsrc[i] = F.ws + WS_RWKS + (m == 0 ? 0 : m == 1 ? 3 * SLOT : m == 2 ? SLOT : 4 * SLOT) + ((size_t)(s * 4096 + row) * 1024 + 64 * h + 8 * pc) * 2; lo[i] = m * TILE64 + o64(row, 8 * pc) * 2; }
        u32x4 R0[8], R1[8], R2[8];
#define H_LD(RR, cc) do { const size_t co_ = (size_t)((cc) < 64 ? (cc) : 63) * 131072; \
_Pragma("unroll") for (int i = 0; i < 8; ++i) RR[i] = *(const u32x4*)(gsrc[i] + co_); } while (0)
#define H_ST(RR, k) do { LAS unsigned char* B_ = L + ((k) & 1) * BUFR; \
_Pragma("unroll") for (int i = 0; i < 8; ++i) *(LAS u32x4*)(B_ + lo[i]) = RR[i]; } while (0)
        H_LD(R0, 0); H_LD(R1, 1); H_LD(R2, 2);
        H_ST(R0, 0); H_LD(R0, 3);
        LDSYNC();
        for (int k = 1; k < 64; k += 3) {
            H_ST(R1, k); H_LD(R1, k + 3); LDSYNC();
            H_ST(R2, k + 1); H_LD(R2, k + 4); LDSYNC();
            H_ST(R0, k + 2); H_LD(R0, k + 5); LDSYNC();
        }
        LDSYNC();
#undef H_LD
#undef H_ST
    }
}
template <int NCH>
DI void gdn_cscan_item(Frame& F, int s, int h, int dq) {
    const int tid = F.tid, lane = F.lane, wave = F.wave, x = lane & 15, g = lane >> 4, nvalid = NCH > 1 ? 64 : 32, mb = seq_base(s);
    LAS unsigned char* L = F.lds;
    constexpr int O_QD = TILE128, O_KDT = 2 * TILE128, O_QK = 2 * TILE128 + TILE128T, O_UT = O_QK + TILE64, BUF = O_UT + 32 * L64 * 2  , WSZ = 16 * L128 * 2 + 16 * L64 * 2  ;
    static_assert(2 * BUF + 2 * WSZ <= LDS_BYTES, "LDS");
    __syncthreads();
    if (wave < 2) {
        const int dvl = 16 * wave, dv0 = 32 * dq + dvl;
        lbf ST = (lbf)(L + 2 * BUF + wave * WSZ), VN = ST + 16 * L128;
        bf16_t* OR = (bf16_t*)(F.ws + WS_ORAW);
        f32x4 S[8];
        if (NCH == 1) { const float* st = KIn{}[4] + ((size_t)((s - 4) * 8 + h) * 128) * 128 + dv0 + x;
#pragma unroll
            for (int i = 0; i < 8; ++i)
#pragma unroll
                for (int e = 0; e < 4; ++e) S[i][e] = st[(size_t)(16 * i + 4 * g + e) * 128]; }
        else {
#pragma unroll
            for (int i = 0; i < 8; ++i) S[i] = (f32x4){0.f, 0.f, 0.f, 0.f}; }
        const float egl_all = ((const float*)(F.ws + C_EGL))[gdn_ch_index(s, lane < NCH ? lane : NCH - 1, h)];
        LDSYNC();
        for (int c = 0; c < NCH; ++c) {
            LAS unsigned char* B = L + (c & 1) * BUF;
            lbf WN = (lbf)B, QD = (lbf)(B + O_QD), KDT = (lbf)(B + O_KDT), QK = (lbf)(B + O_QK), UT = (lbf)(B + O_UT);
            f32x4 vn[4];
#pragma unroll
            for (int i = 0; i < 8; ++i) *(LAS u32x2*)(ST + o128(x, 16 * i + 4 * g)) = pack4(S[i]);
#pragma unroll
            for (int i = 0; i < 4; ++i) vn[i] = unpack4(*(const LAS u32x2*)(UT + o64(dvl + x, 16 * i + 4 * g)));
            const float egl = __builtin_bit_cast(float, __builtin_amdgcn_readlane(__builtin_bit_cast(int, egl_all), c));
            asm volatile("s_waitcnt lgkmcnt(0)" ::: "memory");
            s16x8 sf[4];
#pragma unroll
            for (int ks = 0; ks < 4; ++ks) sf[ks] = *(const LAS s16x8*)(ST + o128(x, 32 * ks + 8 * g));
#pragma unroll
            for (int i = 0; i < 4; ++i)
#pragma unroll
                for (int ks = 0; ks < 4; ++ks) vn[i] = __builtin_amdgcn_mfma_f32_16x16x32_bf16(*(const LAS s16x8*)(WN + o128(16 * i + x, 32 * ks + 8 * g)), sf[ks], vn[i], 0, 0, 0);
#pragma unroll
            for (int i = 0; i < 4; ++i) *(LAS u32x2*)(VN + o64(x, 16 * i + 4 * g)) = pack4(vn[i]);
            asm volatile("s_waitcnt lgkmcnt(0)" ::: "memory");
            const s16x8 v0 = *(const LAS s16x8*)(VN + o64(x, 8 * g)), v1 = *(const LAS s16x8*)(VN + o64(x, 32 + 8 * g));
#pragma unroll
            for (int i = 0; i < 4; ++i) { f32x4 o = (f32x4){0.f, 0.f, 0.f, 0.f};
#pragma unroll
                for (int ks = 0; ks < 4; ++ks) o = __builtin_amdgcn_mfma_f32_16x16x32_bf16(sf[ks], *(const LAS s16x8*)(QD + o128(16 * i + x, 32 * ks + 8 * g)), o, 0, 0, 0);
                o = __builtin_amdgcn_mfma_f32_16x16x32_bf16(v0, *(const LAS s16x8*)(QK + o64(16 * i + x, 8 * g)), o, 0, 0, 0);
                o = __builtin_amdgcn_mfma_f32_16x16x32_bf16(v1, *(const LAS s16x8*)(QK + o64(16 * i + x, 32 + 8 * g)), o, 0, 0, 0);
                const int tt = 16 * i + x; if (tt < nvalid) *(u32x2*)(OR + (size_t)(mb + 64 * c + tt) * 1024 + 128 * h + dv0 + 4 * g) = pack4(o); }
#pragma unroll
            for (int i = 0; i < 8; ++i) { S[i] = S[i] * egl;
                S[i] = __builtin_amdgcn_mfma_f32_16x16x32_bf16(*(const LAS s16x8*)(KDT + o64(16 * i + x, 8 * g)), v0, S[i], 0, 0, 0);
                S[i] = __builtin_amdgcn_mfma_f32_16x16x32_bf16(*(const LAS s16x8*)(KDT + o64(16 * i + x, 32 + 8 * g)), v1, S[i], 0, 0, 0); }
            LDSYNC();
        }
        float* so = F.out + (NCH > 1 ? O_SGP + ((size_t)(s * 8 + h) * 128) * 128 : O_SGS + ((size_t)((s - 4) * 8 + h) * 128) * 128) + dv0 + x;
#pragma unroll
        for (int i = 0; i < 8; ++i)
#pragma unroll
            for (int e = 0; e < 4; ++e) so[(size_t)(16 * i + 4 * g + e) * 128] = S[i][e];
    } else {
        const int ht = tid - 128; int so[10], lo[10];
#pragma unroll
        for (int i = 0; i < 10; ++i) { const int p = ht + 384 * i;
            if (p < 2048) { const int q = p & 1023; so[i] = p * 16; lo[i] = (p >> 10) * O_QD + o128(q >> 4, (q & 15) * 8) * 2; }
            else if (p < 3072) { const int q = p - 2048; so[i] = p * 16; lo[i] = O_KDT + o64(q >> 3, (q & 7) * 8) * 2; }
            else if (p < 3584) { const int q = p - 3072; so[i] = GI_QK + q * 16; lo[i] = O_QK + o64(q >> 3, (q & 7) * 8) * 2; }
            else { const int q = p - 3584; so[i] = GI_UT + dq * 4096 + q * 16; lo[i] = O_UT + o64(q >> 3, (q & 7) * 8) * 2; } }
        const unsigned char* gb = F.ws + WS_GDNI;
        u32x4 R0[10], R1[10], R2[10];
#define H_LD(R, cc) do { const int cc_ = (cc) < NCH ? (cc) : NCH - 1; const unsigned char* b_ = gb + (size_t)gdn_ch_index(s, cc_, h) * GDNI_BLK; \
_Pragma("unroll") for (int i = 0; i < 10; ++i) R[i] = *(const u32x4*)(b_ + so[i]); } while (0)
#define H_ST(R, k) do { LAS unsigned char* B_ = L + ((k) & 1) * BUF; \
_Pragma("unroll") for (int i = 0; i < 10; ++i) *(LAS u32x4*)(B_ + lo[i]) = R[i]; } while (0)
        H_LD(R0, 0);
        if (NCH > 1) { H_LD(R1, 1); H_LD(R2, 2); }
        H_ST(R0, 0);
        if (NCH > 1) H_LD(R0, 3);
        LDSYNC();
        if (NCH > 1) {
            for (int k = 1; k < NCH; k += 3) {
                H_ST(R1, k); H_LD(R1, k + 3); LDSYNC();
                H_ST(R2, k + 1); H_LD(R2, k + 4); LDSYNC();
                H_ST(R0, k + 2); H_LD(R0, k + 5); LDSYNC();
            }
        }
        LDSYNC();
#undef H_LD
#undef H_ST
    }
}
DI void ph_pb(Frame& F) {
    bf16_t* PB = (bf16_t*)(F.ws + WS_GTAIL + GT_PB);
    for (int i = F.bid * 512 + F.tid; i < M * 32; i += F.G * 512) { const int m = i >> 5, c = (i & 31) * 8; const float* src = m < MP ? KIn{}[2] + (size_t)m * 256 + c : KIn{}[3] + (size_t)(m - MP) * 256 + c; float f[8]; ld8f(src, f); *(u32x4*)(PB + (size_t)m * 256 + c) = pack8(f); }
}
DI void ph_cscan(Frame& F) {
    if (F.G == 256) {
        if (F.bid < 128) { const int i = F.bid; gdn_cscan_item<64>(F, (i & 31) >> 3, i & 7, i >> 5); }
        else { Frame F2 = F; F2.bid = F.bid - 128; F2.G = 128; Frame F3 = F; F3.bid = (F.bid - 128) & 63; F3.G = 64;
            if (F.bid < 192) { const int i = F.bid - 128; rwkv_cscan_block(F, i >> 4, i & 15); { const int i2 = 192 + i; gdn_cscan_item<1>(F, 4 + (i2 >> 5), (i2 >> 2) & 7, i2 & 3); } }
            else { const int b_ = F.bid - 192; { const int j = b_ * 8 + F.wave; rwkv_sample_wave(F, 4 + (j >> 6), (j >> 2) & 15, j & 3, F.lds + F.wave * (16 * L64 * 2)); }
                   for (int i = b_; i < 192; i += 64) gdn_cscan_item<1>(F, 4 + (i >> 5), (i >> 2) & 7, i & 3); }
            __syncthreads();
            { const FStore f_{nullptr, (bf16_t*)(F.ws + WS_RWKS + 5 * SLOT), 1024}; const bf16_t* A_ = (const bf16_t*)(F.dob + DO_AG); const bf16_t* B_ = (const bf16_t*)(F.ws + C_G2T);
              run_gemm(F2, A_, B_, MP, 1024, 256, f_); __syncthreads(); sample_gemm(F2, A_, B_, 1024, 256, f_, 0); __syncthreads(); }
            if (F.bid >= 192) { conv_range(F3, 5, 10); ph_pb(F3); }
        }
    } else {
        for (int i = F.bid; i < 128; i += F.G) gdn_cscan_item<64>(F, (i & 31) >> 3, i & 7, i >> 5);
        for (int i = F.bid; i < 64; i += F.G) rwkv_cscan_block(F, i >> 4, i & 15);
        __syncthreads();
        for (int j = F.bid * 8 + F.wave; j < 512; j += F.G * 8) rwkv_sample_wave(F, 4 + (j >> 6), (j >> 2) & 15, j & 3, F.lds + F.wave * (16 * L64 * 2));
        for (int i = F.bid; i < 256; i += F.G) gdn_cscan_item<1>(F, 4 + (i >> 5), (i >> 2) & 7, i & 3);
        __syncthreads();
        { const FStore f_{nullptr, (bf16_t*)(F.ws + WS_RWKS + 5 * SLOT), 1024}; const bf16_t* A_ = (const bf16_t*)(F.dob + DO_AG); const bf16_t* B_ = (const bf16_t*)(F.ws + C_G2T);
          run_gemm(F, A_, B_, MP, 1024, 256, f_); __syncthreads(); sample_gemm(F, A_, B_, 1024, 256, f_, 0); __syncthreads(); }
        conv_range(F, 5, 10); ph_pb(F);
    }
}
DI void ph_post(Frame& F) {
    const KIn in{}; const int c8 = (F.tid & 127) * 8;
    const bf16_t* YR = (const bf16_t*)(F.ws + WS_YRAW); const bf16_t* ORW = (const bf16_t*)(F.ws + WS_ORAW); const bf16_t* S2 = (const bf16_t*)(F.ws + WS_RWKS + 2 * SLOT);
    bf16_t* OB = (bf16_t*)(F.ws + WS_RWKS + 3 * SLOT); const bf16_t* GATE = (const bf16_t*)(F.ws + WS_RWKS + 5 * SLOT); float* rso = (float*)(F.ws + C_RSO); const float* BON = (const float*)(F.ws + C_BONUS);
    float lg[8], lb[8]; ld8f(in[23] + c8, lg); ld8f(in[24] + c8, lb);
#define POST_ROW(m_, ry, rv, rg, ro, sb_) do { const size_t o_ = (size_t)(m_) * 1024 + c8; float y[8], v[8], g[8], ob[8]; unpack8(ry, y); unpack8(rv, v); unpack8(rg, g); float sm = 0.f; \
        _Pragma("unroll") for (int e = 0; e < 8; ++e) sm += y[e]; \
        sm = red8(sm) * (1.f / 64.f); float sv = 0.f; \
        _Pragma("unroll") for (int e = 0; e < 8; ++e) { y[e] -= sm; sv += y[e] * y[e]; } \
        sv = red8(sv) * (1.f / 64.f); const float rstd = rsqrtf(sv + 64e-5f); \
        _Pragma("unroll") for (int e = 0; e < 8; ++e) ob[e] = (y[e] * rstd * lg[e] + lb[e] + (sb_) * v[e]) * g[e]; \
        *(u32x4*)(OB + o_) = pack8(ob); \
        float oa[8]; unpack8(ro, oa); float so = 0.f; \
        _Pragma("unroll") for (int e = 0; e < 8; ++e) so += oa[e] * oa[e]; \
        so = red16(so); if ((F.tid & 15) == 0) rso[(m_) * 8 + (c8 >> 7)] = rsqrtf(so * (1.f / 128.f) + EPS); } while (0)
    const int mstep = F.G * 4;
    for (int m = F.bid * 4 + (F.tid >> 7); m < M; m += 2 * mstep) {
        const int m2 = m + mstep; const bool two = m2 < M; const int mb_ = two ? m2 : m; const size_t oa_ = (size_t)m * 1024 + c8, ob_ = (size_t)mb_ * 1024 + c8;
        const u32x4 y0 = *(const u32x4*)(YR + oa_), v0 = *(const u32x4*)(S2 + oa_), g0 = *(const u32x4*)(GATE + oa_), r0 = *(const u32x4*)(ORW + oa_);
        const u32x4 y1 = *(const u32x4*)(YR + ob_), v1 = *(const u32x4*)(S2 + ob_), g1 = *(const u32x4*)(GATE + ob_), r1 = *(const u32x4*)(ORW + ob_);
        const float sb0 = BON[(size_t)m * 16 + (c8 >> 6)], sb1 = BON[(size_t)mb_ * 16 + (c8 >> 6)];
        POST_ROW(m, y0, v0, g0, r0, sb0);
        if (two) POST_ROW(m2, y1, v1, g1, r1, sb1);
    }
#undef POST_ROW
}
DI void ph_final(Frame& F) {
    const float* ss3 = (const float*)(F.ws + C_SS3); const bf16_t* X3 = (const bf16_t*)(F.ws + WS_RWKS + 2 * SLOT); const int gw = F.bid * 8 + F.wave, NGW = F.G * 8;
    float g[4][8];
    { const float* gf = KIn{}[34];
#pragma unroll
      for (int j = 0; j < 4; ++j) ld8f(gf + 8 * (F.lane + 64 * j), g[j]); }
    for (int m = gw; m < M; m += 2 * NGW) { const int m2 = m + NGW; const bool two = m2 < M; const int mb_ = two ? m2 : m;
        u32x4 ra[4], rb[4];
#pragma unroll
        for (int j = 0; j < 4; ++j) { ra[j] = *(const u32x4*)(X3 + (size_t)m * DM + 8 * (F.lane + 64 * j)); rb[j] = *(const u32x4*)(X3 + (size_t)mb_ * DM + 8 * (F.lane + 64 * j)); }
        const float rsa = rsqrtf(ss3[m] * (1.f / DM) + EPS), rsb = rsqrtf(ss3[mb_] * (1.f / DM) + EPS);
#pragma unroll
        for (int j = 0; j < 4; ++j) { float v[8]; unpack8(ra[j], v);
#pragma unroll
            for (int e = 0; e < 8; ++e) v[e] = v[e] * rsa * g[j][e];
            st8f(F.out + (size_t)m * DM + 8 * (F.lane + 64 * j), v); }
        if (two) {
#pragma unroll
            for (int j = 0; j < 4; ++j) { float v[8]; unpack8(rb[j], v);
#pragma unroll
                for (int e = 0; e < 8; ++e) v[e] = v[e] * rsb * g[j][e];
                st8f(F.out + (size_t)m2 * DM + 8 * (F.lane + 64 * j), v); } }
    }
}

typedef __attribute__((address_space(1))) unsigned gu32;
#define XB_TMO      128
#define XB_XCNT(j)  (256  + 64 * (j))
#define XB_XSUB(j)  (1280 + 64 * (j))
#define XB_XGEN(j)  (2304 + 64 * (j))
#define XB_TOP      3328
#define XB_TOPGEN   3392
#define XCD_BAR_WORDS 3456
#define XB_SPIN_CAP (1u << 18)

__device__ __forceinline__ unsigned xb_ld(unsigned* p)              { return __hip_atomic_load(p, __ATOMIC_RELAXED, __HIP_MEMORY_SCOPE_AGENT); }
__device__ __forceinline__ unsigned xb_add(unsigned* p, unsigned v) { return __hip_atomic_fetch_add(p, v, __ATOMIC_RELAXED, __HIP_MEMORY_SCOPE_AGENT); }
__device__ __forceinline__ unsigned xb_xcc_id() { return (unsigned)__builtin_amdgcn_s_getreg((3 << 11) | 20) & 0xFu; }
#define XB_SPIN(cond, bar) do { unsigned _sp = 0; while (cond) { __builtin_amdgcn_s_sleep(1); \
    if ((++_sp & 255u) == 0u) { if (xb_ld(&(bar)[XB_TMO])) break; if (_sp > XB_SPIN_CAP) { atomicAdd(&(bar)[XB_TMO], 1u); break; } } } } while (0)

struct XcdBarrier {
    unsigned* bar; unsigned x;
    volatile LAS unsigned* st;
};

__device__ __forceinline__ XcdBarrier xcd_barrier_post(unsigned* bar, volatile LAS unsigned* st, int tid) {
    XcdBarrier b; b.bar = bar; b.x = xb_xcc_id(); b.st = st;
    if (tid == 0) (void)xb_add(&bar[XB_XCNT(b.x)], 1u);
    return b;
}
__device__ __forceinline__ void xcd_barrier_complete(unsigned* bar, unsigned x, unsigned& nloc, unsigned& nx) {
    const unsigned G = gridDim.x * gridDim.y * gridDim.z;
    unsigned sum, cnt, mine, sp = 0u;
    for (;;) {
        sum = 0u; cnt = 0u; mine = 0u;
#pragma unroll
        for (unsigned j = 0; j < 16; ++j) { const unsigned c = xb_ld(&bar[XB_XCNT(j)]); sum += c; cnt += (c > 0u) ? 1u : 0u; mine = (j == x) ? c : mine; }
        if (sum == G) break;
        __builtin_amdgcn_s_sleep(1);
        if ((++sp & 255u) == 0u) { if (xb_ld(&bar[XB_TMO])) break; if (sp > XB_SPIN_CAP) { atomicAdd(&bar[XB_TMO], 1u); break; } }
    }
    nloc = mine > 0u ? mine : 1u; nx = cnt > 0u ? cnt : 1u;
}

__device__ __forceinline__ void xcd_barrier(const XcdBarrier& b, int tid) {
    asm volatile("s_waitcnt vmcnt(0)" ::: "memory");
    __syncthreads();
    if (tid == 0) {
        unsigned* bar = b.bar;
        __builtin_amdgcn_s_waitcnt(0);
        unsigned nloc = b.st[0], nx = b.st[1];
        if (nloc == 0u) { xcd_barrier_complete(bar, b.x, nloc, nx); b.st[0] = nloc; b.st[1] = nx; }
        const unsigned old = xb_add(&bar[XB_XSUB(b.x)], 1u);
        const unsigned gen = old / nloc;
        if (old + 1u == (gen + 1u) * nloc) {
            __builtin_amdgcn_fence(__ATOMIC_RELEASE, "agent");
            asm volatile("s_waitcnt vmcnt(0)" ::: "memory");
            const unsigned og = xb_add(&bar[XB_TOP], 1u);
            const unsigned tg = og / nx;
            if (og + 1u == (tg + 1u) * nx) xb_add(&bar[XB_TOPGEN], 1u);
            else XB_SPIN(xb_ld(&bar[XB_TOPGEN]) == tg, bar);
            __builtin_amdgcn_fence(__ATOMIC_ACQUIRE, "agent");
            xb_add(&bar[XB_XGEN(b.x)], 1u);
            asm volatile("s_waitcnt vmcnt(0)" ::: "memory");
        } else {
            XB_SPIN(xb_ld(&bar[XB_XGEN(b.x)]) == gen, bar);
            __builtin_amdgcn_fence(__ATOMIC_ACQUIRE, "agent");
            asm volatile("s_waitcnt vmcnt(0)" ::: "memory");
        }
    }
    __syncthreads();
}

constexpr int N_PHASES = 16;
__global__ void __launch_bounds__(512, 2) mk_fwd(Args a) {
    extern __shared__ __attribute__((aligned(16))) unsigned char lds_raw[];
    cg::grid_group grid = cg::this_grid();
    const int wave0 = __builtin_amdgcn_readfirstlane(threadIdx.x >> 6);
    Frame F; F.lds = (LAS unsigned char*)lds_raw; F.tid = threadIdx.x; F.lane = F.tid & 63; F.wave = __builtin_amdgcn_readfirstlane(F.tid >> 6); F.G = gridDim.x; F.bid = blockIdx.x;
    F.out = a.out; F.ws = a.ws; F.dob = (unsigned char*)a.out;
    unsigned char* ws = a.ws; unsigned char* gt = ws + WS_GTAIL; float* nul = nullptr;
    volatile LAS unsigned* bst = (volatile LAS unsigned*)(F.lds + LDS_BYTES - 16);
    if (F.tid < 2) bst[F.tid] = 0u;
    __syncthreads();
    XcdBarrier bar; bar.bar = (unsigned*)ws; bar.x = 0; bar.st = bst;
    if (a.ph_hi - a.ph_lo > 1) bar = xcd_barrier_post((unsigned*)ws, bst, F.tid);
    bf16_t* PROJ = (bf16_t*)(ws + WS_PROJ);
    const int lo = a.ph_lo, hi = a.ph_hi;
    if (lo < 0) grid.sync();
#ifndef PHMASK
#define PHMASK 0xFFFF
#endif
#define IN(k) (((PHMASK >> (k)) & 1) && lo <= (k) && (k) < hi)
#define RG(A_, B_, N_, K_, f_, fb_) do { const bool sf_ = F.G == 256 && ((fb_) == 0 ? (F.bid & 1) != 0 : F.bid >= (fb_)); \
        _Pragma("unroll 1") for (int ps_ = 0; ps_ < 2; ++ps_) { \
            if ((ps_ == 0) == sf_) { sample_gemm_any(F, A_, B_, N_, K_, f_, fb_); REFRESH(); __syncthreads(); } \
            else { run_gemm(F, A_, B_, MP, N_, K_, f_); REFRESH(); __syncthreads(); } } } while (0)
#define REFRESH() do { int t_; asm volatile("v_mbcnt_lo_u32_b32 %0, -1, 0\n\tv_mbcnt_hi_u32_b32 %0, -1, %0\n\tv_lshl_add_u32 %0, %1, 6, %0" : "=&v"(t_) : "s"(wave0)); F.tid = t_; F.lane = t_ & 63; F.wave = __builtin_amdgcn_readfirstlane(t_ >> 6); } while (0)
#define SEAM(k) do { if (IN(k) && IN((k) + 1)) { REFRESH(); xcd_barrier(bar, F.tid); } { int t_; asm volatile("v_mbcnt_lo_u32_b32 %0, -1, 0\n\tv_mbcnt_hi_u32_b32 %0, -1, %0\n\tv_lshl_add_u32 %0, %1, 6, %0" : "=&v"(t_) : "s"(wave0)); F.tid = t_; F.lane = t_ & 63; F.wave = __builtin_amdgcn_readfirstlane(t_ >> 6); } } while (0)
    if (IN(0)) { ph0(F); } SEAM(0);
    if (IN(1)) { { const auto f_ = FStore{nul, PROJ, NAB}; RG((const bf16_t*)(ws + WS_RWKS), (const bf16_t*)(ws + WS_RWKS + 2 * SLOT), NAB, DM, f_, (F.G == 256 ? 128 : 0)); }
                 if (F.G != 256 || F.bid >= 128) { Frame F2 = F; if (F.G == 256) { F2.bid = F.bid - 128; F2.G = 128; } REFRESH(); __syncthreads(); conv_range(F2, 3, 5); } } SEAM(1);
    if (IN(2)) { ph2a(F); } SEAM(2);
    if (IN(5)) { ph_cprep_gdn(F); REFRESH(); ph_cprep_rwkv(F); REFRESH(); if (hi - lo > 1) xcd_barrier(bar, F.tid); REFRESH(); ph_cscan(F); } SEAM(5);
    if (IN(7)) { ph_post(F); } SEAM(7);
    if (IN(8)) { { const auto f_ = FGates{nul, (const bf16_t*)(ws + WS_ORAW), (const float*)(ws + C_RSO), KIn{}[13], (bf16_t*)(ws + WS_RWKS + 2 * SLOT), (bf16_t*)(ws + WS_RWKS), (bf16_t*)(ws + WS_RWKS + 4 * SLOT)}; RG((const bf16_t*)(F.dob + DO_H), (const bf16_t*)(F.dob + DO_WC), NC, DM, f_, 0); } } SEAM(8);
    if (IN(9)) { const bf16_t* OA_ = (const bf16_t*)(ws + WS_RWKS + 2 * SLOT); const bf16_t* OB_ = (const bf16_t*)(ws + WS_RWKS + 3 * SLOT); const bf16_t* GMA_ = (const bf16_t*)(ws + WS_RWKS); const bf16_t* GMB_ = (const bf16_t*)(ws + WS_RWKS + 4 * SLOT);
                 bf16_t* MG_ = (bf16_t*)(ws + WS_PROJ + 136314880);
                 const bool sf9_ = F.G == 256 && (F.bid & 1);
#pragma unroll 1
                 for (int ps_ = 0; ps_ < 2; ++ps_) {
                     if ((ps_ == 0) == sf9_) {
                         { const auto f_ = FUpA{nul, GMA_, (float*)(ws + WS_PROJ)}; sample_gemm(F, OA_, (const bf16_t*)(gt + GT_UPA), DM, 1024, f_, 0); REFRESH(); __syncthreads(); }
                         { const auto f_ = FUpB{nul, GMB_, (const float*)(ws + WS_PROJ), MG_}; sample_gemm(F, OB_, (const bf16_t*)(gt + GT_UPB), DM, 1024, f_, 0); REFRESH(); __syncthreads(); } }
                     else { run_gemm_up2(F, OA_, (const bf16_t*)(gt + GT_UPA), OB_, (const bf16_t*)(gt + GT_UPB), MP, DM, 1024, EpiUp2{GMA_, GMB_, MG_}); REFRESH(); __syncthreads(); } } } SEAM(9);
    if (IN(10)) { const bool cf_ = !(F.G == 256 && (F.bid & 1));
#pragma unroll 1
                 for (int pc_ = 0; pc_ < 2; ++pc_) {
                     if ((pc_ == 0) == cf_) { __syncthreads(); conv_range(F, 10, 12); __syncthreads(); REFRESH(); }
                     else { const auto f_ = FRes{(float*)(ws + C_SS1), KIn{}[0], KIn{}[1], (bf16_t*)(ws + WS_RWKS)}; RG((const bf16_t*)(ws + WS_PROJ + 136314880), (const bf16_t*)(gt + GT_WO), DM, DM, f_, 0); REFRESH(); __syncthreads(); } } } SEAM(10);
    if (IN(11)) { { const auto f_ = FFf1{nul, (const float*)(ws + C_SS1), PROJ}; RG((const bf16_t*)(ws + WS_RWKS), (const bf16_t*)(ws + WS_RWKS + 2 * SLOT), DFF, DM, f_, 0); } } SEAM(11);
    if (IN(12)) { const bool pf_ = F.G == 256 && (F.bid & 2);
#pragma unroll 1
                 for (int pq_ = 0; pq_ < 2; ++pq_) {
                     if ((pq_ == 0) == pf_) { const auto f_ = FStore{nul, (bf16_t*)(ws + WS_RWKS + 4 * SLOT), DM}; RG((const bf16_t*)(gt + GT_PB), (const bf16_t*)(gt + GT_PLE), DM, DPLE, f_, 0); REFRESH(); __syncthreads(); }
                     else { const auto f_ = FRes2{(float*)(ws + C_SS2), (bf16_t*)(ws + WS_RWKS)}; RG(PROJ, (const bf16_t*)(ws + WS_RWKS + 3 * SLOT), DM, DFF, f_, 0); REFRESH(); __syncthreads(); } } } SEAM(12);
    if (IN(14)) { { const auto f_ = FPg{(float*)(ws + C_SS3), (const float*)(ws + C_SS2), (const bf16_t*)(ws + WS_RWKS + 4 * SLOT), (bf16_t*)(ws + WS_RWKS + 2 * SLOT), (const bf16_t*)(ws + WS_RWKS)}; RG((const bf16_t*)(ws + WS_RWKS), (const bf16_t*)(gt + GT_PG), DM, DM, f_, 0); } } SEAM(14);
    if (IN(15)) { ph_final(F); }
#undef IN
#undef SEAM
}

#ifndef MK_MULTI
#define MK_MULTI 0
#endif
extern "C" void kernel_launch(void* const* d_in, const int* in_sizes, int n_in, void* d_out, int out_size, void* d_ws, size_t ws_size, hipStream_t stream) {
    static int grid = 0;
    if (grid == 0) {
        if (n_in != 35 || out_size != (int)O_END || ws_size < WS_NEED) { fprintf(stderr, "kernel_launch: unexpected problem: n_in %d out %d ws %zu (need %zu)\n", n_in, out_size, ws_size, (size_t)WS_NEED); grid = -1; return; }
        int dev = 0, cus = 0, per_cu = 0;
        hipGetDevice(&dev); hipDeviceGetAttribute(&cus, hipDeviceAttributeMultiprocessorCount, dev);
        if (hipFuncSetAttribute((const void*)mk_fwd, hipFuncAttributeMaxDynamicSharedMemorySize, LDS_BYTES) != hipSuccess) { fprintf(stderr, "kernel_launch: hipFuncSetAttribute failed\n"); grid = -1; return; }
        if (hipOccupancyMaxActiveBlocksPerMultiprocessor(&per_cu, (const void*)mk_fwd, 512, LDS_BYTES) != hipSuccess || per_cu < 1) { fprintf(stderr, "kernel_launch: occupancy query says %d\n", per_cu); per_cu = 1; }
        (void)hipGetLastError();
        grid = cus * per_cu; if (grid > 256) grid = 256;
        fprintf(stderr, "kernel_launch: cus %d per_cu %d grid %d ws %zu\n", cus, per_cu, grid, ws_size);
    }
    if (grid < 0) return;
    (void)hipMemsetAsync(d_ws, 0, 65536, stream);
    Args a{};
    for (int i = 0; i < 35; ++i) a.in[i] = (const float*)d_in[i];
    a.out = (float*)d_out; a.ws = (unsigned char*)d_ws;
#if MK_MULTI
    for (int ph = 0; ph < N_PHASES; ++ph) { a.ph_lo = ph; a.ph_hi = ph + 1; hipLaunchKernelGGL(mk_fwd, dim3(grid), dim3(512), LDS_BYTES, stream, a); }
#else
    a.ph_lo = 0; a.ph_hi = N_PHASES; void* args[] = {&a};
    hipError_t e = hipLaunchCooperativeKernel((const void*)mk_fwd, dim3(grid), dim3(512), args, LDS_BYTES, stream);
    if (e != hipSuccess) fprintf(stderr, "kernel_launch: cooperative launch failed: %s (grid %d)\n", hipGetErrorString(e), grid);
#endif
}
```

```cpp
#include <hip/hip_runtime.h>
#include <hip/hip_cooperative_groups.h>
#include <cstdio>
#include <cstdint>
namespace cg = cooperative_groups;
namespace pg8 {
#define PG8_LAS __attribute__((address_space(3)))
typedef unsigned short bf16_t;
typedef short bf16x8 __attribute__((ext_vector_type(8)));
typedef float f32x4 __attribute__((ext_vector_type(4)));
typedef unsigned u32x4 __attribute__((ext_vector_type(4)));
constexpr int BM = 256, BK = 64, HALF = 128, HTB = HALF * BK * 2  , STAGE_BYTES = 8 * HTB, NXCD = 8, WGM = 8;

__host__ __device__ __forceinline__ int lds_byte(int r, int c) { const int st = (r >> 4) * 2 + (c >> 5), rr = r & 15, cc = c & 31, ob = rr * 64 + cc * 2; return st * 1024 + (ob ^ (((ob >> 9) & 1) << 5)); }
__host__ __device__ __forceinline__ void stage_rc(int b, int& R, int& C) { const int st = b / 1024, sb = b % 1024, swz = sb ^ (((sb >> 9) & 1) << 5); R = (st >> 1) * 16 + swz / 64; C = (st & 1) * 32 + (swz % 64) / 2; }
__host__ __device__ __forceinline__ int perm32(int rho) { const int n = rho >> 4, i = rho & 15; return 8 * (i >> 2) + 4 * n + (i & 3); }

struct Unit { int pm, pn, seg; };
struct Gemm { const bf16_t* A; const bf16_t* Bt; int M, N, K; const bf16_t* A2; const bf16_t* Bt2; };

struct StaticOrder {
    int nM, nN, nwg, G, c;
    __host__ __device__ void init(int M, int N, int G_, int c_) { nM = M / BM; nN = N / BM; nwg = nM * nN; G = G_; c = c_; }
    __host__ __device__ bool next(int i, Unit& u) const {
        const long L = (long)i * G + c; if (L >= nwg) return false;
        int wgid = (int)L; { const int q = nwg / NXCD, r = nwg % NXCD, xcd = wgid % NXCD, off = wgid / NXCD; wgid = (xcd < r ? xcd * (q + 1) : r * (q + 1) + (xcd - r) * q) + off; }
        const int nig = WGM * nN, gid = wgid / nig, fm = gid * WGM, gsz = (nM - fm) < WGM ? (nM - fm) : WGM;
        u.pm = fm + ((wgid % nig) % gsz); u.pn = (wgid % nig) / gsz; u.seg = 0; return true;
    }
    __device__ __forceinline__ void a_ready(const Unit&) const {}
    __device__ __forceinline__ void done(const Unit&) const {}
};
typedef float f32x2_cv __attribute__((ext_vector_type(2)));
typedef __bf16 bf16x2_cv __attribute__((ext_vector_type(2)));
struct StaticOrder2 : StaticOrder { __host__ __device__ bool next(int i, Unit& u) const { if (!StaticOrder::next(i >> 1, u)) return false; u.seg = i & 1; return true; } };
__device__ __forceinline__ unsigned cvt_pk_bf16(float lo, float hi) { const f32x2_cv v = {lo, hi}; return __builtin_bit_cast(unsigned, __builtin_convertvector(v, bf16x2_cv)); }
typedef float f32x2 __attribute__((ext_vector_type(2)));
template <class Epi, class Sched, bool ALIGN_EPI = false, bool SP2 = false, bool TWOSEG = false>
__device__ __forceinline__ void gemm_phase(PG8_LAS unsigned char* lds, const Gemm g, const Sched& S, const Epi& E, const int tid_in) {
    int tid_ = tid_in; asm volatile("" : "+v"(tid_));
    const int tid = tid_, wid = __builtin_amdgcn_readfirstlane(tid >> 6), lane = tid & 63, wr = wid >> 2, wc = wid & 3, fr = lane & 15, fq = lane >> 4;
    const int K = g.K, nt = K / BK;
    unsigned voffA[2], voffB[2];
#pragma unroll
    for (int i = 0; i < 2; ++i) { int R, C; stage_rc(tid * 16 + i * 8192, R, C); const int Rb = Epi::PERM ? ((R & ~31) + perm32(R & 31)) : R;
        voffA[i] = (unsigned)(R * K + C) * 2u; voffB[i] = (unsigned)(Rb * K + C) * 2u; }
    const size_t kstep = (size_t)(BK * 2);
    const size_t hstep = (size_t)HALF * K * 2;
    const size_t tstep = 2 * hstep;
    const unsigned ldsw = (unsigned)wid * 1024u;
    const int aoff = lds_byte(wr * 64 + fr, fq * 8), boff = lds_byte(wc * 32 + fr, fq * 8);
#define PG8_SA(b, h) (((b) * 2 + (h)) * HTB)
#define PG8_SB(b, h) ((4 + (b) * 2 + (h)) * HTB)
#define PG8_STAGE(bufoff, gbase, voff) do { _Pragma("unroll") for (int _i = 0; _i < 2; ++_i) \
        __builtin_amdgcn_global_load_lds((const unsigned*)((const char*)(gbase) + (voff)[_i]), (PG8_LAS unsigned*)(lds + (bufoff) + ldsw + _i * 8192), 16, 0, 0); } while (0)
#define PG8_LDA(dst, b, h) do { _Pragma("unroll") for (int m = 0; m < 4; ++m) _Pragma("unroll") for (int k = 0; k < 2; ++k) dst[m][k] = *(const PG8_LAS bf16x8*)(lds + PG8_SA(b, h) + aoff + m * 2048 + k * 1024); } while (0)
#define PG8_LDB(dst, b, h) do { _Pragma("unroll") for (int n = 0; n < 2; ++n) _Pragma("unroll") for (int k = 0; k < 2; ++k) dst[n][k] = *(const PG8_LAS bf16x8*)(lds + PG8_SB(b, h) + boff + n * 2048 + k * 1024); } while (0)
#define PG8_MMA(ai, bj, At, Bt) do { __builtin_amdgcn_s_setprio(1); _Pragma("unroll") for (int m = 0; m < 4; ++m) _Pragma("unroll") for (int n = 0; n < 2; ++n) _Pragma("unroll") for (int k = 0; k < 2; ++k) \
        acc[ai][bj][m][n] = __builtin_amdgcn_mfma_f32_16x16x32_bf16(Bt[n][k], At[m][k], acc[ai][bj][m][n], 0, 0, 0); __builtin_amdgcn_s_setprio(0); } while (0)
#define PG8_WAIT_V(n) asm volatile("s_waitcnt vmcnt(" #n ")" ::: "memory")
#define PG8_WAIT_L(n) asm volatile("s_waitcnt lgkmcnt(" #n ")" ::: "memory")
#define PG8_BAR __builtin_amdgcn_s_barrier()
#define PG8_SCHED __builtin_amdgcn_sched_barrier(0)
    Unit cur, nxt; int ui = 0;
    if (!S.next(0, cur)) return;
    f32x4 acc[2][2][4][2];
#pragma unroll
    for (int a = 0; a < 2; ++a)
#pragma unroll
        for (int b = 0; b < 2; ++b)
#pragma unroll
            for (int m = 0; m < 4; ++m)
#pragma unroll
                for (int n = 0; n < 2; ++n) acc[a][b][m][n] = (f32x4){0.f, 0.f, 0.f, 0.f};
    bf16x8 At[4][2], B0[2][2], B1[2][2];
    const char* cA = (const char*)((TWOSEG && cur.seg) ? g.A2 : g.A) + (size_t)cur.pm * tstep; const char* cB = (const char*)((TWOSEG && cur.seg) ? g.Bt2 : g.Bt) + (size_t)cur.pn * tstep;
    S.a_ready(cur);
    if constexpr (SP2) {
        PG8_STAGE(PG8_SB(0, 0), cB, voffB); PG8_STAGE(PG8_SB(0, 1), cB + hstep, voffB); PG8_STAGE(PG8_SA(0, 0), cA, voffA); PG8_STAGE(PG8_SA(0, 1), cA + hstep, voffA);
        if (wr == 1) PG8_BAR;
        PG8_WAIT_V(2); PG8_BAR;
        PG8_STAGE(PG8_SB(1, 0), cB + kstep, voffB); PG8_STAGE(PG8_SA(1, 0), cA + kstep, voffA); PG8_STAGE(PG8_SB(1, 1), cB + hstep + kstep, voffB);
        PG8_WAIT_V(6); PG8_BAR;
    } else {
        PG8_STAGE(PG8_SB(0, 0), cB, voffB); PG8_STAGE(PG8_SA(0, 0), cA, voffA); PG8_STAGE(PG8_SB(0, 1), cB + hstep, voffB); PG8_STAGE(PG8_SA(0, 1), cA + hstep, voffA);
        if (wr == 1) PG8_BAR;
        PG8_WAIT_V(4); PG8_BAR;
        PG8_STAGE(PG8_SB(1, 0), cB + kstep, voffB); PG8_STAGE(PG8_SA(1, 0), cA + kstep, voffA); PG8_STAGE(PG8_SB(1, 1), cB + hstep + kstep, voffB);
        PG8_WAIT_V(6); PG8_BAR;
    }
    for (;;) {
        const bool has_next = S.next(ui + 1, nxt);
        const char* nA = has_next ? (const char*)((TWOSEG && nxt.seg) ? g.A2 : g.A) + (size_t)nxt.pm * tstep : cA; const char* nB = has_next ? (const char*)((TWOSEG && nxt.seg) ? g.Bt2 : g.Bt) + (size_t)nxt.pn * tstep : cB;
        for (int t = 0; t < nt; t += 2) {
            const bool last = (t == nt - 2);
            const char* a1 = cA + (size_t)(t + 1) * kstep;
            const char* a2 = last ? nA : cA + (size_t)(t + 2) * kstep; const char* b2 = last ? nB : cB + (size_t)(t + 2) * kstep;
            const char* a3 = a2 + kstep; const char* b3 = b2 + kstep;
            if (last && has_next) S.a_ready(nxt);
            if constexpr (SP2) {
            PG8_LDB(B0, 0, 0); PG8_LDB(B1, 0, 1); PG8_SCHED; PG8_LDA(At, 0, 0); PG8_STAGE(PG8_SA(1, 1), a1 + hstep, voffA);
            PG8_WAIT_V(8); PG8_WAIT_L(0); PG8_BAR; PG8_MMA(0, 0, At, B0); PG8_MMA(0, 1, At, B1); PG8_BAR; PG8_SCHED;
            PG8_LDA(At, 0, 1); PG8_STAGE(PG8_SB(0, 0), b2, voffB); PG8_STAGE(PG8_SB(0, 1), b2 + hstep, voffB); PG8_STAGE(PG8_SA(0, 0), a2, voffA);
            PG8_WAIT_V(8); PG8_WAIT_L(0); PG8_BAR; PG8_MMA(1, 0, At, B0); PG8_MMA(1, 1, At, B1); PG8_BAR; PG8_SCHED;
            PG8_LDB(B0, 1, 0); PG8_LDB(B1, 1, 1); PG8_SCHED; PG8_LDA(At, 1, 0); PG8_STAGE(PG8_SA(0, 1), a2 + hstep, voffA);
            PG8_WAIT_V(8); PG8_WAIT_L(0); PG8_BAR; PG8_MMA(0, 0, At, B0); PG8_MMA(0, 1, At, B1); PG8_BAR; PG8_SCHED;
            PG8_LDA(At, 1, 1); PG8_STAGE(PG8_SB(1, 0), b3, voffB); PG8_STAGE(PG8_SB(1, 1), b3 + hstep, voffB); PG8_STAGE(PG8_SA(1, 0), a3, voffA);
            PG8_WAIT_V(8); PG8_WAIT_L(0); PG8_BAR; PG8_MMA(1, 0, At, B0); PG8_MMA(1, 1, At, B1); PG8_BAR; PG8_SCHED;
            } else {
            PG8_LDB(B0, 0, 0); PG8_SCHED; PG8_LDA(At, 0, 0); PG8_STAGE(PG8_SA(1, 1), a1 + hstep, voffA);
            PG8_WAIT_L(8); PG8_BAR; PG8_WAIT_L(0); PG8_MMA(0, 0, At, B0); PG8_BAR; PG8_SCHED;
            PG8_LDB(B1, 0, 1); PG8_STAGE(PG8_SB(0, 0), b2, voffB);
            PG8_BAR; PG8_WAIT_L(0); PG8_MMA(0, 1, At, B1); PG8_BAR;
            PG8_LDA(At, 0, 1); PG8_STAGE(PG8_SA(0, 0), a2, voffA);
            PG8_BAR; PG8_WAIT_L(0); PG8_MMA(1, 0, At, B0); PG8_BAR; PG8_SCHED;
            PG8_STAGE(PG8_SB(0, 1), b2 + hstep, voffB);
            PG8_WAIT_V(6); PG8_BAR; PG8_MMA(1, 1, At, B1); PG8_BAR;
            PG8_LDB(B0, 1, 0); PG8_SCHED; PG8_LDA(At, 1, 0); PG8_STAGE(PG8_SA(0, 1), a2 + hstep, voffA);
            PG8_WAIT_L(8); PG8_BAR; PG8_WAIT_L(0); PG8_MMA(0, 0, At, B0); PG8_BAR; PG8_SCHED;
            PG8_LDB(B1, 1, 1); PG8_STAGE(PG8_SB(1, 0), b3, voffB);
            PG8_BAR; PG8_WAIT_L(0); PG8_MMA(0, 1, At, B1); PG8_BAR;
            PG8_LDA(At, 1, 1); PG8_STAGE(PG8_SA(1, 0), a3, voffA);
            PG8_BAR; PG8_WAIT_L(0); PG8_MMA(1, 0, At, B0); PG8_BAR; PG8_SCHED;
            PG8_STAGE(PG8_SB(1, 1), b3 + hstep, voffB);
            PG8_WAIT_V(6); PG8_BAR; PG8_MMA(1, 1, At, B1); PG8_BAR;
            }
        }
        if constexpr (ALIGN_EPI) { if (wr == 0) PG8_BAR; }
        if constexpr (TWOSEG) { if (cur.seg == 0) E.mid(acc, cur, wr, wc, fr, fq); else E(acc, cur, wr, wc, fr, fq); }
        else if constexpr (!Epi::AFTER_DRAIN) { E(acc, cur, wr, wc, fr, fq); S.done(cur); }
        if (!has_next) break;
        if (!(TWOSEG && cur.seg == 0))
#pragma unroll
        for (int a = 0; a < 2; ++a)
#pragma unroll
            for (int b = 0; b < 2; ++b)
#pragma unroll
                for (int m = 0; m < 4; ++m)
#pragma unroll
                    for (int n = 0; n < 2; ++n) acc[a][b][m][n] = (f32x4){0.f, 0.f, 0.f, 0.f};
        cur = nxt; cA = nA; cB = nB; ++ui;
        if constexpr (ALIGN_EPI) { if (wr == 1) PG8_BAR; }
    }
    PG8_WAIT_V(0);
    if constexpr (!ALIGN_EPI) { if (wr == 0) PG8_BAR; }
    PG8_BAR;
    if constexpr (Epi::AFTER_DRAIN) { E.fused(acc, cur, wr, wc, fr, fq, lds, wid, lane); S.done(cur); }
#undef PG8_SA
#undef PG8_SB
#undef PG8_STAGE
#undef PG8_LDA
#undef PG8_LDB
#undef PG8_MMA
#undef PG8_WAIT_V
#undef PG8_WAIT_L
#undef PG8_BAR
#undef PG8_SCHED
}
}

using pg8::bf16_t; using pg8::f32x4; using pg8::u32x4; using pg8::Unit;
#define LAS __attribute__((address_space(3)))
#define DI __device__ __forceinline__
typedef unsigned u32x2 __attribute__((ext_vector_type(2)));
typedef LAS f32x4* lds_f4p;
typedef LAS bf16_t* lbf;
typedef const LAS bf16_t* clbf;
typedef short s16x8 __attribute__((ext_vector_type(8)));
#define LDSYNC() do { asm volatile("s_waitcnt lgkmcnt(0)" ::: "memory"); __syncthreads(); } while (0)

constexpr int DM = 2048, MP = 16384, M = 16640, NAB = 6656, NC = 5120, DFF = 8192, DPLE = 256;
constexpr float EPS = 1e-6f;
constexpr size_t O_SGP = 34078720, O_BUFP = 34603008, O_SRP = 34639872, O_SHP = 34902016, O_SGS = 34916096, O_BUFS = 35964672, O_SRS = 36038400, O_SHS = 36562688, O_END = 36590848;
constexpr size_t DO_H = 0, DO_WC = 68157440, DO_WAB = 89128960, DO_AL2 = 116391936, DO_AG = 124911616;
constexpr size_t C_SS1 = 0x10000, C_SS2 = 0x30000, C_SS3 = 0x50000, C_RSO = 0x80000, C_GA = 0x110000, C_GB = 0x1A0000, C_WL2T = 0x230000, C_G2T = 0x330000;
constexpr size_t WS_PROJ = 6291456, WS_GDNS = 227803136, WS_RWKS = 330039296, SLOT = 34078720, WS_NEED = 534511616;
constexpr size_t WS_GTAIL = WS_GDNS + 67502080;
constexpr size_t GT_UPA = 0, GT_UPB = 4194304, GT_WO = 8388608, GT_PG = 16777216, GT_PLE = 25165824, GT_PB = 26214400;
constexpr int LDS_BYTES = 163840;

struct Args { const float* in[35]; float* out; unsigned char* ws; int ph_lo, ph_hi; };

struct Frame {
    LAS unsigned char* lds; int tid, lane, wave, G, bid;
    float* out; unsigned char* ws; unsigned char* dob;
};
struct KIn { DI const float* operator[](int i) const { return ((const float* const volatile __attribute__((address_space(4)))*)__builtin_amdgcn_kernarg_segment_ptr())[i]; } };

DI float bf2f(unsigned short b) { return __uint_as_float((unsigned)b << 16); }
DI void unpack8(const u32x4 w, float (&f)[8]) {
    f[0] = __uint_as_float(w.x << 16); f[1] = __uint_as_float(w.x & 0xffff0000u); f[2] = __uint_as_float(w.y << 16); f[3] = __uint_as_float(w.y & 0xffff0000u);
    f[4] = __uint_as_float(w.z << 16); f[5] = __uint_as_float(w.z & 0xffff0000u); f[6] = __uint_as_float(w.w << 16); f[7] = __uint_as_float(w.w & 0xffff0000u);
}
DI u32x4 pack8(const float (&f)[8]) { u32x4 w; w.x = pg8::cvt_pk_bf16(f[0], f[1]); w.y = pg8::cvt_pk_bf16(f[2], f[3]); w.z = pg8::cvt_pk_bf16(f[4], f[5]); w.w = pg8::cvt_pk_bf16(f[6], f[7]); return w; }
DI void ld8l(const LAS float* p, float (&f)[8]) { const f32x4 a = *(const LAS f32x4*)p, b = *(const LAS f32x4*)(p + 4); f[0] = a.x; f[1] = a.y; f[2] = a.z; f[3] = a.w; f[4] = b.x; f[5] = b.y; f[6] = b.z; f[7] = b.w; }
DI void ld8f(const float* p, float (&f)[8]) { const f32x4 a = *(const f32x4*)p, b = *(const f32x4*)(p + 4); f[0] = a.x; f[1] = a.y; f[2] = a.z; f[3] = a.w; f[4] = b.x; f[5] = b.y; f[6] = b.z; f[7] = b.w; }
DI void st8f(float* p, const float (&f)[8]) { *(f32x4*)p = (f32x4){f[0], f[1], f[2], f[3]}; *(f32x4*)(p + 4) = (f32x4){f[4], f[5], f[6], f[7]}; }
DI float sigm(float x) { return __builtin_amdgcn_rcpf(1.f + __expf(-x)); }
DI float softplus_(float x) { return x > 20.f ? x : __logf(1.f + __expf(x)); }
DI float tanh_(float x) { return 1.f - 2.f * __builtin_amdgcn_rcpf(1.f + __expf(2.f * x)); }
template <int CTRL> DI float dpp_f(float v) { return __builtin_bit_cast(float, __builtin_amdgcn_update_dpp(0, __builtin_bit_cast(int, v), CTRL, 0xF, 0xF, true)); }
DI float red4(float v) { v += dpp_f<0xB1>(v); v += dpp_f<0x4E>(v); return v; }
DI float red8(float v) { v = red4(v); v += dpp_f<0x141>(v); return v; }
DI float red16(float v) { v = red8(v); v += dpp_f<0x140>(v); return v; }
DI float wave_sum(float v) {
#pragma unroll
    for (int o = 1; o < 64; o <<= 1) v += __shfl_xor(v, o);
    return v;
}
DI int seq_base(int s) { return s < 4 ? s * 4096 : MP + (s - 4) * 32; }
DI int seq_T(int s) { return s < 4 ? 4096 : 32; }

template <class F> struct EpiT {
    static constexpr bool PERM = true, AFTER_DRAIN = false; F f;
    DI void operator()(const f32x4 (&acc)[2][2][4][2], const Unit& u, int wr, int wc, int fr, int fq) const {
#pragma unroll
        for (int ai = 0; ai < 2; ++ai) {
            typename F::L l[4][2];
#pragma unroll
            for (int m = 0; m < 4; ++m)
#pragma unroll
                for (int bj = 0; bj < 2; ++bj) f.pre(u, u.pm * 256 + ai * 128 + wr * 64 + m * 16 + fr, u.pn * 256 + bj * 128 + wc * 32 + fq * 8, l[m][bj]);
#pragma unroll
            for (int m = 0; m < 4; ++m) {
                const int row = u.pm * 256 + ai * 128 + wr * 64 + m * 16 + fr; float ss = 0.f;
#pragma unroll
                for (int bj = 0; bj < 2; ++bj) { const int col = u.pn * 256 + bj * 128 + wc * 32 + fq * 8; ss += f.apply(u, row, col, acc[ai][bj][m][0], acc[ai][bj][m][1], l[m][bj]); }
                if (F::SUMSQ) { ss += __shfl_xor(ss, 16); ss += __shfl_xor(ss, 32); if (fq == 0) unsafeAtomicAdd(f.ssq + row, ss); }
            }
            asm volatile("" ::: "memory");
        }
    }
};
template <class F> DI float apply5(const F& f, const Unit& u, int row, int col, f32x4 v0, f32x4 v1) { typename F::L l; f.pre(u, row, col, l); return f.apply(u, row, col, v0, v1, l); }
DI void v2f(const f32x4 v0, const f32x4 v1, float (&f)[8]) { f[0] = v0.x; f[1] = v0.y; f[2] = v0.z; f[3] = v0.w; f[4] = v1.x; f[5] = v1.y; f[6] = v1.z; f[7] = v1.w; }
struct LNone {};
struct FStore { static constexpr bool SUMSQ = false; float* ssq; bf16_t* O; int ld; typedef LNone L;
    DI void pre(const Unit&, int, int, L&) const {}
    DI float apply(const Unit&, int row, int col, f32x4 v0, f32x4 v1, const L&) const { float v[8]; v2f(v0, v1, v); *(u32x4*)(O + (size_t)row * ld + col) = pack8(v); return 0.f; } };
struct FLora { static constexpr bool SUMSQ = false; float* ssq; bf16_t* O0; bf16_t* O1; typedef LNone L;
    DI void pre(const Unit&, int, int, L&) const {}
    DI float apply(const Unit& u, int row, int col, f32x4 v0, f32x4 v1, const L&) const { float v[8]; v2f(v0, v1, v); bf16_t* O = u.pn < 4 ? O0 : O1; *(u32x4*)(O + (size_t)row * 1024 + (col & 1023)) = pack8(v); return 0.f; } };
struct FGates { static constexpr bool SUMSQ = false; float* ssq; const bf16_t* oraw; const float* rso; const float* normg; bf16_t* OA; bf16_t* Gma; bf16_t* Gmb;
    struct L { u32x4 o; float rs; };
    DI void pre(const Unit& u, int row, int col, L& l) const { if (u.pn < 4) { l.o = *(const u32x4*)(oraw + (size_t)row * 1024 + col); l.rs = rso[row * 8 + (col >> 7)]; } }
    DI float apply(const Unit& u, int row, int col, f32x4 v0, f32x4 v1, const L& l) const {
        float v[8], r[8]; v2f(v0, v1, v);
        if (u.pn < 4) { const int d = col & 127; float o[8], g[8]; unpack8(l.o, o); ld8f(normg + d, g); const float rs = l.rs;
#pragma unroll
            for (int j = 0; j < 8; ++j) r[j] = o[j] * rs * g[j] * v[j] * sigm(v[j]);
            *(u32x4*)(OA + (size_t)row * 1024 + col) = pack8(r);
        } else { const int c2 = col - 1024; bf16_t* G = c2 < 2048 ? Gma : Gmb;
#pragma unroll
            for (int j = 0; j < 8; ++j) r[j] = sigm(v[j]);
            *(u32x4*)(G + (size_t)row * 2048 + (c2 & 2047)) = pack8(r); }
        return 0.f; } };
struct FUpA { static constexpr bool SUMSQ = false; float* ssq; const bf16_t* Gma; float* T1; struct L { u32x4 g; };
    DI void pre(const Unit&, int row, int col, L& l) const { l.g = *(const u32x4*)(Gma + (size_t)row * 2048 + col); }
    DI float apply(const Unit&, int row, int col, f32x4 v0, f32x4 v1, const L& l) const { float v[8], g[8]; v2f(v0, v1, v); unpack8(l.g, g);
#pragma unroll
        for (int j = 0; j < 8; ++j) v[j] *= g[j];
        st8f(T1 + (size_t)row * 2048 + col, v); return 0.f; } };
struct FUpB { static constexpr bool SUMSQ = false; float* ssq; const bf16_t* Gmb; const float* T1; bf16_t* MG; struct L { u32x4 g; f32x4 t0, t1; };
    DI void pre(const Unit&, int row, int col, L& l) const { l.g = *(const u32x4*)(Gmb + (size_t)row * 2048 + col); l.t0 = *(const f32x4*)(T1 + (size_t)row * 2048 + col); l.t1 = *(const f32x4*)(T1 + (size_t)row * 2048 + col + 4); }
    DI float apply(const Unit&, int row, int col, f32x4 v0, f32x4 v1, const L& l) const { float v[8], g[8], t[8]; v2f(v0, v1, v); unpack8(l.g, g); v2f(l.t0, l.t1, t);
#pragma unroll
        for (int j = 0; j < 8; ++j) v[j] = t[j] + v[j] * g[j];
        *(u32x4*)(MG + (size_t)row * 2048 + col) = pack8(v); return 0.f; } };
struct FRes { static constexpr bool SUMSQ = true; float* ssq; const float* xp; const float* xs; bf16_t* XB; struct L { f32x4 b0, b1; };
    DI void pre(const Unit&, int row, int col, L& l) const { const float* src = row < MP ? xp + (size_t)row * 2048 + col : xs + (size_t)(row - MP) * 2048 + col; l.b0 = *(const f32x4*)src; l.b1 = *(const f32x4*)(src + 4); }
    DI float apply(const Unit&, int row, int col, f32x4 v0, f32x4 v1, const L& l) const { float v[8], b[8]; v2f(v0, v1, v); v2f(l.b0, l.b1, b); float ss = 0.f;
#pragma unroll
        for (int j = 0; j < 8; ++j) { v[j] += b[j]; ss += v[j] * v[j]; }
        *(u32x4*)(XB + (size_t)row * 2048 + col) = pack8(v); return ss; } };
struct FRes2 { static constexpr bool SUMSQ = true; float* ssq; bf16_t* XB; struct L { u32x4 b; };
    DI void pre(const Unit&, int row, int col, L& l) const { l.b = *(const u32x4*)(XB + (size_t)row * 2048 + col); }
    DI float apply(const Unit&, int row, int col, f32x4 v0, f32x4 v1, const L& l) const { float v[8], b[8]; v2f(v0, v1, v); unpack8(l.b, b); float ss = 0.f;
#pragma unroll
        for (int j = 0; j < 8; ++j) { v[j] += b[j]; ss += v[j] * v[j]; }
        *(u32x4*)(XB + (size_t)row * 2048 + col) = pack8(v); return ss; } };
struct FFf1 { static constexpr bool SUMSQ = false; float* ssq; const float* ssin; bf16_t* HID; struct L { float ss; };
    DI void pre(const Unit&, int row, int, L& l) const { l.ss = ssin[row]; }
    DI float apply(const Unit&, int row, int col, f32x4 v0, f32x4 v1, const L& l) const { float v[8]; v2f(v0, v1, v); const float rs = rsqrtf(l.ss * (1.f / 2048.f) + EPS);
#pragma unroll
        for (int j = 0; j < 8; ++j) { const float t = fmaxf(v[j] * rs, 0.f); v[j] = t * t; }
        *(u32x4*)(HID + (size_t)row * DFF + col) = pack8(v); return 0.f; } };
struct FPg { static constexpr bool SUMSQ = true; float* ssq; const float* ssin; const bf16_t* PL; bf16_t* X3; const bf16_t* XB; struct L { u32x4 b, p; float ss; };
    DI void pre(const Unit&, int row, int col, L& l) const { l.b = *(const u32x4*)(XB + (size_t)row * 2048 + col); l.p = *(const u32x4*)(PL + (size_t)row * 2048 + col); l.ss = ssin[row]; }
    DI float apply(const Unit&, int row, int col, f32x4 v0, f32x4 v1, const L& l) const { float v[8], b[8], p[8]; v2f(v0, v1, v); const float rs = rsqrtf(l.ss * (1.f / 2048.f) + EPS);
        unpack8(l.b, b); unpack8(l.p, p); float ss = 0.f;
#pragma unroll
        for (int j = 0; j < 8; ++j) { v[j] = b[j] + sigm(v[j] * rs) * p[j]; ss += v[j] * v[j]; }
        *(u32x4*)(X3 + (size_t)row * 2048 + col) = pack8(v); return ss; } };

constexpr int SG_LD = 264, SG_A = 32 * SG_LD * 2  , SG_BUF = 96 * SG_LD * 2  , SG_T = 2 * SG_BUF  ;
template <class F> DI void sample_gemm(Frame& Fr, const bf16_t* A, const bf16_t* Bt, int N, int K, const F& f, int first_bid) {
    if (Fr.bid < first_bid) return;
    const int ncg = N >> 6, nun = ((ncg + 7) >> 3) * 64, nkc = K >> 8, tid = Fr.tid, x = Fr.lane & 15, g = Fr.lane >> 4, rt = Fr.wave & 1, ct = Fr.wave >> 1;
    LAS float* T = (LAS float*)(Fr.lds + SG_T);
    const int prow = tid >> 5, pc = (tid & 31) * 8;
    for (int un = Fr.bid - first_bid; un < nun; un += Fr.G - first_bid) {
        const int rg = (un >> 3) & 7, cgp = (un >> 6) * 8 + (un & 7);
        if (cgp >= ncg) continue;
        const bf16_t* ga = A + (size_t)(MP + 32 * rg + prow) * K + pc; const bf16_t* gw = Bt + (size_t)(64 * cgp + prow) * K + pc;
        u32x4 R[4][6];
#define SG_LOAD(q, kc) do { const int k0_ = (kc) << 8; R[q][0] = *(const u32x4*)(ga + k0_); R[q][1] = *(const u32x4*)(ga + (size_t)16 * K + k0_); \
        R[q][2] = *(const u32x4*)(gw + k0_); R[q][3] = *(const u32x4*)(gw + (size_t)16 * K + k0_); R[q][4] = *(const u32x4*)(gw + (size_t)32 * K + k0_); R[q][5] = *(const u32x4*)(gw + (size_t)48 * K + k0_); } while (0)
#pragma unroll
        for (int q = 0; q < 4; ++q) if (q < nkc) SG_LOAD(q, q);
        f32x4 acc = (f32x4){0.f, 0.f, 0.f, 0.f};
        for (int kc4 = 0; kc4 < nkc; kc4 += 4) {
#pragma unroll
            for (int q = 0; q < 4; ++q) {
                const int kc = kc4 + q;
                if (kc < nkc) {
                    LAS unsigned char* buf = Fr.lds + (kc & 1) * SG_BUF; lbf As = (lbf)buf, Ws = (lbf)(buf + SG_A);
                    *(LAS u32x4*)(As + prow * SG_LD + pc) = R[q][0]; *(LAS u32x4*)(As + (prow + 16) * SG_LD + pc) = R[q][1];
                    *(LAS u32x4*)(Ws + prow * SG_LD + pc) = R[q][2]; *(LAS u32x4*)(Ws + (prow + 16) * SG_LD + pc) = R[q][3]; *(LAS u32x4*)(Ws + (prow + 32) * SG_LD + pc) = R[q][4]; *(LAS u32x4*)(Ws + (prow + 48) * SG_LD + pc) = R[q][5];
                    LDSYNC();
                    if (kc + 4 < nkc) SG_LOAD(q, kc + 4);
#pragma unroll
                    for (int ks = 0; ks < 8; ++ks) acc = __builtin_amdgcn_mfma_f32_16x16x32_bf16(*(const LAS s16x8*)(Ws + (16 * ct + x) * SG_LD + 32 * ks + 8 * g), *(const LAS s16x8*)(As + (16 * rt + x) * SG_LD + 32 * ks + 8 * g), acc, 0, 0, 0);
                }
            }
        }
#undef SG_LOAD
        *(lds_f4p)(T + (16 * rt + x) * 68 + 16 * ct + 4 * g) = acc;
        LDSYNC();
        if (tid < 256) { const int row = tid >> 3, c0 = (tid & 7) * 8; const f32x4 v0 = *(const lds_f4p)(T + row * 68 + c0), v1 = *(const lds_f4p)(T + row * 68 + c0 + 4); Unit u; u.pm = 64; u.pn = (64 * cgp) >> 8;
            float ss = apply5(f, u, MP + 32 * rg + row, 64 * cgp + c0, v0, v1);
            if (F::SUMSQ) { ss = red8(ss); if ((tid & 7) == 0) unsafeAtomicAdd(f.ssq + MP + 32 * rg + row, ss); } }
        LDSYNC();
    }
}
constexpr int SG2_LD = 136, SG2_A = 64 * SG2_LD * 2  , SG2_BUF = 192 * SG2_LD * 2  , SG2_T = 2 * SG2_BUF  ;
template <class F> DI void sample_gemm2(Frame& Fr, const bf16_t* A, const bf16_t* Bt, int N, int K, const F& f, int first_bid) {
    if (Fr.bid < first_bid) return;
    const int ncg = N >> 7, nun = ((ncg + 7) >> 3) * 32, nkc = K >> 7, tid = Fr.tid, x = Fr.lane & 15, g = Fr.lane >> 4, rt = Fr.wave & 3, cq = Fr.wave >> 2;
    LAS float* T = (LAS float*)(Fr.lds + SG2_T);
    const int prow = tid >> 4, pc = (tid & 15) * 8;
    for (int un = Fr.bid - first_bid; un < nun; un += Fr.G - first_bid) {
        const int rg = (un >> 3) & 3, cgp = (un >> 5) * 8 + (un & 7);
        if (cgp >= ncg) continue;
        const bf16_t* ga = A + (size_t)(MP + 64 * rg + prow) * K + pc; const bf16_t* gw = Bt + (size_t)(128 * cgp + prow) * K + pc;
        u32x4 R[4][6];
#define SG_LOAD(q, kc) do { const int k0_ = (kc) << 7; R[q][0] = *(const u32x4*)(ga + k0_); R[q][1] = *(const u32x4*)(ga + (size_t)32 * K + k0_); \
        R[q][2] = *(const u32x4*)(gw + k0_); R[q][3] = *(const u32x4*)(gw + (size_t)32 * K + k0_); R[q][4] = *(const u32x4*)(gw + (size_t)64 * K + k0_); R[q][5] = *(const u32x4*)(gw + (size_t)96 * K + k0_); } while (0)
#pragma unroll
        for (int q = 0; q < 4; ++q) SG_LOAD(q, q);
        f32x4 acc[4] = {(f32x4){0.f, 0.f, 0.f, 0.f}, (f32x4){0.f, 0.f, 0.f, 0.f}, (f32x4){0.f, 0.f, 0.f, 0.f}, (f32x4){0.f, 0.f, 0.f, 0.f}};
        for (int kc4 = 0; kc4 < nkc; kc4 += 4) {
#pragma unroll
            for (int q = 0; q < 4; ++q) {
                const int kc = kc4 + q;
                LAS unsigned char* buf = Fr.lds + (kc & 1) * SG2_BUF; lbf As = (lbf)buf, Ws = (lbf)(buf + SG2_A);
                *(LAS u32x4*)(As + prow * SG2_LD + pc) = R[q][0]; *(LAS u32x4*)(As + (prow + 32) * SG2_LD + pc) = R[q][1];
                *(LAS u32x4*)(Ws + prow * SG2_LD + pc) = R[q][2]; *(LAS u32x4*)(Ws + (prow + 32) * SG2_LD + pc) = R[q][3]; *(LAS u32x4*)(Ws + (prow + 64) * SG2_LD + pc) = R[q][4]; *(LAS u32x4*)(Ws + (prow + 96) * SG2_LD + pc) = R[q][5];
                LDSYNC();
                { const int kn = kc + 4 < nkc ? kc + 4 : nkc - 1; SG_LOAD(q, kn); }
#pragma unroll
                for (int ks = 0; ks < 4; ++ks) { const s16x8 af = *(const LAS s16x8*)(As + (16 * rt + x) * SG2_LD + 32 * ks + 8 * g);
#pragma unroll
                    for (int j = 0; j < 4; ++j) acc[j] = __builtin_amdgcn_mfma_f32_16x16x32_bf16(*(const LAS s16x8*)(Ws + (16 * (4 * cq + j) + x) * SG2_LD + 32 * ks + 8 * g), af, acc[j], 0, 0, 0); }
            }
        }
#undef SG_LOAD
#pragma unroll
        for (int j = 0; j < 4; ++j) *(lds_f4p)(T + (16 * rt + x) * 132 + 16 * (4 * cq + j) + 4 * g) = acc[j];
        LDSYNC();
#pragma unroll
        for (int i = 0; i < 2; ++i) { const int idx = tid + 512 * i, row = idx >> 4, c0 = (idx & 15) * 8; const f32x4 v0 = *(const lds_f4p)(T + row * 132 + c0), v1 = *(const lds_f4p)(T + row * 132 + c0 + 4); Unit u; u.pm = 64; u.pn = (128 * cgp) >> 8;
            float ss = apply5(f, u, MP + 64 * rg + row, 128 * cgp + c0, v0, v1);
            if (F::SUMSQ) { ss = red16(ss); if ((tid & 15) == 0) unsafeAtomicAdd(f.ssq + MP + 64 * rg + row, ss); } }
        LDSYNC();
    }
}
template <class F> DI void sample_gemm_any(Frame& Fr, const bf16_t* A, const bf16_t* Bt, int N, int K, const F& f, int first_bid) {
    if (N >= 4096 && (N & 127) == 0 && (K & 511) == 0) sample_gemm2(Fr, A, Bt, N, K, f, first_bid); else sample_gemm(Fr, A, Bt, N, K, f, first_bid); }
struct EpiUp2 { static constexpr bool PERM = true, AFTER_DRAIN = false; const bf16_t* Gma; const bf16_t* Gmb; bf16_t* MG;
    DI void mid(f32x4 (&acc)[2][2][4][2], const Unit& u, int wr, int wc, int fr, int fq) const {
#pragma unroll
        for (int ai = 0; ai < 2; ++ai) { u32x4 la[4][2], lb[4][2];
#pragma unroll
            for (int m = 0; m < 4; ++m)
#pragma unroll
                for (int bj = 0; bj < 2; ++bj) { const size_t o = (size_t)(u.pm * 256 + ai * 128 + wr * 64 + m * 16 + fr) * 2048 + u.pn * 256 + bj * 128 + wc * 32 + fq * 8; la[m][bj] = *(const u32x4*)(Gma + o); lb[m][bj] = *(const u32x4*)(Gmb + o); }
#pragma unroll
            for (int m = 0; m < 4; ++m)
#pragma unroll
                for (int bj = 0; bj < 2; ++bj) { float ga[8], gb[8]; unpack8(la[m][bj], ga); unpack8(lb[m][bj], gb);
#pragma unroll
                    for (int j = 0; j < 8; ++j) ga[j] *= __builtin_amdgcn_rcpf(fmaxf(gb[j], 1e-20f));
                    acc[ai][bj][m][0] *= (f32x4){ga[0], ga[1], ga[2], ga[3]}; acc[ai][bj][m][1] *= (f32x4){ga[4], ga[5], ga[6], ga[7]}; }
            asm volatile("" ::: "memory"); }
    }
    DI void operator()(const f32x4 (&acc)[2][2][4][2], const Unit& u, int wr, int wc, int fr, int fq) const {
#pragma unroll
        for (int ai = 0; ai < 2; ++ai) { u32x4 lb[4][2];
#pragma unroll
            for (int m = 0; m < 4; ++m)
#pragma unroll
                for (int bj = 0; bj < 2; ++bj) lb[m][bj] = *(const u32x4*)(Gmb + (size_t)(u.pm * 256 + ai * 128 + wr * 64 + m * 16 + fr) * 2048 + u.pn * 256 + bj * 128 + wc * 32 + fq * 8);
#pragma unroll
            for (int m = 0; m < 4; ++m)
#pragma unroll
                for (int bj = 0; bj < 2; ++bj) { float v[8], gb[8]; v2f(acc[ai][bj][m][0], acc[ai][bj][m][1], v); unpack8(lb[m][bj], gb);
#pragma unroll
                    for (int j = 0; j < 8; ++j) v[j] *= fmaxf(gb[j], 1e-20f);
                    *(u32x4*)(MG + (size_t)(u.pm * 256 + ai * 128 + wr * 64 + m * 16 + fr) * 2048 + u.pn * 256 + bj * 128 + wc * 32 + fq * 8) = pack8(v); }
            asm volatile("" ::: "memory"); }
    }
};
DI void run_gemm_up2(Frame& Fr, const bf16_t* A1, const bf16_t* B1, const bf16_t* A2, const bf16_t* B2, int Mr, int N, int K, const EpiUp2& E) {
    int Kq = K; asm volatile("" : "+s"(Kq));
    pg8::Gemm g{A1, B1, Mr, N, Kq, A2, B2}; pg8::StaticOrder2 S; S.init(Mr, N, Fr.G, Fr.bid);
    pg8::gemm_phase<EpiUp2, pg8::StaticOrder2, true, true, true>(Fr.lds, g, S, E, Fr.tid);
}
template <class F> DI void run_gemm(Frame& Fr, const bf16_t* A, const bf16_t* Bt, int Mr, int N, int K, const F& f) {
    int Kq = K; asm volatile("" : "+s"(Kq));
    pg8::Gemm g{A, Bt, Mr, N, Kq, A, Bt}; pg8::StaticOrder S; S.init(Mr, N, Fr.G, Fr.bid); EpiT<F> E{f};
    pg8::gemm_phase<EpiT<F>, pg8::StaticOrder, true, true>(Fr.lds, g, S, E, Fr.tid);
}

struct Seg { const float* src; int ldw, K, ncols, nvalid; bf16_t* dst; int ldt; const float* gsc; };
DI Seg get_seg(Frame& F, int id) {
    const KIn in{}; bf16_t* WAB = (bf16_t*)(F.ws + WS_RWKS + 2 * SLOT); bf16_t* WC = (bf16_t*)(F.dob + DO_WC); unsigned char* gt = F.ws + WS_GTAIL; Seg s;
    switch (id) {
    case 0: s = Seg{in[9], 11728, 2048, 3072, 3072, WAB, 2048, nullptr}; break;
    case 1: s = Seg{in[9] + 4112, 11728, 2048, 3520, 3520, WAB + (size_t)3072 * 2048, 2048, nullptr}; break;
    case 2: s = Seg{in[9] + 3072, 11728, 2048, 64, 16, WAB + (size_t)6592 * 2048, 2048, nullptr}; break;
    case 3: s = Seg{in[9] + 3088, 11728, 2048, 1024, 1024, WC, 2048, nullptr}; break;
    case 4: s = Seg{in[9] + 7632, 11728, 2048, 4096, 4096, WC + (size_t)1024 * 2048, 2048, nullptr}; break;
    case 5: s = Seg{in[25], 2048, 1024, 2048, 2048, (bf16_t*)(gt + GT_UPA), 1024, nullptr}; break;
    case 6: s = Seg{in[26], 2048, 1024, 2048, 2048, (bf16_t*)(gt + GT_UPB), 1024, nullptr}; break;
    case 7: s = Seg{in[27], 2048, 2048, 2048, 2048, (bf16_t*)(gt + GT_WO), 2048, nullptr}; break;
    case 8: s = Seg{in[32], 2048, 2048, 2048, 2048, (bf16_t*)(gt + GT_PG), 2048, in[31]}; break;
    case 9: s = Seg{in[33], 2048, 256, 2048, 2048, (bf16_t*)(gt + GT_PLE), 256, nullptr}; break;
    case 10: s = Seg{in[29], 8192, 2048, 8192, 8192, (bf16_t*)(F.ws + WS_RWKS + 2 * SLOT), 2048, in[28]}; break;
    default: s = Seg{in[30], 2048, 8192, 2048, 2048, (bf16_t*)(F.ws + WS_RWKS + 3 * SLOT), 8192, nullptr}; break;
    }
    return s;
}
DI void tr_load(const Seg& sg, int item, int lane, float (&r)[32]) {
    const int nblk = sg.ncols >> 5, kb = item / nblk, nb = item - kb * nblk, k0 = 64 * kb, n0 = 32 * nb, nv = sg.nvalid - n0, c4 = 4 * (lane & 7);
#pragma unroll
    for (int i = 0; i < 8; ++i) { const int kk = 8 * i + (lane >> 3); f32x4 v = (f32x4){0.f, 0.f, 0.f, 0.f}; if (c4 < nv) v = *(const f32x4*)(sg.src + (size_t)(k0 + kk) * sg.ldw + n0 + c4);
        r[4 * i] = v.x; r[4 * i + 1] = v.y; r[4 * i + 2] = v.z; r[4 * i + 3] = v.w; }
}
DI void tr_finish(const Seg& sg, int item, LAS float* scr, int lane, const float (&r)[32]) {
    const int nblk = sg.ncols >> 5, kb = item / nblk, nb = item - kb * nblk, k0 = 64 * kb, n0 = 32 * nb, c4 = 4 * (lane & 7);
#pragma unroll
    for (int i = 0; i < 8; ++i) { const int kk = 8 * i + (lane >> 3); const float gs = sg.gsc ? sg.gsc[k0 + kk] : 1.f;
#pragma unroll
        for (int q = 0; q < 4; ++q) scr[kk * 33 + c4 + q] = r[4 * i + q] * gs; }
    asm volatile("s_waitcnt lgkmcnt(0)" ::: "memory");
    const int c = lane & 7;
#pragma unroll
    for (int j = 0; j < 4; ++j) { const int nn = (lane >> 3) + 8 * j; const LAS float* s = scr + (8 * c) * 33 + nn;
        u32x4 o; o.x = pg8::cvt_pk_bf16(s[0 * 33], s[1 * 33]); o.y = pg8::cvt_pk_bf16(s[2 * 33], s[3 * 33]); o.z = pg8::cvt_pk_bf16(s[4 * 33], s[5 * 33]); o.w = pg8::cvt_pk_bf16(s[6 * 33], s[7 * 33]);
        *(u32x4*)(sg.dst + (size_t)(n0 + nn) * sg.ldt + k0 + 8 * c) = o; }
    asm volatile("s_waitcnt lgkmcnt(0)" ::: "memory");
}
DI void conv_range(Frame& F, int seg_lo, int seg_hi) {
    LAS float* scr = (LAS float*)(F.lds + F.wave * 16384);
    const int gw = F.bid * 8 + F.wave, NGW = F.G * 8; int base = 0;
    for (int id = seg_lo; id < seg_hi; ++id) { const Seg sg = get_seg(F, id); const int ni = (sg.K >> 6) * (sg.ncols >> 5);
        int first = gw - (base % NGW); if (first < 0) first += NGW;
        float ra[32], rb[32];
        if (first < ni) tr_load(sg, first, F.lane, ra);
        for (int it = first; it < ni; it += 2 * NGW) {
            if (it + NGW < ni) tr_load(sg, it + NGW, F.lane, rb);
            tr_finish(sg, it, scr, F.lane, ra);
            if (it + NGW < ni) { if (it + 2 * NGW < ni) tr_load(sg, it + 2 * NGW, F.lane, ra); tr_finish(sg, it + NGW, scr, F.lane, rb); }
        }
        base += ni; }
}

DI void ph0(Frame& F) {
    const KIn in{};
    const int gw = F.bid * 8 + F.wave, NGW = F.G * 8, gt = F.bid * 512 + F.tid, NGT = F.G * 512;
    bf16_t* H = (bf16_t*)(F.dob + DO_H);
    const bool hf_ = F.G == 256 && (F.bid & 1);
#pragma unroll 1
    for (int ps_ = 0; ps_ < 2; ++ps_) {
        if ((ps_ == 0) == hf_) {
            float gm[4][8];
#pragma unroll
            for (int j = 0; j < 4; ++j) ld8f(in[8] + 8 * (F.lane + 64 * j), gm[j]);
            for (int m = gw; m < M; m += NGW) {
                const float* xr = m < MP ? in[0] + (size_t)m * DM : in[1] + (size_t)(m - MP) * DM; float v[4][8]; float ss = 0.f;
#pragma unroll
                for (int j = 0; j < 4; ++j) { ld8f(xr + 8 * (F.lane + 64 * j), v[j]);
#pragma unroll
                    for (int e = 0; e < 8; ++e) ss += v[j][e] * v[j][e]; }
                const float rs = rsqrtf(wave_sum(ss) * (1.f / DM) + EPS);
#pragma unroll
                for (int j = 0; j < 4; ++j) { float o[8];
#pragma unroll
                    for (int e = 0; e < 8; ++e) o[e] = v[j][e] * rs * gm[j][e];
                    const u32x4 w = pack8(o); const size_t off = (size_t)m * DM + 8 * (F.lane + 64 * j);
                    *(u32x4*)(H + off) = w; *(u32x4*)((bf16_t*)(F.ws + WS_RWKS) + off) = w; }
            }
        } else { __syncthreads(); conv_range(F, 0, 3); __syncthreads(); }
    }
    bf16_t* WL2T = (bf16_t*)(F.ws + C_WL2T); bf16_t* G2T = (bf16_t*)(F.ws + C_G2T);
    for (int i = gt; i < 2 * 1024 * 12; i += NGT) { const int mtx = i >= 12288, q = i - 12288 * mtx, n = q & 1023, kg = q >> 10; const float* src = (mtx ? in[18] : in[16]) + (size_t)(8 * kg) * 1024 + n; float f[8];
#pragma unroll
        for (int j = 0; j < 8; ++j) f[j] = src[(size_t)j * 1024];
        *(u32x4*)(WL2T + (size_t)(1024 * mtx + n) * 256 + 96 * mtx + 8 * kg) = pack8(f); }
    for (int i = gt; i < 1024 * 32; i += NGT) { const int n = i & 1023, kg = i >> 10; const float* src = in[19] + (size_t)(8 * kg) * 1024 + n; float f[8];
#pragma unroll
        for (int j = 0; j < 8; ++j) f[j] = src[(size_t)j * 1024];
        *(u32x4*)(G2T + (size_t)n * 256 + 8 * kg) = pack8(f); }
    float* ss1 = (float*)(F.ws + C_SS1); float* ss2 = (float*)(F.ws + C_SS2); float* ss3 = (float*)(F.ws + C_SS3);
    for (int i = gt; i < M; i += NGT) { ss1[i] = 0.f; ss2[i] = 0.f; ss3[i] = 0.f; }
}

DI void tb_decode(int tb, int& s, int& t0) { if (tb < 512) { s = tb >> 7; t0 = (tb & 127) * 32; } else { s = 4 + (tb - 512); t0 = 0; } }
template <int NH, int NI> DI void gdn_prep_item(Frame& F, int s, int t0) {
    const KIn in{}; const int mb = seq_base(s), T = seq_T(s);
    const bf16_t* PROJ = (const bf16_t*)(F.ws + WS_PROJ); bf16_t* GD = (bf16_t*)(F.ws + WS_GDNS);
    if (F.tid < 384) {
        const int ch = F.tid * 8, sec = F.tid >> 7;
        float w0[8], w1[8], w2[8], w3[8]; ld8f(in[10] + ch, w0); ld8f(in[10] + 3072 + ch, w1); ld8f(in[10] + 6144 + ch, w2); ld8f(in[10] + 9216 + ch, w3);
        float x0[8], x1[8], x2[8];
        {
#pragma unroll
          for (int j = 0; j < 3; ++j) { const int pos = t0 + j - 3; float (&xj)[8] = j == 0 ? x0 : j == 1 ? x1 : x2;
              if (pos >= 0) unpack8(*(const u32x4*)(PROJ + (size_t)(mb + pos) * NAB + ch), xj);
              else if (s >= 4) ld8f(in[5] + (size_t)(s - 4) * 9216 + (size_t)(3 + pos) * 3072 + ch, xj);
              else {
#pragma unroll
                  for (int e = 0; e < 8; ++e) xj[e] = 0.f; } } }
        for (int half = 0; half < NH; ++half) {
            u32x4 raw[NI];
#pragma unroll
            for (int i = 0; i < NI; ++i) raw[i] = *(const u32x4*)(PROJ + (size_t)(mb + t0 + half * NI + i) * NAB + ch);
#pragma unroll
            for (int i = 0; i < NI; ++i) {
                float x3[8], c[8]; unpack8(raw[i], x3); float ss = 0.f;
#pragma unroll
                for (int e = 0; e < 8; ++e) { float t = x0[e] * w0[e] + x1[e] * w1[e] + x2[e] * w2[e] + x3[e] * w3[e]; t = t * sigm(t); c[e] = t; ss += t * t; }
                if (sec < 2) { ss = red16(ss); const float sc = rsqrtf(ss + EPS) * (sec == 0 ? 0.08838834764831845f : 1.f);
#pragma unroll
                    for (int e = 0; e < 8; ++e) c[e] *= sc; }
                *(u32x4*)(GD + (size_t)(mb + t0 + half * NI + i) * 3072 + ch) = pack8(c);
#pragma unroll
                for (int e = 0; e < 8; ++e) { x0[e] = x1[e]; x1[e] = x2[e]; x2[e] = x3[e]; }
            }
        }
        if (t0 + NH * NI == T) { float* ob = F.out + (s < 4 ? O_BUFP + (size_t)s * 9216 : O_BUFS + (size_t)(s - 4) * 9216) + ch; st8f(ob, x0); st8f(ob + 3072, x1); st8f(ob + 6144, x2); }
    } else {
        float* ga = (float*)(F.ws + C_GA); float* gb = (float*)(F.ws + C_GB); const int idx = F.tid - 384;
#pragma unroll
        for (int r = 0; r < 2; ++r) { const int p = idx + 128 * r, tt = p >> 3, h = p & 7, m = mb + t0 + tt; if (tt >= NH * NI) continue;
            const float al = bf2f(PROJ[(size_t)m * NAB + 6592 + h]), be = bf2f(PROJ[(size_t)m * NAB + 6600 + h]);
            const float g = -__expf(in[11][h]) * softplus_(al + in[12][h]); ga[m * 8 + h] = g; gb[m * 8 + h] = sigm(be); }
    }
}
template <int NH, int NI> DI void rwkv_mix_item(Frame& F, int s, int t0) {
    const KIn in{}; const int mb = seq_base(s), T = seq_T(s);
    const bf16_t* PROJ = (const bf16_t*)(F.ws + WS_PROJ); bf16_t* AL2 = (bf16_t*)(F.dob + DO_AL2); bf16_t* AG = (bf16_t*)(F.dob + DO_AG);
    if (F.tid < 440) {
        const int i0 = F.tid * 8; float mu[8], xp[8]; ld8f(in[14] + i0, mu);
        if (t0 > 0) unpack8(*(const u32x4*)(PROJ + (size_t)(mb + t0 - 1) * NAB + 3072 + i0), xp);
        else if (s >= 4) ld8f(in[7] + (size_t)(s - 4) * 3520 + i0, xp);
        else {
#pragma unroll
            for (int e = 0; e < 8; ++e) xp[e] = 0.f; }
        for (int half = 0; half < NH; ++half) {
            u32x4 raw[NI];
#pragma unroll
            for (int i = 0; i < NI; ++i) raw[i] = *(const u32x4*)(PROJ + (size_t)(mb + t0 + half * NI + i) * NAB + 3072 + i0);
#pragma unroll
            for (int i = 0; i < NI; ++i) {
                const size_t m = (size_t)(mb + t0 + half * NI + i); float x[8], xm[8]; unpack8(raw[i], x);
#pragma unroll
                for (int e = 0; e < 8; ++e) { xm[e] = x[e] + (xp[e] - x[e]) * mu[e]; xp[e] = x[e]; }
                if (i0 < 3072) { bf16_t* dst = (bf16_t*)(F.ws + WS_RWKS + (size_t)(i0 >> 10) * SLOT); *(u32x4*)(dst + m * 1024 + (i0 & 1023)) = pack8(xm); }
                else if (i0 < 3168) {
#pragma unroll
                    for (int e = 0; e < 8; ++e) xm[e] = tanh_(xm[e]);
                    *(u32x4*)(AL2 + m * 256 + (i0 - 3072)) = pack8(xm); }
                else if (i0 < 3264) { *(u32x4*)(AL2 + m * 256 + 96 + (i0 - 3168)) = pack8(xm); }
                else {
#pragma unroll
                    for (int e = 0; e < 8; ++e) xm[e] = sigm(xm[e]);
                    *(u32x4*)(AG + m * 256 + (i0 - 3264)) = pack8(xm); }
            }
        }
        if (t0 + NH * NI == T) st8f(F.out + (s < 4 ? O_SHP + (size_t)s * 3520 : O_SHS + (size_t)(s - 4) * 3520) + i0, xp);
    } else if (F.tid < 448) {
        const int c = 192 + (F.tid - 440) * 8;
        for (int i = 0; i < NH * NI; ++i) *(u32x4*)(AL2 + (size_t)(mb + t0 + i) * 256 + c) = (u32x4){0u, 0u, 0u, 0u};
    }
}
DI void ph2a(Frame& F) {
    for (int it = F.bid; it < 1024; it += F.G) { const int tb = it >> 1; if ((it ^ (it >> 8)) & 1) rwkv_mix_item<2, 16>(F, tb >> 7, (tb & 127) * 32); else gdn_prep_item<2, 16>(F, tb >> 7, (tb & 127) * 32); }
    for (int it = F.bid; it < 256; it += F.G) { const int q = it >> 1, s = 4 + (q >> 4), t0 = (q & 15) * 2; if (it & 1) rwkv_mix_item<1, 2>(F, s, t0); else gdn_prep_item<1, 2>(F, s, t0); }
}

constexpr int L64 = 64, L128 = 128, TILE64 = 64 * L64 * 2  , TILE128 = 64 * L128 * 2  , TILE128T = 128 * L64 * 2  ;
constexpr size_t C_BONUS = 0x3C0000, C_EGL = 0x4D0000;
constexpr size_t WS_GDNI = WS_PROJ, GDNI_BLK = 73728, WS_RWKI_S = WS_PROJ + 163577856, WS_YRAW = WS_PROJ + 167772160, WS_ORAW = WS_GDNS;
constexpr int GI_W = 0, GI_Q = 16384, GI_KT = 32768, GI_UT = 49152, GI_QK = 65536;

DI u32x2 pack4(const f32x4 v) { u32x2 w; w.x = pg8::cvt_pk_bf16(v.x, v.y); w.y = pg8::cvt_pk_bf16(v.z, v.w); return w; }
DI unsigned short bf1(float v) { return (unsigned short)(pg8::cvt_pk_bf16(v, 0.f) & 0xffffu); }
DI f32x4 unpack4(const u32x2 w) { return (f32x4){__uint_as_float(w.x << 16), __uint_as_float(w.x & 0xffff0000u), __uint_as_float(w.y << 16), __uint_as_float(w.y & 0xffff0000u)}; }
DI int o64(int r, int c) { return r * 64 + ((((c >> 3) ^ ((r >> 1) & 7) ^ ((r >> 4) & 3))) << 3) + (c & 7); }
DI int o128(int r, int c) { return r * 128 + ((((c >> 3) ^ (r & 15))) << 3) + (c & 7); }
template <int KS, int NTW, bool OA, bool SP = false, bool SQ = false> DI void bmm_acc(clbf P, int ldp, clbf QT, int ldq, int mt, int nt0, int lane, f32x4 (&acc)[NTW]) {
    const int x = lane & 15, g = lane >> 4;
#pragma unroll
    for (int ks = 0; ks < KS; ++ks) {
        const int rp = 16 * mt + x; const s16x8 pf = *(const LAS s16x8*)(P + (ldp == L128 ? o128(rp, 32 * ks + 8 * g) : o64(rp, 32 * ks + 8 * g)));
#pragma unroll
        for (int j = 0; j < NTW; ++j) { const int rq = 16 * (nt0 + j) + x; const s16x8 qf = *(const LAS s16x8*)(QT + (ldq == L128 ? o128(rq, 32 * ks + 8 * g) : o64(rq, 32 * ks + 8 * g)));
            acc[j] = OA ? __builtin_amdgcn_mfma_f32_16x16x32_bf16(pf, qf, acc[j], 0, 0, 0) : __builtin_amdgcn_mfma_f32_16x16x32_bf16(qf, pf, acc[j], 0, 0, 0); }
    }
}
template <int KS, int NTW> DI void bmm_dual(clbf P, int ldp, clbf QT, int ldq, int mt, int nt0, int lane, f32x4 (&acc)[NTW], f32x4 (&acc2)[NTW]) {
    const int x = lane & 15, g = lane >> 4;
#pragma unroll
    for (int ks = 0; ks < KS; ++ks) {
        const int rp = 16 * mt + x; const s16x8 pf = *(const LAS s16x8*)(P + (ldp == L128 ? o128(rp, 32 * ks + 8 * g) : o64(rp, 32 * ks + 8 * g)));
#pragma unroll
        for (int j = 0; j < NTW; ++j) { const int rq = 16 * (nt0 + j) + x; const s16x8 qf = *(const LAS s16x8*)(QT + (ldq == L128 ? o128(rq, 32 * ks + 8 * g) : o64(rq, 32 * ks + 8 * g)));
            acc[j] = __builtin_amdgcn_mfma_f32_16x16x32_bf16(qf, pf, acc[j], 0, 0, 0); acc2[j] = __builtin_amdgcn_mfma_f32_16x16x32_bf16(pf, qf, acc2[j], 0, 0, 0); }
    }
}
DI lbf neumann64(lbf Qr0, lbf Qt0, lbf Pt0, lbf Qr1, lbf Qt1, lbf Pt1, f32x4 (&pacc)[2], f32x4 (&pacc2)[2], int mt, int nt0, int lane) {
    const int x = lane & 15, g = lane >> 4;
    { f32x4 q[2] = {(f32x4){0.f, 0.f, 0.f, 0.f}, (f32x4){0.f, 0.f, 0.f, 0.f}}, q2[2] = {(f32x4){0.f, 0.f, 0.f, 0.f}, (f32x4){0.f, 0.f, 0.f, 0.f}};
      bmm_dual<2, 2>(Qr0, L64, Qt0, L64, mt, nt0, lane, q, q2);
#pragma unroll
      for (int j = 0; j < 2; ++j) { *(LAS u32x2*)(Qr1 + o64(16 * mt + x, 16 * (nt0 + j) + 4 * g)) = pack4(q[j]); *(LAS u32x2*)(Qt1 + o64(16 * (nt0 + j) + x, 16 * mt + 4 * g)) = pack4(q2[j]); }
      LDSYNC(); }
    lbf Qr = Qr1, Qt = Qt1, Pt = Pt0, Qrn = Qr0, Qtn = Qt0, Ptn = Pt1;
#pragma unroll 1
    for (int k = 1; k <= 5; ++k) {
        if (k < 5) { f32x4 q[2] = {(f32x4){0.f, 0.f, 0.f, 0.f}, (f32x4){0.f, 0.f, 0.f, 0.f}}, q2[2] = {(f32x4){0.f, 0.f, 0.f, 0.f}, (f32x4){0.f, 0.f, 0.f, 0.f}};
            bmm_dual<2, 2>(Qr, L64, Pt, L64, mt, nt0, lane, pacc, pacc2);
            bmm_dual<2, 2>(Qr, L64, Qt, L64, mt, nt0, lane, q, q2);
#pragma unroll
            for (int j = 0; j < 2; ++j) { const int ot = o64(16 * (nt0 + j) + x, 16 * mt + 4 * g);
                *(LAS u32x2*)(Qrn + o64(16 * mt + x, 16 * (nt0 + j) + 4 * g)) = pack4(q[j]); *(LAS u32x2*)(Qtn + ot) = pack4(q2[j]); *(LAS u32x2*)(Ptn + ot) = pack4(pacc2[j]); } }
        else { bmm_acc<2, 2, false>(Qr, L64, Pt, L64, mt, nt0, lane, pacc);
#pragma unroll
            for (int j = 0; j < 2; ++j) *(LAS u32x2*)(Ptn + o64(16 * mt + x, 16 * (nt0 + j) + 4 * g)) = pack4(pacc[j]); }
        LDSYNC();
        lbf t; t = Qr; Qr = Qrn; Qrn = t; t = Qt; Qt = Qtn; Qtn = t; t = Pt; Pt = Ptn; Ptn = t;
    }
    return Pt;
}

struct RwMat { bf16_t* p[4]; int ld; };
DI RwMat rw_mats(unsigned char* ws, int s, int c, int h) { RwMat r;
    if (s < 4) { const size_t o = (size_t)(s * 4096 + 64 * c) * 1024 + 64 * h; r.ld = 1024; r.p[0] = (bf16_t*)(ws + WS_RWKS) + o; r.p[1] = (bf16_t*)(ws + WS_RWKS + SLOT) + o; r.p[2] = (bf16_t*)(ws + WS_RWKS + 3 * SLOT) + o; r.p[3] = (bf16_t*)(ws + WS_RWKS + 4 * SLOT) + o; }
    else { bf16_t* b = (bf16_t*)(ws + WS_RWKI_S + (size_t)((s - 4) * 16 + h) * 32768); r.ld = 64; r.p[0] = b; r.p[1] = b + 4096; r.p[2] = b + 8192; r.p[3] = b + 12288; }
    return r; }
constexpr int LORA_W_OFF = 14 * TILE64 + 4096;
DI void rwkv_raw_load(Frame& F, u32x4 (&raw)[7], int s, int c, int h, int tid) {
    const int m0 = seq_base(s) + 64 * c;
    const bf16_t* S0 = (const bf16_t*)(F.ws + WS_RWKS) + (size_t)(m0 + (tid >> 3)) * 1024 + 64 * h + 8 * (tid & 7);
#pragma unroll
    for (int i = 0; i < 3; ++i) raw[i] = *(const u32x4*)(S0 + (size_t)i * (SLOT / 2));
    const bf16_t* A0 = (const bf16_t*)(F.dob + DO_AL2) + (size_t)(m0 + (tid >> 5)) * 256 + 8 * (tid & 31);
#pragma unroll
    for (int i = 0; i < 4; ++i) raw[3 + i] = *(const u32x4*)(A0 + (size_t)(16 * i) * 256);
}
DI void rwkv_cprep_item(Frame& F, int s, int c, int h, u32x4 (&raw)[7], int ns, int nc) {
    int tid_ = F.tid; asm volatile("" : "+v"(tid_));
    const int tid = tid_, lane = tid_ & 63, wave = F.wave, x = lane & 15, g = lane >> 4, mt = wave & 3, nt0 = 2 * (wave >> 2);
    const int m0 = seq_base(s) + 64 * c, nvalid = s < 4 ? 64 : 32, t = tid >> 3, cg = tid & 7, ch = 64 * h + 8 * cg;
    LAS unsigned char* L = F.lds;
    lbf AT = (lbf)(L), BT = (lbf)(L + TILE64), KT = (lbf)(L + 2 * TILE64), RT = (lbf)(L + 3 * TILE64), RTR = (lbf)(L + 4 * TILE64), ATT = (lbf)(L + 5 * TILE64), BHT = (lbf)(L + 6 * TILE64), KHT = (lbf)(L + 7 * TILE64), VT = (lbf)(L + 8 * TILE64);
    lbf Qr0 = (lbf)(L + 9 * TILE64), Qt0 = (lbf)(L + 10 * TILE64), Pr0 = (lbf)(L + 11 * TILE64), AAK = (lbf)(L + 12 * TILE64), ABRT = (lbf)(L + 13 * TILE64);
    LAS float* WTOT = (LAS float*)(L + 14 * TILE64); LAS float* GAM = WTOT + 512; const LAS float* PAR = GAM + 64;
    lbf XW = (lbf)(L), XA = (lbf)(L + 2 * TILE64); LAS float* WLF = (LAS float*)(L + 4 * TILE64); LAS float* ALF = (LAS float*)(L + 6 * TILE64);
    clbf W2H = (clbf)(L + LORA_W_OFF), A2H = (clbf)(L + LORA_W_OFF + TILE128);
    { const int pc_ = tid & 31, tk_ = tid >> 5;
      if (pc_ < 24) { lbf X_ = pc_ < 12 ? XW : XA; const int c_ = 8 * (pc_ < 12 ? pc_ : pc_ - 12);
#pragma unroll
          for (int i = 0; i < 4; ++i) *(LAS u32x4*)(X_ + o128(tk_ + 16 * i, c_)) = raw[3 + i]; } }
    LDSYNC();
    { f32x4 a[2] = {(f32x4){0.f, 0.f, 0.f, 0.f}, (f32x4){0.f, 0.f, 0.f, 0.f}}, b[2] = {(f32x4){0.f, 0.f, 0.f, 0.f}, (f32x4){0.f, 0.f, 0.f, 0.f}};
      bmm_acc<3, 2, false>(XW, L128, W2H, L128, mt, nt0, lane, a); bmm_acc<3, 2, false>(XA, L128, A2H, L128, mt, nt0, lane, b);
#pragma unroll
      for (int j = 0; j < 2; ++j) { *(lds_f4p)(WLF + (16 * mt + x) * 64 + 16 * (nt0 + j) + 4 * g) = a[j]; *(lds_f4p)(ALF + (16 * mt + x) * 64 + 16 * (nt0 + j) + 4 * g) = b[j]; } }
    LDSYNC();
    float r[8], kp[8], v[8], lw[8], ka[8], kk[8];
    { u32x4 z = (u32x4){0u, 0u, 0u, 0u}; const bool ok = t < nvalid;
      float kx[8], wl[8], al[8], w0[8], a0[8], kkw[8], kaw[8];
      unpack8(ok ? raw[0] : z, r); unpack8(ok ? raw[1] : z, kx); unpack8(ok ? raw[2] : z, v); ld8l(WLF + t * 64 + 8 * cg, wl); ld8l(ALF + t * 64 + 8 * cg, al);
      if (!ok) {
#pragma unroll
          for (int e = 0; e < 8; ++e) { wl[e] = 0.f; al[e] = 0.f; } }
      ld8l(PAR + 8 * cg, w0); ld8l(PAR + 64 + 8 * cg, a0); ld8l(PAR + 128 + 8 * cg, kkw); ld8l(PAR + 192 + 8 * cg, kaw);
      float ss = 0.f;
#pragma unroll
      for (int e = 0; e < 8; ++e) { lw[e] = ok ? -0.6065306597126334f * sigm(w0[e] + wl[e]) : 0.f;     al[e] = sigm(a0[e] + al[e]); kk[e] = kx[e] * kkw[e]; ss += kk[e] * kk[e]; }
      ss = red8(ss); const float sc = rsqrtf(ss + EPS);
#pragma unroll
      for (int e = 0; e < 8; ++e) { kk[e] *= sc; kp[e] = kx[e] * (1.f + (al[e] - 1.f) * kaw[e]); ka[e] = kk[e] * al[e]; } }
    { float sb = 0.f; float rk[8]; ld8l(PAR + 256 + 8 * cg, rk);
#pragma unroll
      for (int e = 0; e < 8; ++e) sb += r[e] * kp[e] * rk[e];
      sb = red8(sb); if (cg == 0 && t < nvalid) ((float*)(F.ws + C_BONUS))[(size_t)(m0 + t) * 16 + h] = sb; }
    LAS float* LWF = (LAS float*)(L + 9 * TILE64);
    LAS float* OFFS = (LAS float*)(L + 11 * TILE64);
    { f32x4 w0_ = (f32x4){lw[0], lw[1], lw[2], lw[3]}, w1_ = (f32x4){lw[4], lw[5], lw[6], lw[7]}; *(lds_f4p)(LWF + t * 64 + 8 * cg) = w0_; *(lds_f4p)(LWF + t * 64 + 8 * cg + 4) = w1_; }
    LDSYNC();
    { const int c_ = tid & 63; float a = 0.f;
#pragma unroll
      for (int i = 0; i < 8; ++i) { a += LWF[(8 * wave + i) * 64 + c_]; LWF[(8 * wave + i) * 64 + c_] = a; }
      WTOT[wave * 64 + c_] = a; }
    LDSYNC();
    rwkv_raw_load(F, raw, ns, nc, h, tid);
    { const int c_ = tid & 63; float off = 0.f, ref = 0.f;
#pragma unroll
      for (int w = 0; w < 7; ++w) { const float q = WTOT[w * 64 + c_]; if (w < wave) off += q; if (w < 4) ref += q; }
      OFFS[wave * 64 + c_] = off;
      if (wave == 7) { const float tot = off + WTOT[7 * 64 + c_];
          OFFS[512 + c_] = ref; OFFS[576 + c_] = __expf(ref); OFFS[640 + c_] = __expf(tot - ref); GAM[c_] = __expf(tot); } }
    LDSYNC();
    float Lc[8], Lref[8], ER[8], EC[8];
    { float p_[8], o_[8]; ld8l(LWF + t * 64 + 8 * cg, p_); ld8l(OFFS + wave * 64 + 8 * cg, o_); ld8l(OFFS + 512 + 8 * cg, Lref); ld8l(OFFS + 576 + 8 * cg, ER); ld8l(OFFS + 640 + 8 * cg, EC);
#pragma unroll
      for (int e = 0; e < 8; ++e) Lc[e] = p_[e] + o_[e]; }
    { float a1[8], a2[8], a3[8], a4[8], a5[8], a6[8], a7[8], a8[8];
#pragma unroll
      for (int e = 0; e < 8; ++e) { const float E = __expf(Lc[e] - Lref[e]), eneg = __builtin_amdgcn_rcpf(E), ew = __expf(-lw[e]);
          a1[e] = -kk[e] * E * ew;                a2[e] = ka[e] * eneg; a3[e] = kp[e] * eneg; a4[e] = r[e] * E; a5[e] = a4[e] * ER[e];
          a6[e] = a1[e] * ER[e];                          a7[e] = a2[e] * EC[e]; a8[e] = a3[e] * EC[e]; }
      const int o = o64(t, 8 * cg);
      *(LAS u32x4*)(AT + o) = pack8(a1); *(LAS u32x4*)(BT + o) = pack8(a2); *(LAS u32x4*)(KT + o) = pack8(a3); *(LAS u32x4*)(RT + o) = pack8(a4); *(LAS u32x4*)(RTR + o) = pack8(a5);
#pragma unroll
      for (int e = 0; e < 8; ++e) { const int oc = o64(8 * cg + e, t); ATT[oc] = bf1(a6[e]); BHT[oc] = bf1(a7[e]); KHT[oc] = bf1(a8[e]); VT[oc] = bf1(v[e]); } }
    LDSYNC();
    f32x4 pacc[2], pacc2[2], akr[2];
    { f32x4 n[2] = {(f32x4){0.f, 0.f, 0.f, 0.f}, (f32x4){0.f, 0.f, 0.f, 0.f}}, n2[2] = {(f32x4){0.f, 0.f, 0.f, 0.f}, (f32x4){0.f, 0.f, 0.f, 0.f}};
      bmm_dual<2, 2>(AT, L64, BT, L64, mt, nt0, lane, n, n2);
#pragma unroll
      for (int j = 0; j < 2; ++j) { const int m = 16 * mt + x, nn = 16 * (nt0 + j) + 4 * g, r0 = 16 * mt + 4 * g, cc = 16 * (nt0 + j) + x;
#pragma unroll
          for (int e = 0; e < 4; ++e) { if (nn + e >= m) n[j][e] = 0.f; pacc[j][e] = n[j][e] + ((nn + e) == m ? 1.f : 0.f);
              if (cc >= r0 + e) n2[j][e] = 0.f; pacc2[j][e] = n2[j][e] + (cc == (r0 + e) ? 1.f : 0.f); }
          *(LAS u32x2*)(Qr0 + o64(m, nn)) = pack4(n[j]); *(LAS u32x2*)(Qt0 + o64(cc, r0)) = pack4(n2[j]); *(LAS u32x2*)(Pr0 + o64(cc, r0)) = pack4(pacc2[j]); } }
    { f32x4 a[2] = {(f32x4){0.f, 0.f, 0.f, 0.f}, (f32x4){0.f, 0.f, 0.f, 0.f}};
      bmm_acc<2, 2, false>(KT, L64, AT, L64, mt, nt0, lane, a);
#pragma unroll
      for (int j = 0; j < 2; ++j) { const int m = 16 * mt + x, nn = 16 * (nt0 + j) + 4 * g;
#pragma unroll
          for (int e = 0; e < 4; ++e) if (m >= nn + e) a[j][e] = 0.f;
          *(LAS u32x2*)(AAK + o64(m, nn)) = pack4(a[j]); } }
    { f32x4 a[2] = {(f32x4){0.f, 0.f, 0.f, 0.f}, (f32x4){0.f, 0.f, 0.f, 0.f}};
      bmm_acc<2, 2, true>(BT, L64, RT, L64, mt, nt0, lane, a);
      akr[0] = (f32x4){0.f, 0.f, 0.f, 0.f}; akr[1] = akr[0];
      bmm_acc<2, 2, true>(KT, L64, RT, L64, mt, nt0, lane, akr);
#pragma unroll
      for (int j = 0; j < 2; ++j) { const int jj = 16 * mt + 4 * g, tt = 16 * (nt0 + j) + x;
#pragma unroll
          for (int e = 0; e < 4; ++e) if (jj + e > tt) { a[j][e] = 0.f; akr[j][e] = 0.f; }
          *(LAS u32x2*)(ABRT + o64(tt, jj)) = pack4(a[j]); } }
    LDSYNC();
    lbf X = neumann64(Qr0, Qt0, Pr0, AT, BT, KT, pacc, pacc2, mt, nt0, lane);
    lbf W1 = RT, W2 = (X == Pr0) ? KT : Pr0;
    { f32x4 a[2] = {(f32x4){0.f, 0.f, 0.f, 0.f}, (f32x4){0.f, 0.f, 0.f, 0.f}}, b[2] = {(f32x4){0.f, 0.f, 0.f, 0.f}, (f32x4){0.f, 0.f, 0.f, 0.f}};
      bmm_acc<2, 2, false, true, false>(ATT, L64, X, L64, mt, nt0, lane, a);
      bmm_acc<2, 2, false>(AAK, L64, X, L64, mt, nt0, lane, b);
#pragma unroll
      for (int j = 0; j < 2; ++j) { const int o = o64(16 * mt + x, 16 * (nt0 + j) + 4 * g); *(LAS u32x2*)(W1 + o) = pack4(a[j]); *(LAS u32x2*)(W2 + o) = pack4(b[j]); } }
    LDSYNC();
#pragma unroll
    for (int i = 0; i < 7; ++i) asm volatile("" : "+v"(raw[i]));
    const RwMat G = rw_mats(F.ws, s, c, h);
    lbf M2T = Qr0, AKQT = Qt0;
    { f32x4 a[2] = {(f32x4){0.f, 0.f, 0.f, 0.f}, (f32x4){0.f, 0.f, 0.f, 0.f}}, b[2] = {(f32x4){0.f, 0.f, 0.f, 0.f}, (f32x4){0.f, 0.f, 0.f, 0.f}}, d[2] = {(f32x4){0.f, 0.f, 0.f, 0.f}, (f32x4){0.f, 0.f, 0.f, 0.f}};
      bmm_acc<2, 2, true, false, true>(W1, L64, BHT, L64, mt, nt0, lane, a);
      bmm_acc<2, 2, true, false, true>(W2, L64, BHT, L64, mt, nt0, lane, b);
      bmm_acc<2, 2, true>(W1, L64, ABRT, L64, mt, nt0, lane, d);
      bmm_acc<2, 2, true>(W2, L64, ABRT, L64, mt, nt0, lane, akr);
#pragma unroll
      for (int j = 0; j < 2; ++j) { const int mm = 16 * mt + 4 * g, nn = 16 * (nt0 + j) + x;
#pragma unroll
          for (int e = 0; e < 4; ++e) if (mm + e == nn) a[j][e] += GAM[nn];
          *(u32x2*)(G.p[0] + (size_t)nn * G.ld + mm) = pack4(a[j]);
          b[j] += unpack4(*(const LAS u32x2*)(KHT + o64(nn, mm))); *(LAS u32x2*)(M2T + o64(nn, mm)) = pack4(b[j]);
          d[j] += unpack4(*(const LAS u32x2*)(RTR + o64(nn, mm))); *(u32x2*)(G.p[1] + (size_t)nn * G.ld + mm) = pack4(d[j]);
          *(LAS u32x2*)(AKQT + o64(nn, mm)) = pack4(akr[j]); } }
    LDSYNC();
    { f32x4 a[2] = {(f32x4){0.f, 0.f, 0.f, 0.f}, (f32x4){0.f, 0.f, 0.f, 0.f}}, b[2] = {(f32x4){0.f, 0.f, 0.f, 0.f}, (f32x4){0.f, 0.f, 0.f, 0.f}};
      bmm_acc<2, 2, false, true, false>(VT, L64, M2T, L64, mt, nt0, lane, a);
      bmm_acc<2, 2, true, true, false>(VT, L64, AKQT, L64, mt, nt0, lane, b);
#pragma unroll
      for (int j = 0; j < 2; ++j) { *(u32x2*)(G.p[2] + (size_t)(16 * mt + x) * G.ld + 16 * (nt0 + j) + 4 * g) = pack4(a[j]);
          *(u32x2*)(G.p[3] + (size_t)(16 * (nt0 + j) + x) * G.ld + 16 * mt + 4 * g) = pack4(b[j]); } }
    LDSYNC();
}

DI int gdn_ch_index(int s, int c, int h) { return ((s < 4 ? s * 64 + c : 256 + (s - 4)) * 8 + h); }
struct GdnRaw { u32x4 p[6]; float ga, gb; };
DI void gdn_raw_load(Frame& F, GdnRaw& R, int s, int c, int h, int tid) {
    const int m0 = seq_base(s) + 64 * c; const bf16_t* GD = (const bf16_t*)(F.ws + WS_GDNS) + (size_t)(m0 + (tid >> 3)) * 3072 + 128 * h + 16 * (tid & 7);
#pragma unroll
    for (int i = 0; i < 3; ++i) { R.p[2 * i] = *(const u32x4*)(GD + 1024 * i); R.p[2 * i + 1] = *(const u32x4*)(GD + 1024 * i + 8); }
    const size_t og = (size_t)(m0 + (tid & 63)) * 8 + h; R.ga = ((const float*)(F.ws + C_GA))[og]; R.gb = ((const float*)(F.ws + C_GB))[og];
}
DI void gdn_cprep_item(Frame& F, int s, int c, int h, GdnRaw& R, int ns, int nc, int nh) {
    int tid_ = F.tid; asm volatile("" : "+v"(tid_));
    const int tid = tid_, lane = tid_ & 63, wave = F.wave, x = lane & 15, g = lane >> 4, mt = wave & 3, nt0 = 2 * (wave >> 2);
    const int m0 = seq_base(s) + 64 * c, nvalid = s < 4 ? 64 : 32, t = tid >> 3, dg = tid & 7;
    LAS unsigned char* L = F.lds;
    lbf KTm = (lbf)(L), QTm = (lbf)(L + TILE128), KBT = (lbf)(L + 2 * TILE128), VBT = (lbf)(L + 2 * TILE128 + TILE128T), KDT = (lbf)(L + 2 * TILE128 + 2 * TILE128T);
    constexpr int OFF2 = 2 * TILE128 + 3 * TILE128T;
    lbf Qr0 = (lbf)(L + OFF2), Qt0 = (lbf)(L + OFF2 + TILE64), Pr0 = (lbf)(L + OFF2 + 2 * TILE64), Qr1 = (lbf)(L + OFF2 + 3 * TILE64), Qt1 = (lbf)(L + OFF2 + 4 * TILE64), Pr1 = (lbf)(L + OFF2 + 5 * TILE64);
    LAS float* GS = (LAS float*)(L + OFF2 + 6 * TILE64);
    unsigned char* blk = F.ws + WS_GDNI + (size_t)gdn_ch_index(s, c, h) * GDNI_BLK;
    float gsc = lane < nvalid ? R.ga : 0.f; const float gbl = lane < nvalid ? R.gb : 0.f;
#pragma unroll
    for (int d = 1; d < 64; d <<= 1) { const float b = __shfl_up(gsc, d); if (lane >= d) gsc += b; }
    if (wave == 0) { GS[lane] = gsc; GS[64 + lane] = gbl; if (lane == 63) ((float*)(F.ws + C_EGL))[gdn_ch_index(s, c, h)] = __expf(gsc); }
    float q[16], k[16], v[16];
    { const u32x4 z = (u32x4){0u, 0u, 0u, 0u}; const bool ok = t < nvalid; float f[8];
      unpack8(ok ? R.p[0] : z, f);
#pragma unroll
      for (int e = 0; e < 8; ++e) q[e] = f[e];
      unpack8(ok ? R.p[1] : z, f);
#pragma unroll
      for (int e = 0; e < 8; ++e) q[8 + e] = f[e];
      unpack8(ok ? R.p[2] : z, f);
#pragma unroll
      for (int e = 0; e < 8; ++e) k[e] = f[e];
      unpack8(ok ? R.p[3] : z, f);
#pragma unroll
      for (int e = 0; e < 8; ++e) k[8 + e] = f[e];
      unpack8(ok ? R.p[4] : z, f);
#pragma unroll
      for (int e = 0; e < 8; ++e) v[e] = f[e];
      unpack8(ok ? R.p[5] : z, f);
#pragma unroll
      for (int e = 0; e < 8; ++e) v[8 + e] = f[e]; }
    gdn_raw_load(F, R, ns, nc, nh, tid);
    u32x4 qd0, qd1; u32x2 qks[2];
    { const float Gt = __shfl(gsc, t), be = __shfl(gbl, t), gl = __shfl(gsc, 63), eG = __expf(Gt), kb = be * eG, kd = __expf(gl - Gt);
      float f0[8], f1[8];
#pragma unroll
      for (int e = 0; e < 8; ++e) { f0[e] = k[e]; f1[e] = k[8 + e]; }
      *(LAS u32x4*)(KTm + o128(t, 16 * dg)) = pack8(f0); *(LAS u32x4*)(KTm + o128(t, 16 * dg + 8)) = pack8(f1);
#pragma unroll
      for (int e = 0; e < 8; ++e) { f0[e] = q[e]; f1[e] = q[8 + e]; }
      *(LAS u32x4*)(QTm + o128(t, 16 * dg)) = pack8(f0); *(LAS u32x4*)(QTm + o128(t, 16 * dg + 8)) = pack8(f1);
#pragma unroll
      for (int e = 0; e < 8; ++e) { f0[e] = q[e] * eG; f1[e] = q[8 + e] * eG; }
      qd0 = pack8(f0); qd1 = pack8(f1);
#pragma unroll
      for (int e = 0; e < 16; ++e) { const int oc = o64(16 * dg + e, t); KBT[oc] = bf1(k[e] * kb); VBT[oc] = bf1(v[e] * be); KDT[oc] = bf1(k[e] * kd); if ((e & 3) == 3) __builtin_amdgcn_sched_barrier(0); } }
    LDSYNC();
    f32x4 pacc[2], pacc2[2];
    { f32x4 n[2] = {(f32x4){0.f, 0.f, 0.f, 0.f}, (f32x4){0.f, 0.f, 0.f, 0.f}}, n2[2] = {(f32x4){0.f, 0.f, 0.f, 0.f}, (f32x4){0.f, 0.f, 0.f, 0.f}}, qk[2] = {(f32x4){0.f, 0.f, 0.f, 0.f}, (f32x4){0.f, 0.f, 0.f, 0.f}};
      bmm_dual<4, 2>(KTm, L128, KTm, L128, mt, nt0, lane, n, n2);
      bmm_acc<4, 2, false>(QTm, L128, KTm, L128, mt, nt0, lane, qk);
#pragma unroll
      for (int j = 0; j < 2; ++j) { const int m = 16 * mt + x, nn = 16 * (nt0 + j) + 4 * g, r0 = 16 * mt + 4 * g, cc = 16 * (nt0 + j) + x; const float Gi = GS[m], bi = GS[64 + m], Gc = GS[cc];
#pragma unroll
          for (int e = 0; e < 4; ++e) { const float dec = __expf(fminf(Gi - GS[nn + e], 0.f));
              n[j][e] = (nn + e < m) ? -bi * n[j][e] * dec : 0.f; qk[j][e] = (nn + e <= m) ? qk[j][e] * dec : 0.f;
              pacc[j][e] = n[j][e] + ((nn + e) == m ? 1.f : 0.f);
              const float dec2 = __expf(fminf(GS[r0 + e] - Gc, 0.f));
              n2[j][e] = (cc < r0 + e) ? -GS[64 + r0 + e] * n2[j][e] * dec2 : 0.f; pacc2[j][e] = n2[j][e] + (cc == (r0 + e) ? 1.f : 0.f); }
          *(LAS u32x2*)(Qr0 + o64(m, nn)) = pack4(n[j]); *(LAS u32x2*)(Qt0 + o64(cc, r0)) = pack4(n2[j]); *(LAS u32x2*)(Pr0 + o64(cc, r0)) = pack4(pacc2[j]);
          qks[j] = pack4(qk[j]); } }
    LDSYNC();
    lbf X = neumann64(Qr0, Qt0, Pr0, Qr1, Qt1, Pr1, pacc, pacc2, mt, nt0, lane);
#pragma unroll
    for (int i = 0; i < 6; ++i) asm volatile("" : "+v"(R.p[i]));
    asm volatile("" : "+v"(R.ga), "+v"(R.gb));
    *(u32x4*)((bf16_t*)(blk + GI_Q) + t * 128 + 16 * dg) = qd0; *(u32x4*)((bf16_t*)(blk + GI_Q) + t * 128 + 16 * dg + 8) = qd1;
#pragma unroll
    for (int j = 0; j < 2; ++j) *(u32x2*)((bf16_t*)(blk + GI_QK) + (16 * mt + x) * 64 + 16 * (nt0 + j) + 4 * g) = qks[j];
    { const int nt4 = 4 * (wave >> 2);
      f32x4 a[4] = {(f32x4){0.f, 0.f, 0.f, 0.f}, (f32x4){0.f, 0.f, 0.f, 0.f}, (f32x4){0.f, 0.f, 0.f, 0.f}, (f32x4){0.f, 0.f, 0.f, 0.f}}, b[4] = {(f32x4){0.f, 0.f, 0.f, 0.f}, (f32x4){0.f, 0.f, 0.f, 0.f}, (f32x4){0.f, 0.f, 0.f, 0.f}, (f32x4){0.f, 0.f, 0.f, 0.f}};
      bmm_acc<2, 4, false, false, true>(X, L64, KBT, L64, mt, nt4, lane, a);
      bmm_acc<2, 4, true, false, true>(X, L64, VBT, L64, mt, nt4, lane, b);
#pragma unroll
      for (int j = 0; j < 4; ++j) { a[j] = -a[j];
          *(u32x2*)((bf16_t*)(blk + GI_W) + (16 * mt + x) * 128 + 16 * (nt4 + j) + 4 * g) = pack4(a[j]);
          *(u32x2*)((bf16_t*)(blk + GI_UT) + (16 * (nt4 + j) + x) * 64 + 16 * mt + 4 * g) = pack4(b[j]); } }
    { const int row = tid >> 2, c16 = (tid & 3) * 16;
      *(u32x4*)((bf16_t*)(blk + GI_KT) + row * 64 + c16) = *(const LAS u32x4*)(KDT + o64(row, c16)); *(u32x4*)((bf16_t*)(blk + GI_KT) + row * 64 + c16 + 8) = *(const LAS u32x4*)(KDT + o64(row, c16 + 8)); }
    LDSYNC();
}
DI void ck_decode(int ck, int& s, int& c) { if (ck < 256) { s = ck >> 6; c = ck & 63; } else { s = 4 + (ck - 256); c = 0; } }
DI void ph_cprep_gdn(Frame& F) { const int it0 = (F.bid + (F.G >> 1)) % F.G; GdnRaw R;
    if (it0 < 2112) { int s, c; ck_decode(it0 >> 3, s, c); gdn_raw_load(F, R, s, c, it0 & 7, F.tid); }
    for (int it = it0; it < 2112; it += F.G) { int s, c, ns, nc; ck_decode(it >> 3, s, c); const int nit = it + F.G < 2112 ? it + F.G : it; ck_decode(nit >> 3, ns, nc);
        gdn_cprep_item(F, s, c, it & 7, R, ns, nc, nit & 7); } }
DI void ph_cprep_rwkv(Frame& F) {
    LAS float* PAR = (LAS float*)(F.lds + 14 * TILE64) + 512 + 64; int cur_h = -1; u32x4 raw[7];
    if (F.bid < 4224) { int s, c; ck_decode(F.bid >> 4, s, c); rwkv_raw_load(F, raw, s, c, F.bid & 15, F.tid); }
    for (int it = F.bid; it < 4224; it += F.G) { int s, c, ns, nc; ck_decode(it >> 4, s, c); const int h = it & 15, nit = it + F.G < 4224 ? it + F.G : it; ck_decode(nit >> 4, ns, nc);
        if (h != cur_h) { __syncthreads();
            if (F.tid < 320) { const KIn in{}; const int p = F.tid >> 6, ch = 64 * h + (F.tid & 63); PAR[F.tid] = (p == 0 ? in[15] : p == 1 ? in[17] : p == 2 ? in[20] : p == 3 ? in[21] : in[22])[ch]; }
            { const bf16_t* WL = (const bf16_t*)(F.ws + C_WL2T);
#pragma unroll
              for (int i = 0; i < 3; ++i) { const int p = F.tid + 512 * i, mtx = p >= 768, q = p - 768 * mtx, row = q / 12, pc = q - 12 * row;
                  *(LAS u32x4*)((lbf)(F.lds + LORA_W_OFF + mtx * TILE128) + o128(row, 8 * pc)) = *(const u32x4*)(WL + (size_t)(1024 * mtx + 64 * h + row) * 256 + 96 * mtx + 8 * pc); } }
            __syncthreads();
            if (cur_h >= 0) rwkv_raw_load(F, raw, s, c, h, F.tid);
            cur_h = h; }
        rwkv_cprep_item(F, s, c, h, raw, ns, nc); } }

DI u32x4 frag_gload(const bf16_t* base, int ld, int lane) { return *(const u32x4*)(base + (size_t)(lane >> 2) * ld + 8 * (lane & 3)); }
DI s16x8 frag_gperm(const u32x4 w, int lane) { const int src = (4 * (lane & 15) + (lane >> 4)) * 4; u32x4 p;
#pragma unroll
    for (int e = 0; e < 4; ++e) p[e] = (unsigned)__builtin_amdgcn_ds_bpermute(src, (int)w[e]);
    return __builtin_bit_cast(s16x8, p); }
DI u32x2 quad_gload(const bf16_t* base, int ld, int lane) { return *(const u32x2*)(base + (size_t)(lane >> 2) * ld + 4 * (lane & 3)); }
DI u32x2 quad_gperm(const u32x2 w, int lane) { const int src = (4 * (lane & 15) + (lane >> 4)) * 4; u32x2 p; p.x = (unsigned)__builtin_amdgcn_ds_bpermute(src, (int)w.x); p.y = (unsigned)__builtin_amdgcn_ds_bpermute(src, (int)w.y); return p; }
DI s16x8 frag_gather(const bf16_t* base  , int ld, int lane) {
    const u32x4 w = *(const u32x4*)(base + (size_t)(lane >> 2) * ld + 8 * (lane & 3)); const int src = (4 * (lane & 15) + (lane >> 4)) * 4; u32x4 p;
#pragma unroll
    for (int e = 0; e < 4; ++e) p[e] = (unsigned)__builtin_amdgcn_ds_bpermute(src, (int)w[e]);
    return __builtin_bit_cast(s16x8, p);
}
DI u32x2 quad_gather(const bf16_t* base  , int ld, int lane) {
    const u32x2 w = *(const u32x2*)(base + (size_t)(lane >> 2) * ld + 4 * (lane & 3)); const int src = (4 * (lane & 15) + (lane >> 4)) * 4; u32x2 p;
    p.x = (unsigned)__builtin_amdgcn_ds_bpermute(src, (int)w.x); p.y = (unsigned)__builtin_amdgcn_ds_bpermute(src, (int)w.y); return p;
}
DI void rwkv_sample_wave(Frame& F, int s, int h, int vq, LAS unsigned char* wl) {
    const int lane = F.lane, x = lane & 15, g = lane >> 4, mb = seq_base(s); lbf Sb = (lbf)wl;
    const RwMat G = rw_mats(F.ws, s, 0, h); bf16_t* YR = (bf16_t*)(F.ws + WS_YRAW);
    u32x4 fm[4][2], fr[2][2]; u32x2 ds[4], yl[2];
#pragma unroll
    for (int j = 0; j < 4; ++j) { fm[j][0] = frag_gload(G.p[0] + (size_t)(16 * j) * G.ld, G.ld, lane); fm[j][1] = frag_gload(G.p[0] + (size_t)(16 * j) * G.ld + 32, G.ld, lane);
        ds[j] = quad_gload(G.p[2] + (size_t)(16 * vq) * G.ld + 16 * j, G.ld, lane); }
#pragma unroll
    for (int j = 0; j < 2; ++j) { fr[j][0] = frag_gload(G.p[1] + (size_t)(16 * j) * G.ld, G.ld, lane); fr[j][1] = frag_gload(G.p[1] + (size_t)(16 * j) * G.ld + 32, G.ld, lane);
        yl[j] = quad_gload(G.p[3] + (size_t)(16 * j) * G.ld + 16 * vq, G.ld, lane); }
    f32x4 S[4];
    { const float* st = KIn{}[6] + ((size_t)((s - 4) * 16 + h) * 64 + 16 * vq + x) * 64;
#pragma unroll
      for (int j = 0; j < 4; ++j) S[j] = *(const f32x4*)(st + 16 * j + 4 * g); }
#pragma unroll
    for (int j = 0; j < 4; ++j) *(LAS u32x2*)(Sb + o64(x, 16 * j + 4 * g)) = pack4(S[j]);
    asm volatile("s_waitcnt lgkmcnt(0)" ::: "memory");
    const s16x8 s0 = *(const LAS s16x8*)(Sb + o64(x, 8 * g)), s1 = *(const LAS s16x8*)(Sb + o64(x, 32 + 8 * g));
    asm volatile("s_waitcnt lgkmcnt(0)" ::: "memory");
    float* so = F.out + O_SRS + ((size_t)((s - 4) * 16 + h) * 64 + 16 * vq + x) * 64;
#pragma unroll
    for (int j = 0; j < 4; ++j) { f32x4 n = unpack4(quad_gperm(ds[j], lane));
        n = __builtin_amdgcn_mfma_f32_16x16x32_bf16(frag_gperm(fm[j][0], lane), s0, n, 0, 0, 0); n = __builtin_amdgcn_mfma_f32_16x16x32_bf16(frag_gperm(fm[j][1], lane), s1, n, 0, 0, 0);
        *(f32x4*)(so + 16 * j + 4 * g) = n; }
#pragma unroll
    for (int j = 0; j < 2; ++j) { f32x4 y = unpack4(quad_gperm(yl[j], lane));
        y = __builtin_amdgcn_mfma_f32_16x16x32_bf16(s0, frag_gperm(fr[j][0], lane), y, 0, 0, 0); y = __builtin_amdgcn_mfma_f32_16x16x32_bf16(s1, frag_gperm(fr[j][1], lane), y, 0, 0, 0);
        *(u32x2*)(YR + (size_t)(mb + 16 * j + x) * 1024 + 64 * h + 16 * vq + 4 * g) = pack4(y); }
}
DI void rwkv_cscan_block(Frame& F, int s, int h) {
    const int tid = F.tid, lane = F.lane, wave = F.wave, x = lane & 15, g = lane >> 4;
    LAS unsigned char* L = F.lds;
    constexpr int BUFR = 4 * TILE64;
    __syncthreads();
    if (wave < 4) {
        const int vq = wave; lbf Sb = (lbf)(L + 2 * BUFR + wave * (16 * L64 * 2));
        f32x4 S[4];
#pragma unroll
        for (int j = 0; j < 4; ++j) S[j] = (f32x4){0.f, 0.f, 0.f, 0.f};
        bf16_t* yr = (bf16_t*)(F.ws + WS_YRAW) + (size_t)(s * 4096 + x) * 1024 + 64 * h + 16 * vq + 4 * g;
        LDSYNC();
        for (int c = 0; c < 64; ++c) {
            LAS unsigned char* B = L + (c & 1) * BUFR; lbf MT = (lbf)B, DS = (lbf)(B + TILE64), RQ = (lbf)(B + 2 * TILE64), YL = (lbf)(B + 3 * TILE64);
#pragma unroll
            for (int j = 0; j < 4; ++j) *(LAS u32x2*)(Sb + o64(x, 16 * j + 4 * g)) = pack4(S[j]);
            asm volatile("s_waitcnt lgkmcnt(0)" ::: "memory");
            const s16x8 s0 = *(const LAS s16x8*)(Sb + o64(x, 8 * g)), s1 = *(const LAS s16x8*)(Sb + o64(x, 32 + 8 * g));
#pragma unroll
            for (int j = 0; j < 4; ++j) {
                S[j] = unpack4(*(const LAS u32x2*)(DS + o64(16 * vq + x, 16 * j + 4 * g)));
                S[j] = __builtin_amdgcn_mfma_f32_16x16x32_bf16(*(const LAS s16x8*)(MT + o64(16 * j + x, 8 * g)), s0, S[j], 0, 0, 0);
                S[j] = __builtin_amdgcn_mfma_f32_16x16x32_bf16(*(const LAS s16x8*)(MT + o64(16 * j + x, 32 + 8 * g)), s1, S[j], 0, 0, 0); }
#pragma unroll
            for (int j = 0; j < 4; ++j) { f32x4 y = unpack4(*(const LAS u32x2*)(YL + o64(16 * j + x, 16 * vq + 4 * g)));
                y = __builtin_amdgcn_mfma_f32_16x16x32_bf16(s0, *(const LAS s16x8*)(RQ + o64(16 * j + x, 8 * g)), y, 0, 0, 0);
                y = __builtin_amdgcn_mfma_f32_16x16x32_bf16(s1, *(const LAS s16x8*)(RQ + o64(16 * j + x, 32 + 8 * g)), y, 0, 0, 0);
                *(u32x2*)(yr + (size_t)(64 * c + 16 * j) * 1024) = pack4(y); }
            LDSYNC();
        }
        float* so = F.out + O_SRP + ((size_t)(s * 16 + h) * 64 + 16 * vq + x) * 64;
#pragma unroll
        for (int j = 0; j < 4; ++j) *(f32x4*)(so + 16 * j + 4 * g) = S[j];
    } else {
        const int ht = tid - 256;
        const unsigned char* gsrc[8]; int lo[8];
#pragma unroll
        for (int i = 0; i < 8; ++i) { const int p = ht + 256 * i, q = p & 511, row = q >> 3, pc = q & 7, m = i >> 1;
            gsrc[i] = F.ws + WS_RWKS + (m == 0 ? 0 : m == 1 ? 3 * SLOT : m == 2 ? SLOT : 4 * SLOT) + ((size_t)(s * 4096 + row) * 1024 + 64 * h + 8 * pc) * 2; lo[i] = m * TILE64 + o64(row, 8 * pc) * 2; }
        u32x4 R0[8], R1[8], R2[8];
#define H_LD(RR, cc) do { const size_t co_ = (size_t)((cc) < 64 ? (cc) : 63) * 131072; \
_Pragma("unroll") for (int i = 0; i < 8; ++i) RR[i] = *(const u32x4*)(gsrc[i] + co_); } while (0)
#define H_ST(RR, k) do { LAS unsigned char* B_ = L + ((k) & 1) * BUFR; \
_Pragma("unroll") for (int i = 0; i < 8; ++i) *(LAS u32x4*)(B_ + lo[i]) = RR[i]; } while (0)
        H_LD(R0, 0); H_LD(R1, 1); H_LD(R2, 2);
        H_ST(R0, 0); H_LD(R0, 3);
        LDSYNC();
        for (int k = 1; k < 64; k += 3) {
            H_ST(R1, k); H_LD(R1, k + 3); LDSYNC();
            H_ST(R2, k + 1); H_LD(R2, k + 4); LDSYNC();
            H_ST(R0, k + 2); H_LD(R0, k + 5); LDSYNC();
        }
        LDSYNC();
#undef H_LD
#undef H_ST
    }
}
template <int NCH>
DI void gdn_cscan_item(Frame& F, int s, int h, int dq) {
    const int tid = F.tid, lane = F.lane, wave = F.wave, x = lane & 15, g = lane >> 4, nvalid = NCH > 1 ? 64 : 32, mb = seq_base(s);
    LAS unsigned char* L = F.lds;
    constexpr int O_QD = TILE128, O_KDT = 2 * TILE128, O_QK = 2 * TILE128 + TILE128T, O_UT = O_QK + TILE64, BUF = O_UT + 32 * L64 * 2  , WSZ = 16 * L128 * 2 + 16 * L64 * 2  ;
    static_assert(2 * BUF + 2 * WSZ <= LDS_BYTES, "LDS");
    __syncthreads();
    if (wave < 2) {
        const int dvl = 16 * wave, dv0 = 32 * dq + dvl;
        lbf ST = (lbf)(L + 2 * BUF + wave * WSZ), VN = ST + 16 * L128;
        bf16_t* OR = (bf16_t*)(F.ws + WS_ORAW);
        f32x4 S[8];
        if (NCH == 1) { const float* st = KIn{}[4] + ((size_t)((s - 4) * 8 + h) * 128) * 128 + dv0 + x;
#pragma unroll
            for (int i = 0; i < 8; ++i)
#pragma unroll
                for (int e = 0; e < 4; ++e) S[i][e] = st[(size_t)(16 * i + 4 * g + e) * 128]; }
        else {
#pragma unroll
            for (int i = 0; i < 8; ++i) S[i] = (f32x4){0.f, 0.f, 0.f, 0.f}; }
        const float egl_all = ((const float*)(F.ws + C_EGL))[gdn_ch_index(s, lane < NCH ? lane : NCH - 1, h)];
        LDSYNC();
        for (int c = 0; c < NCH; ++c) {
            LAS unsigned char* B = L + (c & 1) * BUF;
            lbf WN = (lbf)B, QD = (lbf)(B + O_QD), KDT = (lbf)(B + O_KDT), QK = (lbf)(B + O_QK), UT = (lbf)(B + O_UT);
            f32x4 vn[4];
#pragma unroll
            for (int i = 0; i < 8; ++i) *(LAS u32x2*)(ST + o128(x, 16 * i + 4 * g)) = pack4(S[i]);
#pragma unroll
            for (int i = 0; i < 4; ++i) vn[i] = unpack4(*(const LAS u32x2*)(UT + o64(dvl + x, 16 * i + 4 * g)));
            const float egl = __builtin_bit_cast(float, __builtin_amdgcn_readlane(__builtin_bit_cast(int, egl_all), c));
            asm volatile("s_waitcnt lgkmcnt(0)" ::: "memory");
            s16x8 sf[4];
#pragma unroll
            for (int ks = 0; ks < 4; ++ks) sf[ks] = *(const LAS s16x8*)(ST + o128(x, 32 * ks + 8 * g));
#pragma unroll
            for (int i = 0; i < 4; ++i)
#pragma unroll
                for (int ks = 0; ks < 4; ++ks) vn[i] = __builtin_amdgcn_mfma_f32_16x16x32_bf16(*(const LAS s16x8*)(WN + o128(16 * i + x, 32 * ks + 8 * g)), sf[ks], vn[i], 0, 0, 0);
#pragma unroll
            for (int i = 0; i < 4; ++i) *(LAS u32x2*)(VN + o64(x, 16 * i + 4 * g)) = pack4(vn[i]);
            asm volatile("s_waitcnt lgkmcnt(0)" ::: "memory");
            const s16x8 v0 = *(const LAS s16x8*)(VN + o64(x, 8 * g)), v1 = *(const LAS s16x8*)(VN + o64(x, 32 + 8 * g));
#pragma unroll
            for (int i = 0; i < 4; ++i) { f32x4 o = (f32x4){0.f, 0.f, 0.f, 0.f};
#pragma unroll
                for (int ks = 0; ks < 4; ++ks) o = __builtin_amdgcn_mfma_f32_16x16x32_bf16(sf[ks], *(const LAS s16x8*)(QD + o128(16 * i + x, 32 * ks + 8 * g)), o, 0, 0, 0);
                o = __builtin_amdgcn_mfma_f32_16x16x32_bf16(v0, *(const LAS s16x8*)(QK + o64(16 * i + x, 8 * g)), o, 0, 0, 0);
                o = __builtin_amdgcn_mfma_f32_16x16x32_bf16(v1, *(const LAS s16x8*)(QK + o64(16 * i + x, 32 + 8 * g)), o, 0, 0, 0);
                const int tt = 16 * i + x; if (tt < nvalid) *(u32x2*)(OR + (size_t)(mb + 64 * c + tt) * 1024 + 128 * h + dv0 + 4 * g) = pack4(o); }
#pragma unroll
            for (int i = 0; i < 8; ++i) { S[i] = S[i] * egl;
                S[i] = __builtin_amdgcn_mfma_f32_16x16x32_bf16(*(const LAS s16x8*)(KDT + o64(16 * i + x, 8 * g)), v0, S[i], 0, 0, 0);
                S[i] = __builtin_amdgcn_mfma_f32_16x16x32_bf16(*(const LAS s16x8*)(KDT + o64(16 * i + x, 32 + 8 * g)), v1, S[i], 0, 0, 0); }
            LDSYNC();
        }
        float* so = F.out + (NCH > 1 ? O_SGP + ((size_t)(s * 8 + h) * 128) * 128 : O_SGS + ((size_t)((s - 4) * 8 + h) * 128) * 128) + dv0 + x;
#pragma unroll
        for (int i = 0; i < 8; ++i)
#pragma unroll
            for (int e = 0; e < 4; ++e) so[(size_t)(16 * i + 4 * g + e) * 128] = S[i][e];
    } else {
        const int ht = tid - 128; int so[10], lo[10];
#pragma unroll
        for (int i = 0; i < 10; ++i) { const int p = ht + 384 * i;
            if (p < 2048) { const int q = p & 1023; so[i] = p * 16; lo[i] = (p >> 10) * O_QD + o128(q >> 4, (q & 15) * 8) * 2; }
            else if (p < 3072) { const int q = p - 2048; so[i] = p * 16; lo[i] = O_KDT + o64(q >> 3, (q & 7) * 8) * 2; }
            else if (p < 3584) { const int q = p - 3072; so[i] = GI_QK + q * 16; lo[i] = O_QK + o64(q >> 3, (q & 7) * 8) * 2; }
            else { const int q = p - 3584; so[i] = GI_UT + dq * 4096 + q * 16; lo[i] = O_UT + o64(q >> 3, (q & 7) * 8) * 2; } }
        const unsigned char* gb = F.ws + WS_GDNI;
        u32x4 R0[10], R1[10], R2[10];
#define H_LD(R, cc) do { const int cc_ = (cc) < NCH ? (cc) : NCH - 1; const unsigned char* b_ = gb + (size_t)gdn_ch_index(s, cc_, h) * GDNI_BLK; \
_Pragma("unroll") for (int i = 0; i < 10; ++i) R[i] = *(const u32x4*)(b_ + so[i]); } while (0)
#define H_ST(R, k) do { LAS unsigned char* B_ = L + ((k) & 1) * BUF; \
_Pragma("unroll") for (int i = 0; i < 10; ++i) *(LAS u32x4*)(B_ + lo[i]) = R[i]; } while (0)
        H_LD(R0, 0);
        if (NCH > 1) { H_LD(R1, 1); H_LD(R2, 2); }
        H_ST(R0, 0);
        if (NCH > 1) H_LD(R0, 3);
        LDSYNC();
        if (NCH > 1) {
            for (int k = 1; k < NCH; k += 3) {
                H_ST(R1, k); H_LD(R1, k + 3); LDSYNC();
                H_ST(R2, k + 1); H_LD(R2, k + 4); LDSYNC();
                H_ST(R0, k + 2); H_LD(R0, k + 5); LDSYNC();
            }
        }
        LDSYNC();
#undef H_LD
#undef H_ST
    }
}
DI void ph_pb(Frame& F) {
    bf16_t* PB = (bf16_t*)(F.ws + WS_GTAIL + GT_PB);
    for (int i = F.bid * 512 + F.tid; i < M * 32; i += F.G * 512) { const int m = i >> 5, c = (i & 31) * 8; const float* src = m < MP ? KIn{}[2] + (size_t)m * 256 + c : KIn{}[3] + (size_t)(m - MP) * 256 + c; float f[8]; ld8f(src, f); *(u32x4*)(PB + (size_t)m * 256 + c) = pack8(f); }
}
DI void ph_cscan(Frame& F) {
    if (F.G == 256) {
        if (F.bid < 128) { const int i = F.bid; gdn_cscan_item<64>(F, (i & 31) >> 3, i & 7, i >> 5); }
        else { Frame F2 = F; F2.bid = F.bid - 128; F2.G = 128; Frame F3 = F; F3.bid = (F.bid - 128) & 63; F3.G = 64;
            if (F.bid < 192) { const int i = F.bid - 128; rwkv_cscan_block(F, i >> 4, i & 15); { const int i2 = 192 + i; gdn_cscan_item<1>(F, 4 + (i2 >> 5), (i2 >> 2) & 7, i2 & 3); } }
            else { const int b_ = F.bid - 192; { const int j = b_ * 8 + F.wave; rwkv_sample_wave(F, 4 + (j >> 6), (j >> 2) & 15, j & 3, F.lds + F.wave * (16 * L64 * 2)); }
                   for (int i = b_; i < 192; i += 64) gdn_cscan_item<1>(F, 4 + (i >> 5), (i >> 2) & 7, i & 3); }
            __syncthreads();
            { const FStore f_{nullptr, (bf16_t*)(F.ws + WS_RWKS + 5 * SLOT), 1024}; const bf16_t* A_ = (const bf16_t*)(F.dob + DO_AG); const bf16_t* B_ = (const bf16_t*)(F.ws + C_G2T);
              run_gemm(F2, A_, B_, MP, 1024, 256, f_); __syncthreads(); sample_gemm(F2, A_, B_, 1024, 256, f_, 0); __syncthreads(); }
            if (F.bid >= 192) { conv_range(F3, 5, 10); ph_pb(F3); }
        }
    } else {
        for (int i = F.bid; i < 128; i += F.G) gdn_cscan_item<64>(F, (i & 31) >> 3, i & 7, i >> 5);
        for (int i = F.bid; i < 64; i += F.G) rwkv_cscan_block(F, i >> 4, i & 15);
        __syncthreads();
        for (int j = F.bid * 8 + F.wave; j < 512; j += F.G * 8) rwkv_sample_wave(F, 4 + (j >> 6), (j >> 2) & 15, j & 3, F.lds + F.wave * (16 * L64 * 2));
        for (int i = F.bid; i < 256; i += F.G) gdn_cscan_item<1>(F, 4 + (i >> 5), (i >> 2) & 7, i & 3);
        __syncthreads();
        { const FStore f_{nullptr, (bf16_t*)(F.ws + WS_RWKS + 5 * SLOT), 1024}; const bf16_t* A_ = (const bf16_t*)(F.dob + DO_AG); const bf16_t* B_ = (const bf16_t*)(F.ws + C_G2T);
          run_gemm(F, A_, B_, MP, 1024, 256, f_); __syncthreads(); sample_gemm(F, A_, B_, 1024, 256, f_, 0); __syncthreads(); }
        conv_range(F, 5, 10); ph_pb(F);
    }
}
DI void ph_post(Frame& F) {
    const KIn in{}; const int c8 = (F.tid & 127) * 8;
    const bf16_t* YR = (const bf16_t*)(F.ws + WS_YRAW); const bf16_t* ORW = (const bf16_t*)(F.ws + WS_ORAW); const bf16_t* S2 = (const bf16_t*)(F.ws + WS_RWKS + 2 * SLOT);
    bf16_t* OB = (bf16_t*)(F.ws + WS_RWKS + 3 * SLOT); const bf16_t* GATE = (const bf16_t*)(F.ws + WS_RWKS + 5 * SLOT); float* rso = (float*)(F.ws + C_RSO); const float* BON = (const float*)(F.ws + C_BONUS);
    float lg[8], lb[8]; ld8f(in[23] + c8, lg); ld8f(in[24] + c8, lb);
#define POST_ROW(m_, ry, rv, rg, ro, sb_) do { const size_t o_ = (size_t)(m_) * 1024 + c8; float y[8], v[8], g[8], ob[8]; unpack8(ry, y); unpack8(rv, v); unpack8(rg, g); float sm = 0.f; \
        _Pragma("unroll") for (int e = 0; e < 8; ++e) sm += y[e]; \
        sm = red8(sm) * (1.f / 64.f); float sv = 0.f; \
        _Pragma("unroll") for (int e = 0; e < 8; ++e) { y[e] -= sm; sv += y[e] * y[e]; } \
        sv = red8(sv) * (1.f / 64.f); const float rstd = rsqrtf(sv + 64e-5f); \
        _Pragma("unroll") for (int e = 0; e < 8; ++e) ob[e] = (y[e] * rstd * lg[e] + lb[e] + (sb_) * v[e]) * g[e]; \
        *(u32x4*)(OB + o_) = pack8(ob); \
        float oa[8]; unpack8(ro, oa); float so = 0.f; \
        _Pragma("unroll") for (int e = 0; e < 8; ++e) so += oa[e] * oa[e]; \
        so = red16(so); if ((F.tid & 15) == 0) rso[(m_) * 8 + (c8 >> 7)] = rsqrtf(so * (1.f / 128.f) + EPS); } while (0)
    const int mstep = F.G * 4;
    for (int m = F.bid * 4 + (F.tid >> 7); m < M; m += 2 * mstep) {
        const int m2 = m + mstep; const bool two = m2 < M; const int mb_ = two ? m2 : m; const size_t oa_ = (size_t)m * 1024 + c8, ob_ = (size_t)mb_ * 1024 + c8;
        const u32x4 y0 = *(const u32x4*)(YR + oa_), v0 = *(const u32x4*)(S2 + oa_), g0 = *(const u32x4*)(GATE + oa_), r0 = *(const u32x4*)(ORW + oa_);
        const u32x4 y1 = *(const u32x4*)(YR + ob_), v1 = *(const u32x4*)(S2 + ob_), g1 = *(const u32x4*)(GATE + ob_), r1 = *(const u32x4*)(ORW + ob_);
        const float sb0 = BON[(size_t)m * 16 + (c8 >> 6)], sb1 = BON[(size_t)mb_ * 16 + (c8 >> 6)];
        POST_ROW(m, y0, v0, g0, r0, sb0);
        if (two) POST_ROW(m2, y1, v1, g1, r1, sb1);
    }
#undef POST_ROW
}
DI void ph_final(Frame& F) {
    const float* ss3 = (const float*)(F.ws + C_SS3); const bf16_t* X3 = (const bf16_t*)(F.ws + WS_RWKS + 2 * SLOT); const int gw = F.bid * 8 + F.wave, NGW = F.G * 8;
    float g[4][8];
    { const float* gf = KIn{}[34];
#pragma unroll
      for (int j = 0; j < 4; ++j) ld8f(gf + 8 * (F.lane + 64 * j), g[j]); }
    for (int m = gw; m < M; m += 2 * NGW) { const int m2 = m + NGW; const bool two = m2 < M; const int mb_ = two ? m2 : m;
        u32x4 ra[4], rb[4];
#pragma unroll
        for (int j = 0; j < 4; ++j) { ra[j] = *(const u32x4*)(X3 + (size_t)m * DM + 8 * (F.lane + 64 * j)); rb[j] = *(const u32x4*)(X3 + (size_t)mb_ * DM + 8 * (F.lane + 64 * j)); }
        const float rsa = rsqrtf(ss3[m] * (1.f / DM) + EPS), rsb = rsqrtf(ss3[mb_] * (1.f / DM) + EPS);
#pragma unroll
        for (int j = 0; j < 4; ++j) { float v[8]; unpack8(ra[j], v);
#pragma unroll
            for (int e = 0; e < 8; ++e) v[e] = v[e] * rsa * g[j][e];
            st8f(F.out + (size_t)m * DM + 8 * (F.lane + 64 * j), v); }
        if (two) {
#pragma unroll
            for (int j = 0; j < 4; ++j) { float v[8]; unpack8(rb[j], v);
#pragma unroll
                for (int e = 0; e < 8; ++e) v[e] = v[e] * rsb * g[j][e];
                st8f(F.out + (size_t)m2 * DM + 8 * (F.lane + 64 * j), v); } }
    }
}

typedef __attribute__((address_space(1))) unsigned gu32;
#define XB_TMO      128
#define XB_XCNT(j)  (256  + 64 * (j))
#define XB_XSUB(j)  (1280 + 64 * (j))
#define XB_XGEN(j)  (2304 + 64 * (j))
#define XB_TOP      3328
#define XB_TOPGEN   3392
#define XCD_BAR_WORDS 3456
#define XB_SPIN_CAP (1u << 18)

__device__ __forceinline__ unsigned xb_ld(unsigned* p)              { return __hip_atomic_load(p, __ATOMIC_RELAXED, __HIP_MEMORY_SCOPE_AGENT); }
__device__ __forceinline__ unsigned xb_add(unsigned* p, unsigned v) { return __hip_atomic_fetch_add(p, v, __ATOMIC_RELAXED, __HIP_MEMORY_SCOPE_AGENT); }
__device__ __forceinline__ unsigned xb_xcc_id() { return (unsigned)__builtin_amdgcn_s_getreg((3 << 11) | 20) & 0xFu; }
#define XB_SPIN(cond, bar) do { unsigned _sp = 0; while (cond) { __builtin_amdgcn_s_sleep(1); \
    if ((++_sp & 255u) == 0u) { if (xb_ld(&(bar)[XB_TMO])) break; if (_sp > XB_SPIN_CAP) { atomicAdd(&(bar)[XB_TMO], 1u); break; } } } } while (0)

struct XcdBarrier {
    unsigned* bar; unsigned x;
    volatile LAS unsigned* st;
};

__device__ __forceinline__ XcdBarrier xcd_barrier_post(unsigned* bar, volatile LAS unsigned* st, int tid) {
    XcdBarrier b; b.bar = bar; b.x = xb_xcc_id(); b.st = st;
    if (tid == 0) (void)xb_add(&bar[XB_XCNT(b.x)], 1u);
    return b;
}
__device__ __forceinline__ void xcd_barrier_complete(unsigned* bar, unsigned x, unsigned& nloc, unsigned& nx) {
    const unsigned G = gridDim.x * gridDim.y * gridDim.z;
    unsigned sum, cnt, mine, sp = 0u;
    for (;;) {
        sum = 0u; cnt = 0u; mine = 0u;
#pragma unroll
        for (unsigned j = 0; j < 16; ++j) { const unsigned c = xb_ld(&bar[XB_XCNT(j)]); sum += c; cnt += (c > 0u) ? 1u : 0u; mine = (j == x) ? c : mine; }
        if (sum == G) break;
        __builtin_amdgcn_s_sleep(1);
        if ((++sp & 255u) == 0u) { if (xb_ld(&bar[XB_TMO])) break; if (sp > XB_SPIN_CAP) { atomicAdd(&bar[XB_TMO], 1u); break; } }
    }
    nloc = mine > 0u ? mine : 1u; nx = cnt > 0u ? cnt : 1u;
}

__device__ __forceinline__ void xcd_barrier(const XcdBarrier& b, int tid) {
    asm volatile("s_waitcnt vmcnt(0)" ::: "memory");
    __syncthreads();
    if (tid == 0) {
        unsigned* bar = b.bar;
        __builtin_amdgcn_s_waitcnt(0);
        unsigned nloc = b.st[0], nx = b.st[1];
        if (nloc == 0u) { xcd_barrier_complete(bar, b.x, nloc, nx); b.st[0] = nloc; b.st[1] = nx; }
        const unsigned old = xb_add(&bar[XB_XSUB(b.x)], 1u);
        const unsigned gen = old / nloc;
        if (old + 1u == (gen + 1u) * nloc) {
            __builtin_amdgcn_fence(__ATOMIC_RELEASE, "agent");
            asm volatile("s_waitcnt vmcnt(0)" ::: "memory");
            const unsigned og = xb_add(&bar[XB_TOP], 1u);
            const unsigned tg = og / nx;
            if (og + 1u == (tg + 1u) * nx) xb_add(&bar[XB_TOPGEN], 1u);
            else XB_SPIN(xb_ld(&bar[XB_TOPGEN]) == tg, bar);
            __builtin_amdgcn_fence(__ATOMIC_ACQUIRE, "agent");
            xb_add(&bar[XB_XGEN(b.x)], 1u);
            asm volatile("s_waitcnt vmcnt(0)" ::: "memory");
        } else {
            XB_SPIN(xb_ld(&bar[XB_XGEN(b.x)]) == gen, bar);
            __builtin_amdgcn_fence(__ATOMIC_ACQUIRE, "agent");
            asm volatile("s_waitcnt vmcnt(0)" ::: "memory");
        }
    }
    __syncthreads();
}

constexpr int N_PHASES = 16;
__global__ void __launch_bounds__(512, 2) mk_fwd(Args a) {
    extern __shared__ __attribute__((aligned(16))) unsigned char lds_raw[];
    cg::grid_group grid = cg::this_grid();
    const int wave0 = __builtin_amdgcn_readfirstlane(threadIdx.x >> 6);
    Frame F; F.lds = (LAS unsigned char*)lds_raw; F.tid = threadIdx.x; F.lane = F.tid & 63; F.wave = __builtin_amdgcn_readfirstlane(F.tid >> 6); F.G = gridDim.x; F.bid = blockIdx.x;
    F.out = a.out; F.ws = a.ws; F.dob = (unsigned char*)a.out;
    unsigned char* ws = a.ws; unsigned char* gt = ws + WS_GTAIL; float* nul = nullptr;
    volatile LAS unsigned* bst = (volatile LAS unsigned*)(F.lds + LDS_BYTES - 16);
    if (F.tid < 2) bst[F.tid] = 0u;
    __syncthreads();
    XcdBarrier bar; bar.bar = (unsigned*)ws; bar.x = 0; bar.st = bst;
    if (a.ph_hi - a.ph_lo > 1) bar = xcd_barrier_post((unsigned*)ws, bst, F.tid);
    bf16_t* PROJ = (bf16_t*)(ws + WS_PROJ);
    const int lo = a.ph_lo, hi = a.ph_hi;
    if (lo < 0) grid.sync();
#ifndef PHMASK
#define PHMASK 0xFFFF
#endif
#define IN(k) (((PHMASK >> (k)) & 1) && lo <= (k) && (k) < hi)
#define RG(A_, B_, N_, K_, f_, fb_) do { const bool sf_ = F.G == 256 && ((fb_) == 0 ? (F.bid & 1) != 0 : F.bid >= (fb_)); \
        _Pragma("unroll 1") for (int ps_ = 0; ps_ < 2; ++ps_) { \
            if ((ps_ == 0) == sf_) { sample_gemm_any(F, A_, B_, N_, K_, f_, fb_); REFRESH(); __syncthreads(); } \
            else { run_gemm(F, A_, B_, MP, N_, K_, f_); REFRESH(); __syncthreads(); } } } while (0)
#define REFRESH() do { int t_; asm volatile("v_mbcnt_lo_u32_b32 %0, -1, 0\n\tv_mbcnt_hi_u32_b32 %0, -1, %0\n\tv_lshl_add_u32 %0, %1, 6, %0" : "=&v"(t_) : "s"(wave0)); F.tid = t_; F.lane = t_ & 63; F.wave = __builtin_amdgcn_readfirstlane(t_ >> 6); } while (0)
#define SEAM(k) do { if (IN(k) && IN((k) + 1)) { REFRESH(); xcd_barrier(bar, F.tid); } { int t_; asm volatile("v_mbcnt_lo_u32_b32 %0, -1, 0\n\tv_mbcnt_hi_u32_b32 %0, -1, %0\n\tv_lshl_add_u32 %0, %1, 6, %0" : "=&v"(t_) : "s"(wave0)); F.tid = t_; F.lane = t_ & 63; F.wave = __builtin_amdgcn_readfirstlane(t_ >> 6); } } while (0)
    if (IN(0)) { ph0(F); } SEAM(0);
    if (IN(1)) { { const auto f_ = FStore{nul, PROJ, NAB}; RG((const bf16_t*)(ws + WS_RWKS), (const bf16_t*)(ws + WS_RWKS + 2 * SLOT), NAB, DM, f_, (F.G == 256 ? 128 : 0)); }
                 if (F.G != 256 || F.bid >= 128) { Frame F2 = F; if (F.G == 256) { F2.bid = F.bid - 128; F2.G = 128; } REFRESH(); __syncthreads(); conv_range(F2, 3, 5); } } SEAM(1);
    if (IN(2)) { ph2a(F); } SEAM(2);
    if (IN(5)) { ph_cprep_gdn(F); REFRESH(); ph_cprep_rwkv(F); REFRESH(); if (hi - lo > 1) xcd_barrier(bar, F.tid); REFRESH(); ph_cscan(F); } SEAM(5);
    if (IN(7)) { ph_post(F); } SEAM(7);
    if (IN(8)) { { const auto f_ = FGates{nul, (const bf16_t*)(ws + WS_ORAW), (const float*)(ws + C_RSO), KIn{}[13], (bf16_t*)(ws + WS_RWKS + 2 * SLOT), (bf16_t*)(ws + WS_RWKS), (bf16_t*)(ws + WS_RWKS + 4 * SLOT)}; RG((const bf16_t*)(F.dob + DO_H), (const bf16_t*)(F.dob + DO_WC), NC, DM, f_, 0); } } SEAM(8);
    if (IN(9)) { const bf16_t* OA_ = (const bf16_t*)(ws + WS_RWKS + 2 * SLOT); const bf16_t* OB_ = (const bf16_t*)(ws + WS_RWKS + 3 * SLOT); const bf16_t* GMA_ = (const bf16_t*)(ws + WS_RWKS); const bf16_t* GMB_ = (const bf16_t*)(ws + WS_RWKS + 4 * SLOT);
                 bf16_t* MG_ = (bf16_t*)(ws + WS_PROJ + 136314880);
                 const bool sf9_ = F.G == 256 && (F.bid & 1);
#pragma unroll 1
                 for (int ps_ = 0; ps_ < 2; ++ps_) {
                     if ((ps_ == 0) == sf9_) {
                         { const auto f_ = FUpA{nul, GMA_, (float*)(ws + WS_PROJ)}; sample_gemm(F, OA_, (const bf16_t*)(gt + GT_UPA), DM, 1024, f_, 0); REFRESH(); __syncthreads(); }
                         { const auto f_ = FUpB{nul, GMB_, (const float*)(ws + WS_PROJ), MG_}; sample_gemm(F, OB_, (const bf16_t*)(gt + GT_UPB), DM, 1024, f_, 0); REFRESH(); __syncthreads(); } }
                     else { run_gemm_up2(F, OA_, (const bf16_t*)(gt + GT_UPA), OB_, (const bf16_t*)(gt + GT_UPB), MP, DM, 1024, EpiUp2{GMA_, GMB_, MG_}); REFRESH(); __syncthreads(); } } } SEAM(9);
    if (IN(10)) { const bool cf_ = !(F.G == 256 && (F.bid & 1));
#pragma unroll 1
                 for (int pc_ = 0; pc_ < 2; ++pc_) {
                     if ((pc_ == 0) == cf_) { __syncthreads(); conv_range(F, 10, 12); __syncthreads(); REFRESH(); }
                     else { const auto f_ = FRes{(float*)(ws + C_SS1), KIn{}[0], KIn{}[1], (bf16_t*)(ws + WS_RWKS)}; RG((const bf16_t*)(ws + WS_PROJ + 136314880), (const bf16_t*)(gt + GT_WO), DM, DM, f_, 0); REFRESH(); __syncthreads(); } } } SEAM(10);
    if (IN(11)) { { const auto f_ = FFf1{nul, (const float*)(ws + C_SS1), PROJ}; RG((const bf16_t*)(ws + WS_RWKS), (const bf16_t*)(ws + WS_RWKS + 2 * SLOT), DFF, DM, f_, 0); } } SEAM(11);
    if (IN(12)) { const bool pf_ = F.G == 256 && (F.bid & 2);
#pragma unroll 1
                 for (int pq_ = 0; pq_ < 2; ++pq_) {
                     if ((pq_ == 0) == pf_) { const auto f_ = FStore{nul, (bf16_t*)(ws + WS_RWKS + 4 * SLOT), DM}; RG((const bf16_t*)(gt + GT_PB), (const bf16_t*)(gt + GT_PLE), DM, DPLE, f_, 0); REFRESH(); __syncthreads(); }
                     else { const auto f_ = FRes2{(float*)(ws + C_SS2), (bf16_t*)(ws + WS_RWKS)}; RG(PROJ, (const bf16_t*)(ws + WS_RWKS + 3 * SLOT), DM, DFF, f_, 0); REFRESH(); __syncthreads(); } } } SEAM(12);
    if (IN(14)) { { const auto f_ = FPg{(float*)(ws + C_SS3), (const float*)(ws + C_SS2), (const bf16_t*)(ws + WS_RWKS + 4 * SLOT), (bf16_t*)(ws + WS_RWKS + 2 * SLOT), (const bf16_t*)(ws + WS_RWKS)}; RG((const bf16_t*)(ws + WS_RWKS), (const bf16_t*)(gt + GT_PG), DM, DM, f_, 0); } } SEAM(14);
    if (IN(15)) { ph_final(F); }
#undef IN
#undef SEAM
}

#ifndef MK_MULTI
#define MK_MULTI 0
#endif
extern "C" void kernel_launch(void* const* d_in, const int* in_sizes, int n_in, void* d_out, int out_size, void* d_ws, size_t ws_size, hipStream_t stream) {
    static int grid = 0;
    if (grid == 0) {
        if (n_in != 35 || out_size != (int)O_END || ws_size < WS_NEED) { fprintf(stderr, "kernel_launch: unexpected problem: n_in %d out %d ws %zu (need %zu)\n", n_in, out_size, ws_size, (size_t)WS_NEED); grid = -1; return; }
        int dev = 0, cus = 0, per_cu = 0;
        hipGetDevice(&dev); hipDeviceGetAttribute(&cus, hipDeviceAttributeMultiprocessorCount, dev);
        if (hipFuncSetAttribute((const void*)mk_fwd, hipFuncAttributeMaxDynamicSharedMemorySize, LDS_BYTES) != hipSuccess) { fprintf(stderr, "kernel_launch: hipFuncSetAttribute failed\n"); grid = -1; return; }
        if (hipOccupancyMaxActiveBlocksPerMultiprocessor(&per_cu, (const void*)mk_fwd, 512, LDS_BYTES) != hipSuccess || per_cu < 1) { fprintf(stderr, "kernel_launch: occupancy query says %d\n", per_cu); per_cu = 1; }
        (void)hipGetLastError();
        grid = cus * per_cu; if (grid > 256) grid = 256;
        fprintf(stderr, "kernel_launch: cus %d per_cu %d grid %d ws %zu\n", cus, per_cu, grid, ws_size);
    }
    if (grid < 0) return;
    (void)hipMemsetAsync(d_ws, 0, 65536, stream);
    Args a{};
    for (int i = 0; i < 35; ++i) a.in[i] = (const float*)d_in[i];
    a.out = (float*)d_out; a.ws = (unsigned char*)d_ws;
#if MK_MULTI
    for (int ph = 0; ph < N_PHASES; ++ph) { a.ph_lo = ph; a.ph_hi = ph + 1; hipLaunchKernelGGL(mk_fwd, dim3(grid), dim3(512), LDS_BYTES, stream, a); }
#else
    a.ph_lo = 0; a.ph_hi = N_PHASES; void* args[] = {&a};
    hipError_t e = hipLaunchCooperativeKernel((const void*)mk_fwd, dim3(grid), dim3(512), args, LDS_BYTES, stream);
    if (e != hipSuccess) fprintf(stderr, "kernel_launch: cooperative launch failed: %s (grid %d)\n", hipGetErrorString(e), grid);
#endif
}
```

```cpp
#include <hip/hip_runtime.h>
#include <hip/hip_cooperative_groups.h>
#include <cstdio>
#include <cstdint>
namespace cg = cooperative_groups;
namespace pg8 {
#define PG8_LAS __attribute__((address_space(3)))
typedef unsigned short bf16_t;
typedef short bf16x8 __attribute__((ext_vector_type(8)));
typedef float f32x4 __attribute__((ext_vector_type(4)));
typedef unsigned u32x4 __attribute__((ext_vector_type(4)));
constexpr int BM = 256, BK = 64, HALF = 128, HTB = HALF * BK * 2  , STAGE_BYTES = 8 * HTB, NXCD = 8, WGM = 8;

__host__ __device__ __forceinline__ int lds_byte(int r, int c) { const int st = (r >> 4) * 2 + (c >> 5), rr = r & 15, cc = c & 31, ob = rr * 64 + cc * 2; return st * 1024 + (ob ^ (((ob >> 9) & 1) << 5)); }
__host__ __device__ __forceinline__ void stage_rc(int b, int& R, int& C) { const int st = b / 1024, sb = b % 1024, swz = sb ^ (((sb >> 9) & 1) << 5); R = (st >> 1) * 16 + swz / 64; C = (st & 1) * 32 + (swz % 64) / 2; }
__host__ __device__ __forceinline__ int perm32(int rho) { const int n = rho >> 4, i = rho & 15; return 8 * (i >> 2) + 4 * n + (i & 3); }

struct Unit { int pm, pn, seg; };
struct Gemm { const bf16_t* A; const bf16_t* Bt; int M, N, K; const bf16_t* A2; const bf16_t* Bt2; };

struct StaticOrder {
    int nM, nN, nwg, G, c, wgm;
    __host__ __device__ void init(int M, int N, int G_, int c_, int wgm_ = WGM) { nM = M / BM; nN = N / BM; nwg = nM * nN; G = G_; c = c_; wgm = wgm_; }
    __host__ __device__ bool next(int i, Unit& u) const {
        const long L = (long)i * G + c; if (L >= nwg) return false;
        int wgid = (int)L; { const int q = nwg / NXCD, r = nwg % NXCD, xcd = wgid % NXCD, off = wgid / NXCD; wgid = (xcd < r ? xcd * (q + 1) : r * (q + 1) + (xcd - r) * q) + off; }
        const int nig = wgm * nN, gid = wgid / nig, fm = gid * wgm, gsz = (nM - fm) < wgm ? (nM - fm) : wgm;
        u.pm = fm + ((wgid % nig) % gsz); u.pn = (wgid % nig) / gsz; u.seg = 0; return true;
    }
    __device__ __forceinline__ void a_ready(const Unit&) const {}
    __device__ __forceinline__ void done(const Unit&) const {}
};
typedef float f32x2_cv __attribute__((ext_vector_type(2)));
typedef __bf16 bf16x2_cv __attribute__((ext_vector_type(2)));
struct StaticOrder2 : StaticOrder { __host__ __device__ bool next(int i, Unit& u) const { if (!StaticOrder::next(i >> 1, u)) return false; u.seg = i & 1; return true; } };
__device__ __forceinline__ unsigned cvt_pk_bf16(float lo, float hi) { const f32x2_cv v = {lo, hi}; return __builtin_bit_cast(unsigned, __builtin_convertvector(v, bf16x2_cv)); }
typedef float f32x2 __attribute__((ext_vector_type(2)));
template <class Epi, class Sched, bool ALIGN_EPI = false, bool SP2 = false, bool TWOSEG = false>
__device__ __forceinline__ void gemm_phase(PG8_LAS unsigned char* lds, const Gemm g, const Sched& S, const Epi& E, const int tid_in) {
    int tid_ = tid_in; asm volatile("" : "+v"(tid_));
    const int tid = tid_, wid = __builtin_amdgcn_readfirstlane(tid >> 6), lane = tid & 63, wr = wid >> 2, wc = wid & 3, fr = lane & 15, fq = lane >> 4;
    const int K = g.K, nt = K / BK;
    unsigned voffA[2], voffB[2];
#pragma unroll
    for (int i = 0; i < 2; ++i) { int R, C; stage_rc(tid * 16 + i * 8192, R, C); const int Rb = Epi::PERM ? ((R & ~31) + perm32(R & 31)) : R;
        voffA[i] = (unsigned)(R * K + C) * 2u; voffB[i] = (unsigned)(Rb * K + C) * 2u; }
    const size_t kstep = (size_t)(BK * 2);
    const size_t hstep = (size_t)HALF * K * 2;
    const size_t tstep = 2 * hstep;
    const unsigned ldsw = (unsigned)wid * 1024u;
    const int aoff = lds_byte(wr * 64 + fr, fq * 8), boff = lds_byte(wc * 32 + fr, fq * 8);
#define PG8_SA(b, h) (((b) * 2 + (h)) * HTB)
#define PG8_SB(b, h) ((4 + (b) * 2 + (h)) * HTB)
#define PG8_STAGE(bufoff, gbase, voff) do { _Pragma("unroll") for (int _i = 0; _i < 2; ++_i) \
        __builtin_amdgcn_global_load_lds((const unsigned*)((const char*)(gbase) + (voff)[_i]), (PG8_LAS unsigned*)(lds + (bufoff) + ldsw + _i * 8192), 16, 0, 0); } while (0)
#define PG8_LDA(dst, b, h) do { _Pragma("unroll") for (int m = 0; m < 4; ++m) _Pragma("unroll") for (int k = 0; k < 2; ++k) dst[m][k] = *(const PG8_LAS bf16x8*)(lds + PG8_SA(b, h) + aoff + m * 2048 + k * 1024); } while (0)
#define PG8_LDB(dst, b, h) do { _Pragma("unroll") for (int n = 0; n < 2; ++n) _Pragma("unroll") for (int k = 0; k < 2; ++k) dst[n][k] = *(const PG8_LAS bf16x8*)(lds + PG8_SB(b, h) + boff + n * 2048 + k * 1024); } while (0)
#define PG8_MMA(ai, bj, At, Bt) do { __builtin_amdgcn_s_setprio(1); _Pragma("unroll") for (int m = 0; m < 4; ++m) _Pragma("unroll") for (int n = 0; n < 2; ++n) _Pragma("unroll") for (int k = 0; k < 2; ++k) \
        acc[ai][bj][m][n] = __builtin_amdgcn_mfma_f32_16x16x32_bf16(Bt[n][k], At[m][k], acc[ai][bj][m][n], 0, 0, 0); __builtin_amdgcn_s_setprio(0); } while (0)
#define PG8_WAIT_V(n) asm volatile("s_waitcnt vmcnt(" #n ")" ::: "memory")
#define PG8_WAIT_L(n) asm volatile("s_waitcnt lgkmcnt(" #n ")" ::: "memory")
#define PG8_BAR __builtin_amdgcn_s_barrier()
#define PG8_SCHED __builtin_amdgcn_sched_barrier(0)
    Unit cur, nxt; int ui = 0;
    if (!S.next(0, cur)) return;
    f32x4 acc[2][2][4][2];
#pragma unroll
    for (int a = 0; a < 2; ++a)
#pragma unroll
        for (int b = 0; b < 2; ++b)
#pragma unroll
            for (int m = 0; m < 4; ++m)
#pragma unroll
                for (int n = 0; n < 2; ++n) acc[a][b][m][n] = (f32x4){0.f, 0.f, 0.f, 0.f};
    bf16x8 At[4][2], B0[2][2], B1[2][2];
    const char* cA = (const char*)((TWOSEG && cur.seg) ? g.A2 : g.A) + (size_t)cur.pm * tstep; const char* cB = (const char*)((TWOSEG && cur.seg) ? g.Bt2 : g.Bt) + (size_t)cur.pn * tstep;
    S.a_ready(cur);
    if constexpr (SP2) {
        PG8_STAGE(PG8_SB(0, 0), cB, voffB); PG8_STAGE(PG8_SB(0, 1), cB + hstep, voffB); PG8_STAGE(PG8_SA(0, 0), cA, voffA); PG8_STAGE(PG8_SA(0, 1), cA + hstep, voffA);
        if (wr == 1) PG8_BAR;
        PG8_WAIT_V(2); PG8_BAR;
        PG8_STAGE(PG8_SB(1, 0), cB + kstep, voffB); PG8_STAGE(PG8_SA(1, 0), cA + kstep, voffA); PG8_STAGE(PG8_SB(1, 1), cB + hstep + kstep, voffB);
        PG8_WAIT_V(6); PG8_BAR;
    } else {
        PG8_STAGE(PG8_SB(0, 0), cB, voffB); PG8_STAGE(PG8_SA(0, 0), cA, voffA); PG8_STAGE(PG8_SB(0, 1), cB + hstep, voffB); PG8_STAGE(PG8_SA(0, 1), cA + hstep, voffA);
        if (wr == 1) PG8_BAR;
        PG8_WAIT_V(4); PG8_BAR;
        PG8_STAGE(PG8_SB(1, 0), cB + kstep, voffB); PG8_STAGE(PG8_SA(1, 0), cA + kstep, voffA); PG8_STAGE(PG8_SB(1, 1), cB + hstep + kstep, voffB);
        PG8_WAIT_V(6); PG8_BAR;
    }
    for (;;) {
        const bool has_next = S.next(ui + 1, nxt);
        const char* nA = has_next ? (const char*)((TWOSEG && nxt.seg) ? g.A2 : g.A) + (size_t)nxt.pm * tstep : cA; const char* nB = has_next ? (const char*)((TWOSEG && nxt.seg) ? g.Bt2 : g.Bt) + (size_t)nxt.pn * tstep : cB;
        for (int t = 0; t < nt; t += 2) {
            const bool last = (t == nt - 2);
            const char* a1 = cA + (size_t)(t + 1) * kstep;
            const char* a2 = last ? nA : cA + (size_t)(t + 2) * kstep; const char* b2 = last ? nB : cB + (size_t)(t + 2) * kstep;
            const char* a3 = a2 + kstep; const char* b3 = b2 + kstep;
            if (last && has_next) S.a_ready(nxt);
            if constexpr (SP2) {
            PG8_LDB(B0, 0, 0); PG8_LDB(B1, 0, 1); PG8_SCHED; PG8_LDA(At, 0, 0); PG8_STAGE(PG8_SA(1, 1), a1 + hstep, voffA);
            PG8_WAIT_V(8); PG8_WAIT_L(0); PG8_BAR; PG8_MMA(0, 0, At, B0); PG8_MMA(0, 1, At, B1); PG8_BAR; PG8_SCHED;
            PG8_LDA(At, 0, 1); PG8_STAGE(PG8_SB(0, 0), b2, voffB); PG8_STAGE(PG8_SB(0, 1), b2 + hstep, voffB); PG8_STAGE(PG8_SA(0, 0), a2, voffA);
            PG8_WAIT_V(8); PG8_WAIT_L(0); PG8_BAR; PG8_MMA(1, 0, At, B0); PG8_MMA(1, 1, At, B1); PG8_BAR; PG8_SCHED;
            PG8_LDB(B0, 1, 0); PG8_LDB(B1, 1, 1); PG8_SCHED; PG8_LDA(At, 1, 0); PG8_STAGE(PG8_SA(0, 1), a2 + hstep, voffA);
            PG8_WAIT_V(8); PG8_WAIT_L(0); PG8_BAR; PG8_MMA(0, 0, At, B0); PG8_MMA(0, 1, At, B1); PG8_BAR; PG8_SCHED;
            PG8_LDA(At, 1, 1); PG8_STAGE(PG8_SB(1, 0), b3, voffB); PG8_STAGE(PG8_SB(1, 1), b3 + hstep, voffB); PG8_STAGE(PG8_SA(1, 0), a3, voffA);
            PG8_WAIT_V(8); PG8_WAIT_L(0); PG8_BAR; PG8_MMA(1, 0, At, B0); PG8_MMA(1, 1, At, B1); PG8_BAR; PG8_SCHED;
            } else {
            PG8_LDB(B0, 0, 0); PG8_SCHED; PG8_LDA(At, 0, 0); PG8_STAGE(PG8_SA(1, 1), a1 + hstep, voffA);
            PG8_WAIT_L(8); PG8_BAR; PG8_WAIT_L(0); PG8_MMA(0, 0, At, B0); PG8_BAR; PG8_SCHED;
            PG8_LDB(B1, 0, 1); PG8_STAGE(PG8_SB(0, 0), b2, voffB);
            PG8_BAR; PG8_WAIT_L(0); PG8_MMA(0, 1, At, B1); PG8_BAR;
            PG8_LDA(At, 0, 1); PG8_STAGE(PG8_SA(0, 0), a2, voffA);
            PG8_BAR; PG8_WAIT_L(0); PG8_MMA(1, 0, At, B0); PG8_BAR; PG8_SCHED;
            PG8_STAGE(PG8_SB(0, 1), b2 + hstep, voffB);
            PG8_WAIT_V(6); PG8_BAR; PG8_MMA(1, 1, At, B1); PG8_BAR;
            PG8_LDB(B0, 1, 0); PG8_SCHED; PG8_LDA(At, 1, 0); PG8_STAGE(PG8_SA(0, 1), a2 + hstep, voffA);
            PG8_WAIT_L(8); PG8_BAR; PG8_WAIT_L(0); PG8_MMA(0, 0, At, B0); PG8_BAR; PG8_SCHED;
            PG8_LDB(B1, 1, 1); PG8_STAGE(PG8_SB(1, 0), b3, voffB);
            PG8_BAR; PG8_WAIT_L(0); PG8_MMA(0, 1, At, B1); PG8_BAR;
            PG8_LDA(At, 1, 1); PG8_STAGE(PG8_SA(1, 0), a3, voffA);
            PG8_BAR; PG8_WAIT_L(0); PG8_MMA(1, 0, At, B0); PG8_BAR; PG8_SCHED;
            PG8_STAGE(PG8_SB(1, 1), b3 + hstep, voffB);
            PG8_WAIT_V(6); PG8_BAR; PG8_MMA(1, 1, At, B1); PG8_BAR;
            }
        }
        if constexpr (ALIGN_EPI) { if (wr == 0) PG8_BAR; }
        if constexpr (TWOSEG) { if (cur.seg == 0) E.mid(acc, cur, wr, wc, fr, fq); else E(acc, cur, wr, wc, fr, fq); }
        else if constexpr (!Epi::AFTER_DRAIN) { E(acc, cur, wr, wc, fr, fq); S.done(cur); }
        if (!has_next) break;
        if (!(TWOSEG && cur.seg == 0))
#pragma unroll
        for (int a = 0; a < 2; ++a)
#pragma unroll
            for (int b = 0; b < 2; ++b)
#pragma unroll
                for (int m = 0; m < 4; ++m)
#pragma unroll
                    for (int n = 0; n < 2; ++n) acc[a][b][m][n] = (f32x4){0.f, 0.f, 0.f, 0.f};
        cur = nxt; cA = nA; cB = nB; ++ui;
        if constexpr (ALIGN_EPI) { if (wr == 1) PG8_BAR; }
    }
    PG8_WAIT_V(0);
    if constexpr (!ALIGN_EPI) { if (wr == 0) PG8_BAR; }
    PG8_BAR;
    if constexpr (Epi::AFTER_DRAIN) { E.fused(acc, cur, wr, wc, fr, fq, lds, wid, lane); S.done(cur); }
#undef PG8_SA
#undef PG8_SB
#undef PG8_STAGE
#undef PG8_LDA
#undef PG8_LDB
#undef PG8_MMA
#undef PG8_WAIT_V
#undef PG8_WAIT_L
#undef PG8_BAR
#undef PG8_SCHED
}
}

using pg8::bf16_t; using pg8::f32x4; using pg8::u32x4; using pg8::Unit;
#define LAS __attribute__((address_space(3)))
#define DI __device__ __forceinline__
typedef unsigned u32x2 __attribute__((ext_vector_type(2)));
typedef LAS f32x4* lds_f4p;
typedef LAS bf16_t* lbf;
typedef const LAS bf16_t* clbf;
typedef short s16x8 __attribute__((ext_vector_type(8)));
#define LDSYNC() do { asm volatile("s_waitcnt lgkmcnt(0)" ::: "memory"); __syncthreads(); } while (0)

constexpr int DM = 2048, MP = 16384, M = 16640, NAB = 6656, NC = 5120, DFF = 8192, DPLE = 256;
constexpr float EPS = 1e-6f;
constexpr size_t O_SGP = 34078720, O_BUFP = 34603008, O_SRP = 34639872, O_SHP = 34902016, O_SGS = 34916096, O_BUFS = 35964672, O_SRS = 36038400, O_SHS = 36562688, O_END = 36590848;
constexpr size_t DO_H = 0, DO_WC = 68157440, DO_WAB = 89128960, DO_AL2 = 116391936, DO_AG = 124911616;
constexpr size_t C_SS1 = 0x10000, C_SS2 = 0x30000, C_SS3 = 0x50000, C_RSO = 0x80000, C_GA = 0x110000, C_GB = 0x1A0000, C_WL2T = 0x230000, C_G2T = 0x330000;
constexpr size_t WS_PROJ = 6291456, WS_GDNS = 227803136, WS_RWKS = 330039296, SLOT = 34078720, WS_NEED = 534511616;
constexpr size_t WS_GTAIL = WS_GDNS + 67502080;
constexpr size_t GT_UPA = 0, GT_UPB = 4194304, GT_WO = 8388608, GT_PG = 16777216, GT_PLE = 25165824, GT_PB = 26214400;
constexpr int LDS_BYTES = 163840;

struct Args { const float* in[35]; float* out; unsigned char* ws; int ph_lo, ph_hi; };

struct Frame {
    LAS unsigned char* lds; int tid, lane, wave, G, bid;
    float* out; unsigned char* ws; unsigned char* dob;
};
struct KIn { DI const float* operator[](int i) const { return ((const float* const volatile __attribute__((address_space(4)))*)__builtin_amdgcn_kernarg_segment_ptr())[i]; } };

DI float bf2f(unsigned short b) { return __uint_as_float((unsigned)b << 16); }
DI void unpack8(const u32x4 w, float (&f)[8]) {
    f[0] = __uint_as_float(w.x << 16); f[1] = __uint_as_float(w.x & 0xffff0000u); f[2] = __uint_as_float(w.y << 16); f[3] = __uint_as_float(w.y & 0xffff0000u);
    f[4] = __uint_as_float(w.z << 16); f[5] = __uint_as_float(w.z & 0xffff0000u); f[6] = __uint_as_float(w.w << 16); f[7] = __uint_as_float(w.w & 0xffff0000u);
}
DI u32x4 pack8(const float (&f)[8]) { u32x4 w; w.x = pg8::cvt_pk_bf16(f[0], f[1]); w.y = pg8::cvt_pk_bf16(f[2], f[3]); w.z = pg8::cvt_pk_bf16(f[4], f[5]); w.w = pg8::cvt_pk_bf16(f[6], f[7]); return w; }
DI void ld8l(const LAS float* p, float (&f)[8]) { const f32x4 a = *(const LAS f32x4*)p, b = *(const LAS f32x4*)(p + 4); f[0] = a.x; f[1] = a.y; f[2] = a.z; f[3] = a.w; f[4] = b.x; f[5] = b.y; f[6] = b.z; f[7] = b.w; }
DI void ld8f(const float* p, float (&f)[8]) { const f32x4 a = *(const f32x4*)p, b = *(const f32x4*)(p + 4); f[0] = a.x; f[1] = a.y; f[2] = a.z; f[3] = a.w; f[4] = b.x; f[5] = b.y; f[6] = b.z; f[7] = b.w; }
DI void st8f(float* p, const float (&f)[8]) { *(f32x4*)p = (f32x4){f[0], f[1], f[2], f[3]}; *(f32x4*)(p + 4) = (f32x4){f[4], f[5], f[6], f[7]}; }
DI void ld8f_nt(const float* p, float (&f)[8]) { const f32x4 a = __builtin_nontemporal_load((const f32x4*)p), b = __builtin_nontemporal_load((const f32x4*)(p + 4)); f[0] = a.x; f[1] = a.y; f[2] = a.z; f[3] = a.w; f[4] = b.x; f[5] = b.y; f[6] = b.z; f[7] = b.w; }
DI void st8f_nt(float* p, const float (&f)[8]) { __builtin_nontemporal_store((f32x4){f[0], f[1], f[2], f[3]}, (f32x4*)p); __builtin_nontemporal_store((f32x4){f[4], f[5], f[6], f[7]}, (f32x4*)(p + 4)); }
DI float sigm(float x) { return __builtin_amdgcn_rcpf(1.f + __expf(-x)); }
DI float softplus_(float x) { return x > 20.f ? x : __logf(1.f + __expf(x)); }
DI float tanh_(float x) { return 1.f - 2.f * __builtin_amdgcn_rcpf(1.f + __expf(2.f * x)); }
template <int CTRL> DI float dpp_f(float v) { return __builtin_bit_cast(float, __builtin_amdgcn_update_dpp(0, __builtin_bit_cast(int, v), CTRL, 0xF, 0xF, true)); }
DI float red4(float v) { v += dpp_f<0xB1>(v); v += dpp_f<0x4E>(v); return v; }
DI float red8(float v) { v = red4(v); v += dpp_f<0x141>(v); return v; }
DI float red16(float v) { v = red8(v); v += dpp_f<0x140>(v); return v; }
DI float wave_sum(float v) {
#pragma unroll
    for (int o = 1; o < 64; o <<= 1) v += __shfl_xor(v, o);
    return v;
}
DI int seq_base(int s) { return s < 4 ? s * 4096 : MP + (s - 4) * 32; }
DI int seq_T(int s) { return s < 4 ? 4096 : 32; }

template <class F> struct EpiT {
    static constexpr bool PERM = true, AFTER_DRAIN = false; F f;
    DI void operator()(const f32x4 (&acc)[2][2][4][2], const Unit& u, int wr, int wc, int fr, int fq) const {
#pragma unroll
        for (int ai = 0; ai < 2; ++ai) {
            typename F::L l[4][2];
#pragma unroll
            for (int m = 0; m < 4; ++m)
#pragma unroll
                for (int bj = 0; bj < 2; ++bj) f.pre(u, u.pm * 256 + ai * 128 + wr * 64 + m * 16 + fr, u.pn * 256 + bj * 128 + wc * 32 + fq * 8, l[m][bj]);
#pragma unroll
            for (int m = 0; m < 4; ++m) {
                const int row = u.pm * 256 + ai * 128 + wr * 64 + m * 16 + fr; float ss = 0.f;
#pragma unroll
                for (int bj = 0; bj < 2; ++bj) { const int col = u.pn * 256 + bj * 128 + wc * 32 + fq * 8; ss += f.apply(u, row, col, acc[ai][bj][m][0], acc[ai][bj][m][1], l[m][bj]); }
                if (F::SUMSQ) { ss += __shfl_xor(ss, 16); ss += __shfl_xor(ss, 32); if (fq == 0) unsafeAtomicAdd(f.ssq + row, ss); }
            }
            asm volatile("" ::: "memory");
        }
    }
};
template <class F> DI float apply5(const F& f, const Unit& u, int row, int col, f32x4 v0, f32x4 v1) { typename F::L l; f.pre(u, row, col, l); return f.apply(u, row, col, v0, v1, l); }
DI void v2f(const f32x4 v0, const f32x4 v1, float (&f)[8]) { f[0] = v0.x; f[1] = v0.y; f[2] = v0.z; f[3] = v0.w; f[4] = v1.x; f[5] = v1.y; f[6] = v1.z; f[7] = v1.w; }
struct LNone {};
struct FStore { static constexpr bool SUMSQ = false; float* ssq; bf16_t* O; int ld; typedef LNone L;
    DI void pre(const Unit&, int, int, L&) const {}
    DI float apply(const Unit&, int row, int col, f32x4 v0, f32x4 v1, const L&) const { float v[8]; v2f(v0, v1, v); *(u32x4*)(O + (size_t)row * ld + col) = pack8(v); return 0.f; } };
struct FLora { static constexpr bool SUMSQ = false; float* ssq; bf16_t* O0; bf16_t* O1; typedef LNone L;
    DI void pre(const Unit&, int, int, L&) const {}
    DI float apply(const Unit& u, int row, int col, f32x4 v0, f32x4 v1, const L&) const { float v[8]; v2f(v0, v1, v); bf16_t* O = u.pn < 4 ? O0 : O1; *(u32x4*)(O + (size_t)row * 1024 + (col & 1023)) = pack8(v); return 0.f; } };
struct FGates { static constexpr bool SUMSQ = false; float* ssq; const bf16_t* oraw; const float* rso; const float* normg; bf16_t* OA; bf16_t* Gma; bf16_t* Gmb;
    struct L { u32x4 o; float rs; };
    DI void pre(const Unit& u, int row, int col, L& l) const { if (u.pn < 4) { l.o = *(const u32x4*)(oraw + (size_t)row * 1024 + col); l.rs = rso[row * 8 + (col >> 7)]; } }
    DI float apply(const Unit& u, int row, int col, f32x4 v0, f32x4 v1, const L& l) const {
        float v[8], r[8]; v2f(v0, v1, v);
        if (u.pn < 4) { const int d = col & 127; float o[8], g[8]; unpack8(l.o, o); ld8f(normg + d, g); const float rs = l.rs;
#pragma unroll
            for (int j = 0; j < 8; ++j) r[j] = o[j] * rs * g[j] * v[j] * sigm(v[j]);
            *(u32x4*)(OA + (size_t)row * 1024 + col) = pack8(r);
        } else { const int c2 = col - 1024; bf16_t* G = c2 < 2048 ? Gma : Gmb;
#pragma unroll
            for (int j = 0; j < 8; ++j) r[j] = sigm(v[j]);
            *(u32x4*)(G + (size_t)row * 2048 + (c2 & 2047)) = pack8(r); }
        return 0.f; } };
struct FUpA { static constexpr bool SUMSQ = false; float* ssq; const bf16_t* Gma; float* T1; struct L { u32x4 g; };
    DI void pre(const Unit&, int row, int col, L& l) const { l.g = *(const u32x4*)(Gma + (size_t)row * 2048 + col); }
    DI float apply(const Unit&, int row, int col, f32x4 v0, f32x4 v1, const L& l) const { float v[8], g[8]; v2f(v0, v1, v); unpack8(l.g, g);
#pragma unroll
        for (int j = 0; j < 8; ++j) v[j] *= g[j];
        st8f(T1 + (size_t)row * 2048 + col, v); return 0.f; } };
struct FUpB { static constexpr bool SUMSQ = false; float* ssq; const bf16_t* Gmb; const float* T1; bf16_t* MG; struct L { u32x4 g; f32x4 t0, t1; };
    DI void pre(const Unit&, int row, int col, L& l) const { l.g = *(const u32x4*)(Gmb + (size_t)row * 2048 + col); l.t0 = *(const f32x4*)(T1 + (size_t)row * 2048 + col); l.t1 = *(const f32x4*)(T1 + (size_t)row * 2048 + col + 4); }
    DI float apply(const Unit&, int row, int col, f32x4 v0, f32x4 v1, const L& l) const { float v[8], g[8], t[8]; v2f(v0, v1, v); unpack8(l.g, g); v2f(l.t0, l.t1, t);
#pragma unroll
        for (int j = 0; j < 8; ++j) v[j] = t[j] + v[j] * g[j];
        *(u32x4*)(MG + (size_t)row * 2048 + col) = pack8(v); return 0.f; } };
struct FRes { static constexpr bool SUMSQ = true; float* ssq; const float* xp; const float* xs; bf16_t* XB; struct L { f32x4 b0, b1; };
    DI void pre(const Unit&, int row, int col, L& l) const { const float* src = row < MP ? xp + (size_t)row * 2048 + col : xs + (size_t)(row - MP) * 2048 + col; l.b0 = __builtin_nontemporal_load((const f32x4*)src); l.b1 = __builtin_nontemporal_load((const f32x4*)(src + 4)); }
    DI float apply(const Unit&, int row, int col, f32x4 v0, f32x4 v1, const L& l) const { float v[8], b[8]; v2f(v0, v1, v); v2f(l.b0, l.b1, b); float ss = 0.f;
#pragma unroll
        for (int j = 0; j < 8; ++j) { v[j] += b[j]; ss += v[j] * v[j]; }
        *(u32x4*)(XB + (size_t)row * 2048 + col) = pack8(v); return ss; } };
struct FRes2 { static constexpr bool SUMSQ = true; float* ssq; bf16_t* XB; struct L { u32x4 b; };
    DI void pre(const Unit&, int row, int col, L& l) const { l.b = *(const u32x4*)(XB + (size_t)row * 2048 + col); }
    DI float apply(const Unit&, int row, int col, f32x4 v0, f32x4 v1, const L& l) const { float v[8], b[8]; v2f(v0, v1, v); unpack8(l.b, b); float ss = 0.f;
#pragma unroll
        for (int j = 0; j < 8; ++j) { v[j] += b[j]; ss += v[j] * v[j]; }
        *(u32x4*)(XB + (size_t)row * 2048 + col) = pack8(v); return ss; } };
struct FFf1 { static constexpr bool SUMSQ = false; float* ssq; const float* ssin; bf16_t* HID; struct L { float ss; };
    DI void pre(const Unit&, int row, int, L& l) const { l.ss = ssin[row]; }
    DI float apply(const Unit&, int row, int col, f32x4 v0, f32x4 v1, const L& l) const { float v[8]; v2f(v0, v1, v); const float rs = rsqrtf(l.ss * (1.f / 2048.f) + EPS);
#pragma unroll
        for (int j = 0; j < 8; ++j) { const float t = fmaxf(v[j] * rs, 0.f); v[j] = t * t; }
        __builtin_nontemporal_store(pack8(v), (u32x4*)(HID + (size_t)row * DFF + col)); return 0.f; } };
struct FPg { static constexpr bool SUMSQ = true; float* ssq; const float* ssin; const bf16_t* PL; bf16_t* X3; const bf16_t* XB; struct L { u32x4 b, p; float ss; };
    DI void pre(const Unit&, int row, int col, L& l) const { l.b = *(const u32x4*)(XB + (size_t)row * 2048 + col); l.p = *(const u32x4*)(PL + (size_t)row * 2048 + col); l.ss = ssin[row]; }
    DI float apply(const Unit&, int row, int col, f32x4 v0, f32x4 v1, const L& l) const { float v[8], b[8], p[8]; v2f(v0, v1, v); const float rs = rsqrtf(l.ss * (1.f / 2048.f) + EPS);
        unpack8(l.b, b); unpack8(l.p, p); float ss = 0.f;
#pragma unroll
        for (int j = 0; j < 8; ++j) { v[j] = b[j] + sigm(v[j] * rs) * p[j]; ss += v[j] * v[j]; }
        *(u32x4*)(X3 + (size_t)row * 2048 + col) = pack8(v); return ss; } };

constexpr int SG_LD = 264, SG_A = 32 * SG_LD * 2  , SG_BUF = 96 * SG_LD * 2  , SG_T = 2 * SG_BUF  ;
template <class F> DI void sample_gemm(Frame& Fr, const bf16_t* A, const bf16_t* Bt, int N, int K, const F& f, int first_bid) {
    if (Fr.bid < first_bid) return;
    const int ncg = N >> 6, nun = ((ncg + 7) >> 3) * 64, nkc = K >> 8, tid = Fr.tid, x = Fr.lane & 15, g = Fr.lane >> 4, rt = Fr.wave & 1, ct = Fr.wave >> 1;
    LAS float* T = (LAS float*)(Fr.lds + SG_T);
    const int prow = tid >> 5, pc = (tid & 31) * 8;
    for (int un = Fr.bid - first_bid; un < nun; un += Fr.G - first_bid) {
        const int rg = (un >> 3) & 7, cgp = (un >> 6) * 8 + (un & 7);
        if (cgp >= ncg) continue;
        const bf16_t* ga = A + (size_t)(MP + 32 * rg + prow) * K + pc; const bf16_t* gw = Bt + (size_t)(64 * cgp + prow) * K + pc;
        u32x4 R[4][6];
#define SG_LOAD(q, kc) do { const int k0_ = (kc) << 8; R[q][0] = *(const u32x4*)(ga + k0_); R[q][1] = *(const u32x4*)(ga + (size_t)16 * K + k0_); \
        R[q][2] = *(const u32x4*)(gw + k0_); R[q][3] = *(const u32x4*)(gw + (size_t)16 * K + k0_); R[q][4] = *(const u32x4*)(gw + (size_t)32 * K + k0_); R[q][5] = *(const u32x4*)(gw + (size_t)48 * K + k0_); } while (0)
#pragma unroll
        for (int q = 0; q < 4; ++q) if (q < nkc) SG_LOAD(q, q);
        f32x4 acc = (f32x4){0.f, 0.f, 0.f, 0.f};
        for (int kc4 = 0; kc4 < nkc; kc4 += 4) {
#pragma unroll
            for (int q = 0; q < 4; ++q) {
                const int kc = kc4 + q;
                if (kc < nkc) {
                    LAS unsigned char* buf = Fr.lds + (kc & 1) * SG_BUF; lbf As = (lbf)buf, Ws = (lbf)(buf + SG_A);
                    *(LAS u32x4*)(As + prow * SG_LD + pc) = R[q][0]; *(LAS u32x4*)(As + (prow + 16) * SG_LD + pc) = R[q][1];
                    *(LAS u32x4*)(Ws + prow * SG_LD + pc) = R[q][2]; *(LAS u32x4*)(Ws + (prow + 16) * SG_LD + pc) = R[q][3]; *(LAS u32x4*)(Ws + (prow + 32) * SG_LD + pc) = R[q][4]; *(LAS u32x4*)(Ws + (prow + 48) * SG_LD + pc) = R[q][5];
                    LDSYNC();
                    if (kc + 4 < nkc) SG_LOAD(q, kc + 4);
#pragma unroll
                    for (int ks = 0; ks < 8; ++ks) acc = __builtin_amdgcn_mfma_f32_16x16x32_bf16(*(const LAS s16x8*)(Ws + (16 * ct + x) * SG_LD + 32 * ks + 8 * g), *(const LAS s16x8*)(As + (16 * rt + x) * SG_LD + 32 * ks + 8 * g), acc, 0, 0, 0);
                }
            }
        }
#undef SG_LOAD
        *(lds_f4p)(T + (16 * rt + x) * 68 + 16 * ct + 4 * g) = acc;
        LDSYNC();
        if (tid < 256) { const int row = tid >> 3, c0 = (tid & 7) * 8; const f32x4 v0 = *(const lds_f4p)(T + row * 68 + c0), v1 = *(const lds_f4p)(T + row * 68 + c0 + 4); Unit u; u.pm = 64; u.pn = (64 * cgp) >> 8;
            float ss = apply5(f, u, MP + 32 * rg + row, 64 * cgp + c0, v0, v1);
            if (F::SUMSQ) { ss = red8(ss); if ((tid & 7) == 0) unsafeAtomicAdd(f.ssq + MP + 32 * rg + row, ss); } }
        LDSYNC();
    }
}
constexpr int SG2_LD = 136, SG2_A = 64 * SG2_LD * 2  , SG2_BUF = 192 * SG2_LD * 2  , SG2_T = 2 * SG2_BUF  ;
template <class F> DI void sample_gemm2(Frame& Fr, const bf16_t* A, const bf16_t* Bt, int N, int K, const F& f, int first_bid) {
    if (Fr.bid < first_bid) return;
    const int ncg = N >> 7, nun = ((ncg + 7) >> 3) * 32, nkc = K >> 7, tid = Fr.tid, x = Fr.lane & 15, g = Fr.lane >> 4, rt = Fr.wave & 3, cq = Fr.wave >> 2;
    LAS float* T = (LAS float*)(Fr.lds + SG2_T);
    const int prow = tid >> 4, pc = (tid & 15) * 8;
    for (int un = Fr.bid - first_bid; un < nun; un += Fr.G - first_bid) {
        const int rg = (un >> 3) & 3, cgp = (un >> 5) * 8 + (un & 7);
        if (cgp >= ncg) continue;
        const bf16_t* ga = A + (size_t)(MP + 64 * rg + prow) * K + pc; const bf16_t* gw = Bt + (size_t)(128 * cgp + prow) * K + pc;
        u32x4 R[4][6];
#define SG_LOAD(q, kc) do { const int k0_ = (kc) << 7; R[q][0] = *(const u32x4*)(ga + k0_); R[q][1] = *(const u32x4*)(ga + (size_t)32 * K + k0_); \
        R[q][2] = *(const u32x4*)(gw + k0_); R[q][3] = *(const u32x4*)(gw + (size_t)32 * K + k0_); R[q][4] = *(const u32x4*)(gw + (size_t)64 * K + k0_); R[q][5] = *(const u32x4*)(gw + (size_t)96 * K + k0_); } while (0)
#pragma unroll
        for (int q = 0; q < 4; ++q) SG_LOAD(q, q);
        f32x4 acc[4] = {(f32x4){0.f, 0.f, 0.f, 0.f}, (f32x4){0.f, 0.f, 0.f, 0.f}, (f32x4){0.f, 0.f, 0.f, 0.f}, (f32x4){0.f, 0.f, 0.f, 0.f}};
        for (int kc4 = 0; kc4 < nkc; kc4 += 4) {
#pragma unroll
            for (int q = 0; q < 4; ++q) {
                const int kc = kc4 + q;
                LAS unsigned char* buf = Fr.lds + (kc & 1) * SG2_BUF; lbf As = (lbf)buf, Ws = (lbf)(buf + SG2_A);
                *(LAS u32x4*)(As + prow * SG2_LD + pc) = R[q][0]; *(LAS u32x4*)(As + (prow + 32) * SG2_LD + pc) = R[q][1];
                *(LAS u32x4*)(Ws + prow * SG2_LD + pc) = R[q][2]; *(LAS u32x4*)(Ws + (prow + 32) * SG2_LD + pc) = R[q][3]; *(LAS u32x4*)(Ws + (prow + 64) * SG2_LD + pc) = R[q][4]; *(LAS u32x4*)(Ws + (prow + 96) * SG2_LD + pc) = R[q][5];
                LDSYNC();
                { const int kn = kc + 4 < nkc ? kc + 4 : nkc - 1; SG_LOAD(q, kn); }
#pragma unroll
                for (int ks = 0; ks < 4; ++ks) { const s16x8 af = *(const LAS s16x8*)(As + (16 * rt + x) * SG2_LD + 32 * ks + 8 * g);
#pragma unroll
                    for (int j = 0; j < 4; ++j) acc[j] = __builtin_amdgcn_mfma_f32_16x16x32_bf16(*(const LAS s16x8*)(Ws + (16 * (4 * cq + j) + x) * SG2_LD + 32 * ks + 8 * g), af, acc[j], 0, 0, 0); }
            }
        }
#undef SG_LOAD
#pragma unroll
        for (int j = 0; j < 4; ++j) *(lds_f4p)(T + (16 * rt + x) * 132 + 16 * (4 * cq + j) + 4 * g) = acc[j];
        LDSYNC();
#pragma unroll
        for (int i = 0; i < 2; ++i) { const int idx = tid + 512 * i, row = idx >> 4, c0 = (idx & 15) * 8; const f32x4 v0 = *(const lds_f4p)(T + row * 132 + c0), v1 = *(const lds_f4p)(T + row * 132 + c0 + 4); Unit u; u.pm = 64; u.pn = (128 * cgp) >> 8;
            float ss = apply5(f, u, MP + 64 * rg + row, 128 * cgp + c0, v0, v1);
            if (F::SUMSQ) { ss = red16(ss); if ((tid & 15) == 0) unsafeAtomicAdd(f.ssq + MP + 64 * rg + row, ss); } }
        LDSYNC();
    }
}
template <class F> DI void sample_gemm_any(Frame& Fr, const bf16_t* A, const bf16_t* Bt, int N, int K, const F& f, int first_bid) {
    if (N >= 4096 && (N & 127) == 0 && (K & 511) == 0) sample_gemm2(Fr, A, Bt, N, K, f, first_bid); else sample_gemm(Fr, A, Bt, N, K, f, first_bid); }
struct EpiUp2 { static constexpr bool PERM = true, AFTER_DRAIN = false; const bf16_t* Gma; const bf16_t* Gmb; bf16_t* MG;
    DI void mid(f32x4 (&acc)[2][2][4][2], const Unit& u, int wr, int wc, int fr, int fq) const {
#pragma unroll
        for (int ai = 0; ai < 2; ++ai) { u32x4 la[4][2], lb[4][2];
#pragma unroll
            for (int m = 0; m < 4; ++m)
#pragma unroll
                for (int bj = 0; bj < 2; ++bj) { const size_t o = (size_t)(u.pm * 256 + ai * 128 + wr * 64 + m * 16 + fr) * 2048 + u.pn * 256 + bj * 128 + wc * 32 + fq * 8; la[m][bj] = *(const u32x4*)(Gma + o); lb[m][bj] = *(const u32x4*)(Gmb + o); }
#pragma unroll
            for (int m = 0; m < 4; ++m)
#pragma unroll
                for (int bj = 0; bj < 2; ++bj) { float ga[8], gb[8]; unpack8(la[m][bj], ga); unpack8(lb[m][bj], gb);
#pragma unroll
                    for (int j = 0; j < 8; ++j) ga[j] *= __builtin_amdgcn_rcpf(fmaxf(gb[j], 1e-20f));
                    acc[ai][bj][m][0] *= (f32x4){ga[0], ga[1], ga[2], ga[3]}; acc[ai][bj][m][1] *= (f32x4){ga[4], ga[5], ga[6], ga[7]}; }
            asm volatile("" ::: "memory"); }
    }
    DI void operator()(const f32x4 (&acc)[2][2][4][2], const Unit& u, int wr, int wc, int fr, int fq) const {
#pragma unroll
        for (int ai = 0; ai < 2; ++ai) { u32x4 lb[4][2];
#pragma unroll
            for (int m = 0; m < 4; ++m)
#pragma unroll
                for (int bj = 0; bj < 2; ++bj) lb[m][bj] = *(const u32x4*)(Gmb + (size_t)(u.pm * 256 + ai * 128 + wr * 64 + m * 16 + fr) * 2048 + u.pn * 256 + bj * 128 + wc * 32 + fq * 8);
#pragma unroll
            for (int m = 0; m < 4; ++m)
#pragma unroll
                for (int bj = 0; bj < 2; ++bj) { float v[8], gb[8]; v2f(acc[ai][bj][m][0], acc[ai][bj][m][1], v); unpack8(lb[m][bj], gb);
#pragma unroll
                    for (int j = 0; j < 8; ++j) v[j] *= fmaxf(gb[j], 1e-20f);
                    *(u32x4*)(MG + (size_t)(u.pm * 256 + ai * 128 + wr * 64 + m * 16 + fr) * 2048 + u.pn * 256 + bj * 128 + wc * 32 + fq * 8) = pack8(v); }
            asm volatile("" ::: "memory"); }
    }
};
DI void run_gemm_up2(Frame& Fr, const bf16_t* A1, const bf16_t* B1, const bf16_t* A2, const bf16_t* B2, int Mr, int N, int K, const EpiUp2& E) {
    int Kq = K; asm volatile("" : "+s"(Kq));
    pg8::Gemm g{A1, B1, Mr, N, Kq, A2, B2}; pg8::StaticOrder2 S; S.init(Mr, N, Fr.G, Fr.bid);
    pg8::gemm_phase<EpiUp2, pg8::StaticOrder2, true, true, true>(Fr.lds, g, S, E, Fr.tid);
}
template <class F> DI void run_gemm(Frame& Fr, const bf16_t* A, const bf16_t* Bt, int Mr, int N, int K, const F& f) {
    int Kq = K; asm volatile("" : "+s"(Kq));
    const int wgm = ((K >= 4096 && N == 2048) || N == 5120) ? 4 : 8;
    pg8::Gemm g{A, Bt, Mr, N, Kq, A, Bt}; pg8::StaticOrder S; S.init(Mr, N, Fr.G, Fr.bid, wgm); EpiT<F> E{f};
    pg8::gemm_phase<EpiT<F>, pg8::StaticOrder, true, true>(Fr.lds, g, S, E, Fr.tid);
}

struct Seg { const float* src; int ldw, K, ncols, nvalid; bf16_t* dst; int ldt; const float* gsc; };
DI Seg get_seg(Frame& F, int id) {
    const KIn in{}; bf16_t* WAB = (bf16_t*)(F.ws + WS_RWKS + 2 * SLOT); bf16_t* WC = (bf16_t*)(F.dob + DO_WC); unsigned char* gt = F.ws + WS_GTAIL; Seg s;
    switch (id) {
    case 0: s = Seg{in[9], 11728, 2048, 3072, 3072, WAB, 2048, nullptr}; break;
    case 1: s = Seg{in[9] + 4112, 11728, 2048, 3520, 3520, WAB + (size_t)3072 * 2048, 2048, nullptr}; break;
    case 2: s = Seg{in[9] + 3072, 11728, 2048, 64, 16, WAB + (size_t)6592 * 2048, 2048, nullptr}; break;
    case 3: s = Seg{in[9] + 3088, 11728, 2048, 1024, 1024, WC, 2048, nullptr}; break;
    case 4: s = Seg{in[9] + 7632, 11728, 2048, 4096, 4096, WC + (size_t)1024 * 2048, 2048, nullptr}; break;
    case 5: s = Seg{in[25], 2048, 1024, 2048, 2048, (bf16_t*)(gt + GT_UPA), 1024, nullptr}; break;
    case 6: s = Seg{in[26], 2048, 1024, 2048, 2048, (bf16_t*)(gt + GT_UPB), 1024, nullptr}; break;
    case 7: s = Seg{in[27], 2048, 2048, 2048, 2048, (bf16_t*)(gt + GT_WO), 2048, nullptr}; break;
    case 8: s = Seg{in[32], 2048, 2048, 2048, 2048, (bf16_t*)(gt + GT_PG), 2048, in[31]}; break;
    case 9: s = Seg{in[33], 2048, 256, 2048, 2048, (bf16_t*)(gt + GT_PLE), 256, nullptr}; break;
    case 10: s = Seg{in[29], 8192, 2048, 8192, 8192, (bf16_t*)(F.ws + WS_RWKS + 2 * SLOT), 2048, in[28]}; break;
    default: s = Seg{in[30], 2048, 8192, 2048, 2048, (bf16_t*)(F.ws + WS_RWKS + 3 * SLOT), 8192, nullptr}; break;
    }
    return s;
}
DI void tr_load(const Seg& sg, int item, int lane, float (&r)[32]) {
    const int nblk = sg.ncols >> 5, kb = item / nblk, nb = item - kb * nblk, k0 = 64 * kb, n0 = 32 * nb, nv = sg.nvalid - n0, c4 = 4 * (lane & 7);
#pragma unroll
    for (int i = 0; i < 8; ++i) { const int kk = 8 * i + (lane >> 3); f32x4 v = (f32x4){0.f, 0.f, 0.f, 0.f}; if (c4 < nv) v = __builtin_nontemporal_load((const f32x4*)(sg.src + (size_t)(k0 + kk) * sg.ldw + n0 + c4));
        r[4 * i] = v.x; r[4 * i + 1] = v.y; r[4 * i + 2] = v.z; r[4 * i + 3] = v.w; }
}
DI void tr_finish(const Seg& sg, int item, LAS float* scr, int lane, const float (&r)[32]) {
    const int nblk = sg.ncols >> 5, kb = item / nblk, nb = item - kb * nblk, k0 = 64 * kb, n0 = 32 * nb, c4 = 4 * (lane & 7);
#pragma unroll
    for (int i = 0; i < 8; ++i) { const int kk = 8 * i + (lane >> 3); const float gs = sg.gsc ? sg.gsc[k0 + kk] : 1.f;
#pragma unroll
        for (int q = 0; q < 4; ++q) scr[kk * 33 + c4 + q] = r[4 * i + q] * gs; }
    asm volatile("s_waitcnt lgkmcnt(0)" ::: "memory");
    const int c = lane & 7;
#pragma unroll
    for (int j = 0; j < 4; ++j) { const int nn = (lane >> 3) + 8 * j; const LAS float* s = scr + (8 * c) * 33 + nn;
        u32x4 o; o.x = pg8::cvt_pk_bf16(s[0 * 33], s[1 * 33]); o.y = pg8::cvt_pk_bf16(s[2 * 33], s[3 * 33]); o.z = pg8::cvt_pk_bf16(s[4 * 33], s[5 * 33]); o.w = pg8::cvt_pk_bf16(s[6 * 33], s[7 * 33]);
        *(u32x4*)(sg.dst + (size_t)(n0 + nn) * sg.ldt + k0 + 8 * c) = o; }
    asm volatile("s_waitcnt lgkmcnt(0)" ::: "memory");
}
DI void conv_range(Frame& F, int seg_lo, int seg_hi) {
    LAS float* scr = (LAS float*)(F.lds + F.wave * 16384);
    const int gw = F.bid * 8 + F.wave, NGW = F.G * 8; int base = 0;
    for (int id = seg_lo; id < seg_hi; ++id) { const Seg sg = get_seg(F, id); const int ni = (sg.K >> 6) * (sg.ncols >> 5);
        int first = gw - (base % NGW); if (first < 0) first += NGW;
        float ra[32], rb[32];
        if (first < ni) tr_load(sg, first, F.lane, ra);
        for (int it = first; it < ni; it += 2 * NGW) {
            if (it + NGW < ni) tr_load(sg, it + NGW, F.lane, rb);
            tr_finish(sg, it, scr, F.lane, ra);
            if (it + NGW < ni) { if (it + 2 * NGW < ni) tr_load(sg, it + 2 * NGW, F.lane, ra); tr_finish(sg, it + NGW, scr, F.lane, rb); }
        }
        base += ni; }
}

DI void ph0(Frame& F) {
    const KIn in{};
    const int gw = F.bid * 8 + F.wave, NGW = F.G * 8, gt = F.bid * 512 + F.tid, NGT = F.G * 512;
    bf16_t* H = (bf16_t*)(F.dob + DO_H);
    const bool hf_ = F.G == 256 && (F.bid & 1);
#pragma unroll 1
    for (int ps_ = 0; ps_ < 2; ++ps_) {
        if ((ps_ == 0) == hf_) {
            float gm[4][8];
#pragma unroll
            for (int j = 0; j < 4; ++j) ld8f(in[8] + 8 * (F.lane + 64 * j), gm[j]);
            for (int m = gw; m < M; m += NGW) {
                const float* xr = m < MP ? in[0] + (size_t)m * DM : in[1] + (size_t)(m - MP) * DM; float v[4][8]; float ss = 0.f;
#pragma unroll
                for (int j = 0; j < 4; ++j) { ld8f_nt(xr + 8 * (F.lane + 64 * j), v[j]);
#pragma unroll
                    for (int e = 0; e < 8; ++e) ss += v[j][e] * v[j][e]; }
                const float rs = rsqrtf(wave_sum(ss) * (1.f / DM) + EPS);
#pragma unroll
                for (int j = 0; j < 4; ++j) { float o[8];
#pragma unroll
                    for (int e = 0; e < 8; ++e) o[e] = v[j][e] * rs * gm[j][e];
                    const u32x4 w = pack8(o); const size_t off = (size_t)m * DM + 8 * (F.lane + 64 * j);
                    __builtin_nontemporal_store(w, (u32x4*)(H + off)); *(u32x4*)((bf16_t*)(F.ws + WS_RWKS) + off) = w; }
            }
        } else { __syncthreads(); conv_range(F, 0, 3); __syncthreads(); }
    }
    bf16_t* WL2T = (bf16_t*)(F.ws + C_WL2T); bf16_t* G2T = (bf16_t*)(F.ws + C_G2T);
    for (int i = gt; i < 2 * 1024 * 12; i += NGT) { const int mtx = i >= 12288, q = i - 12288 * mtx, n = q & 1023, kg = q >> 10; const float* src = (mtx ? in[18] : in[16]) + (size_t)(8 * kg) * 1024 + n; float f[8];
#pragma unroll
        for (int j = 0; j < 8; ++j) f[j] = src[(size_t)j * 1024];
        *(u32x4*)(WL2T + (size_t)(1024 * mtx + n) * 256 + 96 * mtx + 8 * kg) = pack8(f); }
    for (int i = gt; i < 1024 * 32; i += NGT) { const int n = i & 1023, kg = i >> 10; const float* src = in[19] + (size_t)(8 * kg) * 1024 + n; float f[8];
#pragma unroll
        for (int j = 0; j < 8; ++j) f[j] = src[(size_t)j * 1024];
        *(u32x4*)(G2T + (size_t)n * 256 + 8 * kg) = pack8(f); }
    float* ss1 = (float*)(F.ws + C_SS1); float* ss2 = (float*)(F.ws + C_SS2); float* ss3 = (float*)(F.ws + C_SS3);
    for (int i = gt; i < M; i += NGT) { ss1[i] = 0.f; ss2[i] = 0.f; ss3[i] = 0.f; }
}

DI void tb_decode(int tb, int& s, int& t0) { if (tb < 512) { s = tb >> 7; t0 = (tb & 127) * 32; } else { s = 4 + (tb - 512); t0 = 0; } }
template <int NH, int NI> DI void gdn_prep_item(Frame& F, int s, int t0) {
    const KIn in{}; const int mb = seq_base(s), T = seq_T(s);
    const bf16_t* PROJ = (const bf16_t*)(F.ws + WS_PROJ); bf16_t* GD = (bf16_t*)(F.ws + WS_GDNS);
    if (F.tid < 384) {
        const int ch = F.tid * 8, sec = F.tid >> 7;
        float w0[8], w1[8], w2[8], w3[8]; ld8f(in[10] + ch, w0); ld8f(in[10] + 3072 + ch, w1); ld8f(in[10] + 6144 + ch, w2); ld8f(in[10] + 9216 + ch, w3);
        float x0[8], x1[8], x2[8];
        {
#pragma unroll
          for (int j = 0; j < 3; ++j) { const int pos = t0 + j - 3; float (&xj)[8] = j == 0 ? x0 : j == 1 ? x1 : x2;
              if (pos >= 0) unpack8(*(const u32x4*)(PROJ + (size_t)(mb + pos) * NAB + ch), xj);
              else if (s >= 4) ld8f(in[5] + (size_t)(s - 4) * 9216 + (size_t)(3 + pos) * 3072 + ch, xj);
              else {
#pragma unroll
                  for (int e = 0; e < 8; ++e) xj[e] = 0.f; } } }
        for (int half = 0; half < NH; ++half) {
            u32x4 raw[NI];
#pragma unroll
            for (int i = 0; i < NI; ++i) raw[i] = *(const u32x4*)(PROJ + (size_t)(mb + t0 + half * NI + i) * NAB + ch);
#pragma unroll
            for (int i = 0; i < NI; ++i) {
                float x3[8], c[8]; unpack8(raw[i], x3); float ss = 0.f;
#pragma unroll
                for (int e = 0; e < 8; ++e) { float t = x0[e] * w0[e] + x1[e] * w1[e] + x2[e] * w2[e] + x3[e] * w3[e]; t = t * sigm(t); c[e] = t; ss += t * t; }
                if (sec < 2) { ss = red16(ss); const float sc = rsqrtf(ss + EPS) * (sec == 0 ? 0.08838834764831845f : 1.f);
#pragma unroll
                    for (int e = 0; e < 8; ++e) c[e] *= sc; }
                *(u32x4*)(GD + (size_t)(mb + t0 + half * NI + i) * 3072 + ch) = pack8(c);
#pragma unroll
                for (int e = 0; e < 8; ++e) { x0[e] = x1[e]; x1[e] = x2[e]; x2[e] = x3[e]; }
            }
        }
        if (t0 + NH * NI == T) { float* ob = F.out + (s < 4 ? O_BUFP + (size_t)s * 9216 : O_BUFS + (size_t)(s - 4) * 9216) + ch; st8f(ob, x0); st8f(ob + 3072, x1); st8f(ob + 6144, x2); }
    } else {
        float* ga = (float*)(F.ws + C_GA); float* gb = (float*)(F.ws + C_GB); const int idx = F.tid - 384;
#pragma unroll
        for (int r = 0; r < 2; ++r) { const int p = idx + 128 * r, tt = p >> 3, h = p & 7, m = mb + t0 + tt; if (tt >= NH * NI) continue;
            const float al = bf2f(PROJ[(size_t)m * NAB + 6592 + h]), be = bf2f(PROJ[(size_t)m * NAB + 6600 + h]);
            const float g = -__expf(in[11][h]) * softplus_(al + in[12][h]); ga[m * 8 + h] = g; gb[m * 8 + h] = sigm(be); }
    }
}
template <int NH, int NI> DI void rwkv_mix_item(Frame& F, int s, int t0) {
    const KIn in{}; const int mb = seq_base(s), T = seq_T(s);
    const bf16_t* PROJ = (const bf16_t*)(F.ws + WS_PROJ); bf16_t* AL2 = (bf16_t*)(F.dob + DO_AL2); bf16_t* AG = (bf16_t*)(F.dob + DO_AG);
    if (F.tid < 440) {
        const int i0 = F.tid * 8; float mu[8], xp[8]; ld8f(in[14] + i0, mu);
        if (t0 > 0) unpack8(*(const u32x4*)(PROJ + (size_t)(mb + t0 - 1) * NAB + 3072 + i0), xp);
        else if (s >= 4) ld8f(in[7] + (size_t)(s - 4) * 3520 + i0, xp);
        else {
#pragma unroll
            for (int e = 0; e < 8; ++e) xp[e] = 0.f; }
        for (int half = 0; half < NH; ++half) {
            u32x4 raw[NI];
#pragma unroll
            for (int i = 0; i < NI; ++i) raw[i] = *(const u32x4*)(PROJ + (size_t)(mb + t0 + half * NI + i) * NAB + 3072 + i0);
#pragma unroll
            for (int i = 0; i < NI; ++i) {
                const size_t m = (size_t)(mb + t0 + half * NI + i); float x[8], xm[8]; unpack8(raw[i], x);
#pragma unroll
                for (int e = 0; e < 8; ++e) { xm[e] = x[e] + (xp[e] - x[e]) * mu[e]; xp[e] = x[e]; }
                if (i0 < 3072) { bf16_t* dst = (bf16_t*)(F.ws + WS_RWKS + (size_t)(i0 >> 10) * SLOT); *(u32x4*)(dst + m * 1024 + (i0 & 1023)) = pack8(xm); }
                else if (i0 < 3168) {
#pragma unroll
                    for (int e = 0; e < 8; ++e) xm[e] = tanh_(xm[e]);
                    *(u32x4*)(AL2 + m * 256 + (i0 - 3072)) = pack8(xm); }
                else if (i0 < 3264) { *(u32x4*)(AL2 + m * 256 + 96 + (i0 - 3168)) = pack8(xm); }
                else {
#pragma unroll
                    for (int e = 0; e < 8; ++e) xm[e] = sigm(xm[e]);
                    *(u32x4*)(AG + m * 256 + (i0 - 3264)) = pack8(xm); }
            }
        }
        if (t0 + NH * NI == T) st8f(F.out + (s < 4 ? O_SHP + (size_t)s * 3520 : O_SHS + (size_t)(s - 4) * 3520) + i0, xp);
    } else if (F.tid < 448) {
        const int c = 192 + (F.tid - 440) * 8;
        for (int i = 0; i < NH * NI; ++i) *(u32x4*)(AL2 + (size_t)(mb + t0 + i) * 256 + c) = (u32x4){0u, 0u, 0u, 0u};
    }
}
DI void ph2a(Frame& F) {
    for (int it = F.bid; it < 1024; it += F.G) { const int tb = it >> 1; if ((it ^ (it >> 8)) & 1) rwkv_mix_item<2, 16>(F, tb >> 7, (tb & 127) * 32); else gdn_prep_item<2, 16>(F, tb >> 7, (tb & 127) * 32); }
    for (int it = F.bid; it < 256; it += F.G) { const int q = it >> 1, s = 4 + (q >> 4), t0 = (q & 15) * 2; if (it & 1) rwkv_mix_item<1, 2>(F, s, t0); else gdn_prep_item<1, 2>(F, s, t0); }
}

constexpr int L64 = 64, L128 = 128, TILE64 = 64 * L64 * 2  , TILE128 = 64 * L128 * 2  , TILE128T = 128 * L64 * 2  ;
constexpr size_t C_BONUS = 0x3C0000, C_EGL = 0x4D0000;
constexpr size_t WS_GDNI = WS_PROJ, GDNI_BLK = 73728, WS_RWKI_S = WS_PROJ + 163577856, WS_YRAW = WS_PROJ + 167772160, WS_ORAW = WS_GDNS;
constexpr int GI_W = 0, GI_Q = 16384, GI_KT = 32768, GI_UT = 49152, GI_QK = 65536;

DI u32x2 pack4(const f32x4 v) { u32x2 w; w.x = pg8::cvt_pk_bf16(v.x, v.y); w.y = pg8::cvt_pk_bf16(v.z, v.w); return w; }
DI unsigned short bf1(float v) { return (unsigned short)(pg8::cvt_pk_bf16(v, 0.f) & 0xffffu); }
DI f32x4 unpack4(const u32x2 w) { return (f32x4){__uint_as_float(w.x << 16), __uint_as_float(w.x & 0xffff0000u), __uint_as_float(w.y << 16), __uint_as_float(w.y & 0xffff0000u)}; }
DI int o64(int r, int c) { return r * 64 + ((((c >> 3) ^ ((r >> 1) & 7) ^ ((r >> 4) & 3))) << 3) + (c & 7); }
DI int o128(int r, int c) { return r * 128 + ((((c >> 3) ^ (r & 15))) << 3) + (c & 7); }
template <int KS, int NTW, bool OA, bool SP = false, bool SQ = false> DI void bmm_acc(clbf P, int ldp, clbf QT, int ldq, int mt, int nt0, int lane, f32x4 (&acc)[NTW]) {
    const int x = lane & 15, g = lane >> 4;
#pragma unroll
    for (int ks = 0; ks < KS; ++ks) {
        const int rp = 16 * mt + x; const s16x8 pf = *(const LAS s16x8*)(P + (ldp == L128 ? o128(rp, 32 * ks + 8 * g) : o64(rp, 32 * ks + 8 * g)));
#pragma unroll
        for (int j = 0; j < NTW; ++j) { const int rq = 16 * (nt0 + j) + x; const s16x8 qf = *(const LAS s16x8*)(QT + (ldq == L128 ? o128(rq, 32 * ks + 8 * g) : o64(rq, 32 * ks + 8 * g)));
            acc[j] = OA ? __builtin_amdgcn_mfma_f32_16x16x32_bf16(pf, qf, acc[j], 0, 0, 0) : __builtin_amdgcn_mfma_f32_16x16x32_bf16(qf, pf, acc[j], 0, 0, 0); }
    }
}
template <int KS, int NTW> DI void bmm_dual(clbf P, int ldp, clbf QT, int ldq, int mt, int nt0, int lane, f32x4 (&acc)[NTW], f32x4 (&acc2)[NTW]) {
    const int x = lane & 15, g = lane >> 4;
#pragma unroll
    for (int ks = 0; ks < KS; ++ks) {
        const int rp = 16 * mt + x; const s16x8 pf = *(const LAS s16x8*)(P + (ldp == L128 ? o128(rp, 32 * ks + 8 * g) : o64(rp, 32 * ks + 8 * g)));
#pragma unroll
        for (int j = 0; j < NTW; ++j) { const int rq = 16 * (nt0 + j) + x; const s16x8 qf = *(const LAS s16x8*)(QT + (ldq == L128 ? o128(rq, 32 * ks + 8 * g) : o64(rq, 32 * ks + 8 * g)));
            acc[j] = __builtin_amdgcn_mfma_f32_16x16x32_bf16(qf, pf, acc[j], 0, 0, 0); acc2[j] = __builtin_amdgcn_mfma_f32_16x16x32_bf16(pf, qf, acc2[j], 0, 0, 0); }
    }
}
DI lbf neumann64(lbf Qr0, lbf Qt0, lbf Pt0, lbf Qr1, lbf Qt1, lbf Pt1, f32x4 (&pacc)[2], f32x4 (&pacc2)[2], int mt, int nt0, int lane) {
    const int x = lane & 15, g = lane >> 4;
    { f32x4 q[2] = {(f32x4){0.f, 0.f, 0.f, 0.f}, (f32x4){0.f, 0.f, 0.f, 0.f}}, q2[2] = {(f32x4){0.f, 0.f, 0.f, 0.f}, (f32x4){0.f, 0.f, 0.f, 0.f}};
      bmm_dual<2, 2>(Qr0, L64, Qt0, L64, mt, nt0, lane, q, q2);
#pragma unroll
      for (int j = 0; j < 2; ++j) { *(LAS u32x2*)(Qr1 + o64(16 * mt + x, 16 * (nt0 + j) + 4 * g)) = pack4(q[j]); *(LAS u32x2*)(Qt1 + o64(16 * (nt0 + j) + x, 16 * mt + 4 * g)) = pack4(q2[j]); }
      LDSYNC(); }
    lbf Qr = Qr1, Qt = Qt1, Pt = Pt0, Qrn = Qr0, Qtn = Qt0, Ptn = Pt1;
#pragma unroll 1
    for (int k = 1; k <= 5; ++k) {
        if (k < 5) { f32x4 q[2] = {(f32x4){0.f, 0.f, 0.f, 0.f}, (f32x4){0.f, 0.f, 0.f, 0.f}}, q2[2] = {(f32x4){0.f, 0.f, 0.f, 0.f}, (f32x4){0.f, 0.f, 0.f, 0.f}};
            bmm_dual<2, 2>(Qr, L64, Pt, L64, mt, nt0, lane, pacc, pacc2);
            bmm_dual<2, 2>(Qr, L64, Qt, L64, mt, nt0, lane, q, q2);
#pragma unroll
            for (int j = 0; j < 2; ++j) { const int ot = o64(16 * (nt0 + j) + x, 16 * mt + 4 * g);
                *(LAS u32x2*)(Qrn + o64(16 * mt + x, 16 * (nt0 + j) + 4 * g)) = pack4(q[j]); *(LAS u32x2*)(Qtn + ot) = pack4(q2[j]); *(LAS u32x2*)(Ptn + ot) = pack4(pacc2[j]); } }
        else { bmm_acc<2, 2, false>(Qr, L64, Pt, L64, mt, nt0, lane, pacc);
#pragma unroll
            for (int j = 0; j < 2; ++j) *(LAS u32x2*)(Ptn + o64(16 * mt + x, 16 * (nt0 + j) + 4 * g)) = pack4(pacc[j]); }
        LDSYNC();
        lbf t; t = Qr; Qr = Qrn; Qrn = t; t = Qt; Qt = Qtn; Qtn = t; t = Pt; Pt = Ptn; Ptn = t;
    }
    return Pt;
}

struct RwMat { bf16_t* p[4]; int ld; };
DI RwMat rw_mats(unsigned char* ws, int s, int c, int h) { RwMat r;
    if (s < 4) { const size_t o = (size_t)(s * 4096 + 64 * c) * 1024 + 64 * h; r.ld = 1024; r.p[0] = (bf16_t*)(ws + WS_RWKS) + o; r.p[1] = (bf16_t*)(ws + WS_RWKS + SLOT) + o; r.p[2] = (bf16_t*)(ws + WS_RWKS + 3 * SLOT) + o; r.p[3] = (bf16_t*)(ws + WS_RWKS + 4 * SLOT) + o; }
    else { bf16_t* b = (bf16_t*)(ws + WS_RWKI_S + (size_t)((s - 4) * 16 + h) * 32768); r.ld = 64; r.p[0] = b; r.p[1] = b + 4096; r.p[2] = b + 8192; r.p[3] = b + 12288; }
    return r; }
constexpr int LORA_W_OFF = 14 * TILE64 + 4096;
DI void rwkv_raw_load(Frame& F, u32x4 (&raw)[7], int s, int c, int h, int tid) {
    const int m0 = seq_base(s) + 64 * c;
    const bf16_t* S0 = (const bf16_t*)(F.ws + WS_RWKS) + (size_t)(m0 + (tid >> 3)) * 1024 + 64 * h + 8 * (tid & 7);
#pragma unroll
    for (int i = 0; i < 3; ++i) raw[i] = *(const u32x4*)(S0 + (size_t)i * (SLOT / 2));
    const bf16_t* A0 = (const bf16_t*)(F.dob + DO_AL2) + (size_t)(m0 + (tid >> 5)) * 256 + 8 * (tid & 31);
#pragma unroll
    for (int i = 0; i < 4; ++i) raw[3 + i] = *(const u32x4*)(A0 + (size_t)(16 * i) * 256);
}
DI void rwkv_cprep_item(Frame& F, int s, int c, int h, u32x4 (&raw)[7], int ns, int nc) {
    int tid_ = F.tid; asm volatile("" : "+v"(tid_));
    const int tid = tid_, lane = tid_ & 63, wave = F.wave, x = lane & 15, g = lane >> 4, mt = wave & 3, nt0 = 2 * (wave >> 2);
    const int m0 = seq_base(s) + 64 * c, nvalid = s < 4 ? 64 : 32, t = tid >> 3, cg = tid & 7, ch = 64 * h + 8 * cg;
    LAS unsigned char* L = F.lds;
    lbf AT = (lbf)(L), BT = (lbf)(L + TILE64), KT = (lbf)(L + 2 * TILE64), RT = (lbf)(L + 3 * TILE64), RTR = (lbf)(L + 4 * TILE64), ATT = (lbf)(L + 5 * TILE64), BHT = (lbf)(L + 6 * TILE64), KHT = (lbf)(L + 7 * TILE64), VT = (lbf)(L + 8 * TILE64);
    lbf Qr0 = (lbf)(L + 9 * TILE64), Qt0 = (lbf)(L + 10 * TILE64), Pr0 = (lbf)(L + 11 * TILE64), AAK = (lbf)(L + 12 * TILE64), ABRT = (lbf)(L + 13 * TILE64);
    LAS float* WTOT = (LAS float*)(L + 14 * TILE64); LAS float* GAM = WTOT + 512; const LAS float* PAR = GAM + 64;
    lbf XW = (lbf)(L), XA = (lbf)(L + 2 * TILE64); LAS float* WLF = (LAS float*)(L + 4 * TILE64); LAS float* ALF = (LAS float*)(L + 6 * TILE64);
    clbf W2H = (clbf)(L + LORA_W_OFF), A2H = (clbf)(L + LORA_W_OFF + TILE128);
    { const int pc_ = tid & 31, tk_ = tid >> 5;
      if (pc_ < 24) { lbf X_ = pc_ < 12 ? XW : XA; const int c_ = 8 * (pc_ < 12 ? pc_ : pc_ - 12);
#pragma unroll
          for (int i = 0; i < 4; ++i) *(LAS u32x4*)(X_ + o128(tk_ + 16 * i, c_)) = raw[3 + i]; } }
    LDSYNC();
    { f32x4 a[2] = {(f32x4){0.f, 0.f, 0.f, 0.f}, (f32x4){0.f, 0.f, 0.f, 0.f}}, b[2] = {(f32x4){0.f, 0.f, 0.f, 0.f}, (f32x4){0.f, 0.f, 0.f, 0.f}};
      bmm_acc<3, 2, false>(XW, L128, W2H, L128, mt, nt0, lane, a); bmm_acc<3, 2, false>(XA, L128, A2H, L128, mt, nt0, lane, b);
#pragma unroll
      for (int j = 0; j < 2; ++j) { *(lds_f4p)(WLF + (16 * mt + x) * 64 + 16 * (nt0 + j) + 4 * g) = a[j]; *(lds_f4p)(ALF + (16 * mt + x) * 64 + 16 * (nt0 + j) + 4 * g) = b[j]; } }
    LDSYNC();
    float r[8], kp[8], v[8], lw[8], ka[8], kk[8];
    { u32x4 z = (u32x4){0u, 0u, 0u, 0u}; const bool ok = t < nvalid;
      float kx[8], wl[8], al[8], w0[8], a0[8], kkw[8], kaw[8];
      unpack8(ok ? raw[0] : z, r); unpack8(ok ? raw[1] : z, kx); unpack8(ok ? raw[2] : z, v); ld8l(WLF + t * 64 + 8 * cg, wl); ld8l(ALF + t * 64 + 8 * cg, al);
      if (!ok) {
#pragma unroll
          for (int e = 0; e < 8; ++e) { wl[e] = 0.f; al[e] = 0.f; } }
      ld8l(PAR + 8 * cg, w0); ld8l(PAR + 64 + 8 * cg, a0); ld8l(PAR + 128 + 8 * cg, kkw); ld8l(PAR + 192 + 8 * cg, kaw);
      float ss = 0.f;
#pragma unroll
      for (int e = 0; e < 8; ++e) { lw[e] = ok ? -0.6065306597126334f * sigm(w0[e] + wl[e]) : 0.f;     al[e] = sigm(a0[e] + al[e]); kk[e] = kx[e] * kkw[e]; ss += kk[e] * kk[e]; }
      ss = red8(ss); const float sc = rsqrtf(ss + EPS);
#pragma unroll
      for (int e = 0; e < 8; ++e) { kk[e] *= sc; kp[e] = kx[e] * (1.f + (al[e] - 1.f) * kaw[e]); ka[e] = kk[e] * al[e]; } }
    { float sb = 0.f; float rk[8]; ld8l(PAR + 256 + 8 * cg, rk);
#pragma unroll
      for (int e = 0; e < 8; ++e) sb += r[e] * kp[e] * rk[e];
      sb = red8(sb); if (cg == 0 && t < nvalid) ((float*)(F.ws + C_BONUS))[(size_t)(m0 + t) * 16 + h] = sb; }
    LAS float* LWF = (LAS float*)(L + 9 * TILE64);
    LAS float* OFFS = (LAS float*)(L + 11 * TILE64);
    { f32x4 w0_ = (f32x4){lw[0], lw[1], lw[2], lw[3]}, w1_ = (f32x4){lw[4], lw[5], lw[6], lw[7]}; *(lds_f4p)(LWF + t * 64 + 8 * cg) = w0_; *(lds_f4p)(LWF + t * 64 + 8 * cg + 4) = w1_; }
    LDSYNC();
    { const int c_ = tid & 63; float a = 0.f;
#pragma unroll
      for (int i = 0; i < 8; ++i) { a += LWF[(8 * wave + i) * 64 + c_]; LWF[(8 * wave + i) * 64 + c_] = a; }
      WTOT[wave * 64 + c_] = a; }
    LDSYNC();
    rwkv_raw_load(F, raw, ns, nc, h, tid);
    { const int c_ = tid & 63; float off = 0.f, ref = 0.f;
#pragma unroll
      for (int w = 0; w < 7; ++w) { const float q = WTOT[w * 64 + c_]; if (w < wave) off += q; if (w < 4) ref += q; }
      OFFS[wave * 64 + c_] = off;
      if (wave == 7) { const float tot = off + WTOT[7 * 64 + c_];
          OFFS[512 + c_] = ref; OFFS[576 + c_] = __expf(ref); OFFS[640 + c_] = __expf(tot - ref); GAM[c_] = __expf(tot); } }
    LDSYNC();
    float Lc[8], Lref[8], ER[8], EC[8];
    { float p_[8], o_[8]; ld8l(LWF + t * 64 + 8 * cg, p_); ld8l(OFFS + wave * 64 + 8 * cg, o_); ld8l(OFFS + 512 + 8 * cg, Lref); ld8l(OFFS + 576 + 8 * cg, ER); ld8l(OFFS + 640 + 8 * cg, EC);
#pragma unroll
      for (int e = 0; e < 8; ++e) Lc[e] = p_[e] + o_[e]; }
    { float a1[8], a2[8], a3[8], a4[8], a5[8], a6[8], a7[8], a8[8];
#pragma unroll
      for (int e = 0; e < 8; ++e) { const float E = __expf(Lc[e] - Lref[e]), eneg = __builtin_amdgcn_rcpf(E), ew = __expf(-lw[e]);
          a1[e] = -kk[e] * E * ew;                a2[e] = ka[e] * eneg; a3[e] = kp[e] * eneg; a4[e] = r[e] * E; a5[e] = a4[e] * ER[e];
          a6[e] = a1[e] * ER[e];                          a7[e] = a2[e] * EC[e]; a8[e] = a3[e] * EC[e]; }
      const int o = o64(t, 8 * cg);
      *(LAS u32x4*)(AT + o) = pack8(a1); *(LAS u32x4*)(BT + o) = pack8(a2); *(LAS u32x4*)(KT + o) = pack8(a3); *(LAS u32x4*)(RT + o) = pack8(a4); *(LAS u32x4*)(RTR + o) = pack8(a5);
#pragma unroll
      for (int e = 0; e < 8; ++e) { const int oc = o64(8 * cg + e, t); ATT[oc] = bf1(a6[e]); BHT[oc] = bf1(a7[e]); KHT[oc] = bf1(a8[e]); VT[oc] = bf1(v[e]); } }
    LDSYNC();
    f32x4 pacc[2], pacc2[2], akr[2];
    { f32x4 n[2] = {(f32x4){0.f, 0.f, 0.f, 0.f}, (f32x4){0.f, 0.f, 0.f, 0.f}}, n2[2] = {(f32x4){0.f, 0.f, 0.f, 0.f}, (f32x4){0.f, 0.f, 0.f, 0.f}};
      bmm_dual<2, 2>(AT, L64, BT, L64, mt, nt0, lane, n, n2);
#pragma unroll
      for (int j = 0; j < 2; ++j) { const int m = 16 * mt + x, nn = 16 * (nt0 + j) + 4 * g, r0 = 16 * mt + 4 * g, cc = 16 * (nt0 + j) + x;
#pragma unroll
          for (int e = 0; e < 4; ++e) { if (nn + e >= m) n[j][e] = 0.f; pacc[j][e] = n[j][e] + ((nn + e) == m ? 1.f : 0.f);
              if (cc >= r0 + e) n2[j][e] = 0.f; pacc2[j][e] = n2[j][e] + (cc == (r0 + e) ? 1.f : 0.f); }
          *(LAS u32x2*)(Qr0 + o64(m, nn)) = pack4(n[j]); *(LAS u32x2*)(Qt0 + o64(cc, r0)) = pack4(n2[j]); *(LAS u32x2*)(Pr0 + o64(cc, r0)) = pack4(pacc2[j]); } }
    { f32x4 a[2] = {(f32x4){0.f, 0.f, 0.f, 0.f}, (f32x4){0.f, 0.f, 0.f, 0.f}};
      bmm_acc<2, 2, false>(KT, L64, AT, L64, mt, nt0, lane, a);
#pragma unroll
      for (int j = 0; j < 2; ++j) { const int m = 16 * mt + x, nn = 16 * (nt0 + j) + 4 * g;
#pragma unroll
          for (int e = 0; e < 4; ++e) if (m >= nn + e) a[j][e] = 0.f;
          *(LAS u32x2*)(AAK + o64(m, nn)) = pack4(a[j]); } }
    { f32x4 a[2] = {(f32x4){0.f, 0.f, 0.f, 0.f}, (f32x4){0.f, 0.f, 0.f, 0.f}};
      bmm_acc<2, 2, true>(BT, L64, RT, L64, mt, nt0, lane, a);
      akr[0] = (f32x4){0.f, 0.f, 0.f, 0.f}; akr[1] = akr[0];
      bmm_acc<2, 2, true>(KT, L64, RT, L64, mt, nt0, lane, akr);
#pragma unroll
      for (int j = 0; j < 2; ++j) { const int jj = 16 * mt + 4 * g, tt = 16 * (nt0 + j) + x;
#pragma unroll
          for (int e = 0; e < 4; ++e) if (jj + e > tt) { a[j][e] = 0.f; akr[j][e] = 0.f; }
          *(LAS u32x2*)(ABRT + o64(tt, jj)) = pack4(a[j]); } }
    LDSYNC();
    lbf X = neumann64(Qr0, Qt0, Pr0, AT, BT, KT, pacc, pacc2, mt, nt0, lane);
    lbf W1 = RT, W2 = (X == Pr0) ? KT : Pr0;
    { f32x4 a[2] = {(f32x4){0.f, 0.f, 0.f, 0.f}, (f32x4){0.f, 0.f, 0.f, 0.f}}, b[2] = {(f32x4){0.f, 0.f, 0.f, 0.f}, (f32x4){0.f, 0.f, 0.f, 0.f}};
      bmm_acc<2, 2, false, true, false>(ATT, L64, X, L64, mt, nt0, lane, a);
      bmm_acc<2, 2, false>(AAK, L64, X, L64, mt, nt0, lane, b);
#pragma unroll
      for (int j = 0; j < 2; ++j) { const int o = o64(16 * mt + x, 16 * (nt0 + j) + 4 * g); *(LAS u32x2*)(W1 + o) = pack4(a[j]); *(LAS u32x2*)(W2 + o) = pack4(b[j]); } }
    LDSYNC();
#pragma unroll
    for (int i = 0; i < 7; ++i) asm volatile("" : "+v"(raw[i]));
    const RwMat G = rw_mats(F.ws, s, c, h);
    lbf M2T = Qr0, AKQT = Qt0;
    { f32x4 a[2] = {(f32x4){0.f, 0.f, 0.f, 0.f}, (f32x4){0.f, 0.f, 0.f, 0.f}}, b[2] = {(f32x4){0.f, 0.f, 0.f, 0.f}, (f32x4){0.f, 0.f, 0.f, 0.f}}, d[2] = {(f32x4){0.f, 0.f, 0.f, 0.f}, (f32x4){0.f, 0.f, 0.f, 0.f}};
      bmm_acc<2, 2, true, false, true>(W1, L64, BHT, L64, mt, nt0, lane, a);
      bmm_acc<2, 2, true, false, true>(W2, L64, BHT, L64, mt, nt0, lane, b);
      bmm_acc<2, 2, true>(W1, L64, ABRT, L64, mt, nt0, lane, d);
      bmm_acc<2, 2, true>(W2, L64, ABRT, L64, mt, nt0, lane, akr);
#pragma unroll
      for (int j = 0; j < 2; ++j) { const int mm = 16 * mt + 4 * g, nn = 16 * (nt0 + j) + x;
#pragma unroll
          for (int e = 0; e < 4; ++e) if (mm + e == nn) a[j][e] += GAM[nn];
          *(u32x2*)(G.p[0] + (size_t)nn * G.ld + mm) = pack4(a[j]);
          b[j] += unpack4(*(const LAS u32x2*)(KHT + o64(nn, mm))); *(LAS u32x2*)(M2T + o64(nn, mm)) = pack4(b[j]);
          d[j] += unpack4(*(const LAS u32x2*)(RTR + o64(nn, mm))); *(u32x2*)(G.p[1] + (size_t)nn * G.ld + mm) = pack4(d[j]);
          *(LAS u32x2*)(AKQT + o64(nn, mm)) = pack4(akr[j]); } }
    LDSYNC();
    { f32x4 a[2] = {(f32x4){0.f, 0.f, 0.f, 0.f}, (f32x4){0.f, 0.f, 0.f, 0.f}}, b[2] = {(f32x4){0.f, 0.f, 0.f, 0.f}, (f32x4){0.f, 0.f, 0.f, 0.f}};
      bmm_acc<2, 2, false, true, false>(VT, L64, M2T, L64, mt, nt0, lane, a);
      bmm_acc<2, 2, true, true, false>(VT, L64, AKQT, L64, mt, nt0, lane, b);
#pragma unroll
      for (int j = 0; j < 2; ++j) { *(u32x2*)(G.p[2] + (size_t)(16 * mt + x) * G.ld + 16 * (nt0 + j) + 4 * g) = pack4(a[j]);
          *(u32x2*)(G.p[3] + (size_t)(16 * (nt0 + j) + x) * G.ld + 16 * mt + 4 * g) = pack4(b[j]); } }
    LDSYNC();
}

DI int gdn_ch_index(int s, int c, int h) { return ((s < 4 ? s * 64 + c : 256 + (s - 4)) * 8 + h); }
struct GdnRaw { u32x4 p[6]; float ga, gb; };
DI void gdn_raw_load(Frame& F, GdnRaw& R, int s, int c, int h, int tid) {
    const int m0 = seq_base(s) + 64 * c; const bf16_t* GD = (const bf16_t*)(F.ws + WS_GDNS) + (size_t)(m0 + (tid >> 3)) * 3072 + 128 * h + 16 * (tid & 7);
#pragma unroll
    for (int i = 0; i < 3; ++i) { R.p[2 * i] = *(const u32x4*)(GD + 1024 * i); R.p[2 * i + 1] = *(const u32x4*)(GD + 1024 * i + 8); }
    const size_t og = (size_t)(m0 + (tid & 63)) * 8 + h; R.ga = ((const float*)(F.ws + C_GA))[og]; R.gb = ((const float*)(F.ws + C_GB))[og];
}
DI void gdn_cprep_item(Frame& F, int s, int c, int h, GdnRaw& R, int ns, int nc, int nh) {
    int tid_ = F.tid; asm volatile("" : "+v"(tid_));
    const int tid = tid_, lane = tid_ & 63, wave = F.wave, x = lane & 15, g = lane >> 4, mt = wave & 3, nt0 = 2 * (wave >> 2);
    const int m0 = seq_base(s) + 64 * c, nvalid = s < 4 ? 64 : 32, t = tid >> 3, dg = tid & 7;
    LAS unsigned char* L = F.lds;
    lbf KTm = (lbf)(L), QTm = (lbf)(L + TILE128), KBT = (lbf)(L + 2 * TILE128), VBT = (lbf)(L + 2 * TILE128 + TILE128T), KDT = (lbf)(L + 2 * TILE128 + 2 * TILE128T);
    constexpr int OFF2 = 2 * TILE128 + 3 * TILE128T;
    lbf Qr0 = (lbf)(L + OFF2), Qt0 = (lbf)(L + OFF2 + TILE64), Pr0 = (lbf)(L + OFF2 + 2 * TILE64), Qr1 = (lbf)(L + OFF2 + 3 * TILE64), Qt1 = (lbf)(L + OFF2 + 4 * TILE64), Pr1 = (lbf)(L + OFF2 + 5 * TILE64);
    LAS float* GS = (LAS float*)(L + OFF2 + 6 * TILE64);
    unsigned char* blk = F.ws + WS_GDNI + (size_t)gdn_ch_index(s, c, h) * GDNI_BLK;
    if (wave == 0) { const bool ok = lane < nvalid;
        float a = ok ? R.ga : 0.f; const float be = ok ? R.gb : 0.f;
#pragma unroll
        for (int d = 1; d < 64; d <<= 1) { const float b = __shfl_up(a, d); if (lane >= d) a += b; }
        GS[lane] = a; GS[64 + lane] = be; if (lane == 63) ((float*)(F.ws + C_EGL))[gdn_ch_index(s, c, h)] = __expf(a); }
    float q[16], k[16], v[16];
    { const u32x4 z = (u32x4){0u, 0u, 0u, 0u}; const bool ok = t < nvalid; float f[8];
      unpack8(ok ? R.p[0] : z, f);
#pragma unroll
      for (int e = 0; e < 8; ++e) q[e] = f[e];
      unpack8(ok ? R.p[1] : z, f);
#pragma unroll
      for (int e = 0; e < 8; ++e) q[8 + e] = f[e];
      unpack8(ok ? R.p[2] : z, f);
#pragma unroll
      for (int e = 0; e < 8; ++e) k[e] = f[e];
      unpack8(ok ? R.p[3] : z, f);
#pragma unroll
      for (int e = 0; e < 8; ++e) k[8 + e] = f[e];
      unpack8(ok ? R.p[4] : z, f);
#pragma unroll
      for (int e = 0; e < 8; ++e) v[e] = f[e];
      unpack8(ok ? R.p[5] : z, f);
#pragma unroll
      for (int e = 0; e < 8; ++e) v[8 + e] = f[e]; }
    LDSYNC();
    gdn_raw_load(F, R, ns, nc, nh, tid);
    u32x4 qd0, qd1; u32x2 qks[2];
    { const float Gt = GS[t], be = GS[64 + t], gl = GS[63], eG = __expf(Gt), kb = be * eG, kd = __expf(gl - Gt);
      float f0[8], f1[8];
#pragma unroll
      for (int e = 0; e < 8; ++e) { f0[e] = k[e]; f1[e] = k[8 + e]; }
      *(LAS u32x4*)(KTm + o128(t, 16 * dg)) = pack8(f0); *(LAS u32x4*)(KTm + o128(t, 16 * dg + 8)) = pack8(f1);
#pragma unroll
      for (int e = 0; e < 8; ++e) { f0[e] = q[e]; f1[e] = q[8 + e]; }
      *(LAS u32x4*)(QTm + o128(t, 16 * dg)) = pack8(f0); *(LAS u32x4*)(QTm + o128(t, 16 * dg + 8)) = pack8(f1);
#pragma unroll
      for (int e = 0; e < 8; ++e) { f0[e] = q[e] * eG; f1[e] = q[8 + e] * eG; }
      qd0 = pack8(f0); qd1 = pack8(f1);
#pragma unroll
      for (int e = 0; e < 16; ++e) { const int oc = o64(16 * dg + e, t); KBT[oc] = bf1(k[e] * kb); VBT[oc] = bf1(v[e] * be); KDT[oc] = bf1(k[e] * kd); if ((e & 3) == 3) __builtin_amdgcn_sched_barrier(0); } }
    LDSYNC();
    f32x4 pacc[2], pacc2[2];
    { f32x4 n[2] = {(f32x4){0.f, 0.f, 0.f, 0.f}, (f32x4){0.f, 0.f, 0.f, 0.f}}, n2[2] = {(f32x4){0.f, 0.f, 0.f, 0.f}, (f32x4){0.f, 0.f, 0.f, 0.f}}, qk[2] = {(f32x4){0.f, 0.f, 0.f, 0.f}, (f32x4){0.f, 0.f, 0.f, 0.f}};
      bmm_dual<4, 2>(KTm, L128, KTm, L128, mt, nt0, lane, n, n2);
      bmm_acc<4, 2, false>(QTm, L128, KTm, L128, mt, nt0, lane, qk);
#pragma unroll
      for (int j = 0; j < 2; ++j) { const int m = 16 * mt + x, nn = 16 * (nt0 + j) + 4 * g, r0 = 16 * mt + 4 * g, cc = 16 * (nt0 + j) + x; const float Gi = GS[m], bi = GS[64 + m], Gc = GS[cc];
#pragma unroll
          for (int e = 0; e < 4; ++e) { const float dec = __expf(fminf(Gi - GS[nn + e], 0.f));
              n[j][e] = (nn + e < m) ? -bi * n[j][e] * dec : 0.f; qk[j][e] = (nn + e <= m) ? qk[j][e] * dec : 0.f;
              pacc[j][e] = n[j][e] + ((nn + e) == m ? 1.f : 0.f);
              const float dec2 = __expf(fminf(GS[r0 + e] - Gc, 0.f));
              n2[j][e] = (cc < r0 + e) ? -GS[64 + r0 + e] * n2[j][e] * dec2 : 0.f; pacc2[j][e] = n2[j][e] + (cc == (r0 + e) ? 1.f : 0.f); }
          *(LAS u32x2*)(Qr0 + o64(m, nn)) = pack4(n[j]); *(LAS u32x2*)(Qt0 + o64(cc, r0)) = pack4(n2[j]); *(LAS u32x2*)(Pr0 + o64(cc, r0)) = pack4(pacc2[j]);
          qks[j] = pack4(qk[j]); } }
    LDSYNC();
    lbf X = neumann64(Qr0, Qt0, Pr0, Qr1, Qt1, Pr1, pacc, pacc2, mt, nt0, lane);
#pragma unroll
    for (int i = 0; i < 6; ++i) asm volatile("" : "+v"(R.p[i]));
    asm volatile("" : "+v"(R.ga), "+v"(R.gb));
    *(u32x4*)((bf16_t*)(blk + GI_Q) + t * 128 + 16 * dg) = qd0; *(u32x4*)((bf16_t*)(blk + GI_Q) + t * 128 + 16 * dg + 8) = qd1;
#pragma unroll
    for (int j = 0; j < 2; ++j) *(u32x2*)((bf16_t*)(blk + GI_QK) + (16 * mt + x) * 64 + 16 * (nt0 + j) + 4 * g) = qks[j];
    { const int nt4 = 4 * (wave >> 2);
      f32x4 a[4] = {(f32x4){0.f, 0.f, 0.f, 0.f}, (f32x4){0.f, 0.f, 0.f, 0.f}, (f32x4){0.f, 0.f, 0.f, 0.f}, (f32x4){0.f, 0.f, 0.f, 0.f}}, b[4] = {(f32x4){0.f, 0.f, 0.f, 0.f}, (f32x4){0.f, 0.f, 0.f, 0.f}, (f32x4){0.f, 0.f, 0.f, 0.f}, (f32x4){0.f, 0.f, 0.f, 0.f}};
      bmm_acc<2, 4, false, false, true>(X, L64, KBT, L64, mt, nt4, lane, a);
      bmm_acc<2, 4, true, false, true>(X, L64, VBT, L64, mt, nt4, lane, b);
#pragma unroll
      for (int j = 0; j < 4; ++j) { a[j] = -a[j];
          *(u32x2*)((bf16_t*)(blk + GI_W) + (16 * mt + x) * 128 + 16 * (nt4 + j) + 4 * g) = pack4(a[j]);
          *(u32x2*)((bf16_t*)(blk + GI_UT) + (16 * (nt4 + j) + x) * 64 + 16 * mt + 4 * g) = pack4(b[j]); } }
    { const int row = tid >> 2, c16 = (tid & 3) * 16;
      *(u32x4*)((bf16_t*)(blk + GI_KT) + row * 64 + c16) = *(const LAS u32x4*)(KDT + o64(row, c16)); *(u32x4*)((bf16_t*)(blk + GI_KT) + row * 64 + c16 + 8) = *(const LAS u32x4*)(KDT + o64(row, c16 + 8)); }
    LDSYNC();
}
DI void ck_decode(int ck, int& s, int& c) { if (ck < 256) { s = ck >> 6; c = ck & 63; } else { s = 4 + (ck - 256); c = 0; } }
DI void ph_cprep_gdn(Frame& F) { const int it0 = (F.bid + (F.G >> 1)) % F.G; GdnRaw R;
    if (it0 < 2112) { int s, c; ck_decode(it0 >> 3, s, c); gdn_raw_load(F, R, s, c, it0 & 7, F.tid); }
    for (int it = it0; it < 2112; it += F.G) { int s, c, ns, nc; ck_decode(it >> 3, s, c); const int nit = it + F.G < 2112 ? it + F.G : it; ck_decode(nit >> 3, ns, nc);
        gdn_cprep_item(F, s, c, it & 7, R, ns, nc, nit & 7); } }
DI void ph_cprep_rwkv(Frame& F) {
    LAS float* PAR = (LAS float*)(F.lds + 14 * TILE64) + 512 + 64; int cur_h = -1; u32x4 raw[7];
    if (F.bid < 4224) { int s, c; ck_decode(F.bid >> 4, s, c); rwkv_raw_load(F, raw, s, c, F.bid & 15, F.tid); }
    for (int it = F.bid; it < 4224; it += F.G) { int s, c, ns, nc; ck_decode(it >> 4, s, c); const int h = it & 15, nit = it + F.G < 4224 ? it + F.G : it; ck_decode(nit >> 4, ns, nc);
        if (h != cur_h) { __syncthreads();
            if (F.tid < 320) { const KIn in{}; const int p = F.tid >> 6, ch = 64 * h + (F.tid & 63); PAR[F.tid] = (p == 0 ? in[15] : p == 1 ? in[17] : p == 2 ? in[20] : p == 3 ? in[21] : in[22])[ch]; }
            { const bf16_t* WL = (const bf16_t*)(F.ws + C_WL2T);
#pragma unroll
              for (int i = 0; i < 3; ++i) { const int p = F.tid + 512 * i, mtx = p >= 768, q = p - 768 * mtx, row = q / 12, pc = q - 12 * row;
                  *(LAS u32x4*)((lbf)(F.lds + LORA_W_OFF + mtx * TILE128) + o128(row, 8 * pc)) = *(const u32x4*)(WL + (size_t)(1024 * mtx + 64 * h + row) * 256 + 96 * mtx + 8 * pc); } }
            __syncthreads();
            if (cur_h >= 0) rwkv_raw_load(F, raw, s, c, h, F.tid);
            cur_h = h; }
        rwkv_cprep_item(F, s, c, h, raw, ns, nc); } }

DI u32x4 frag_gload(const bf16_t* base, int ld, int lane) { return *(const u32x4*)(base + (size_t)(lane >> 2) * ld + 8 * (lane & 3)); }
DI s16x8 frag_gperm(const u32x4 w, int lane) { const int src = (4 * (lane & 15) + (lane >> 4)) * 4; u32x4 p;
#pragma unroll
    for (int e = 0; e < 4; ++e) p[e] = (unsigned)__builtin_amdgcn_ds_bpermute(src, (int)w[e]);
    return __builtin_bit_cast(s16x8, p); }
DI u32x2 quad_gload(const bf16_t* base, int ld, int lane) { return *(const u32x2*)(base + (size_t)(lane >> 2) * ld + 4 * (lane & 3)); }
DI u32x2 quad_gperm(const u32x2 w, int lane) { const int src = (4 * (lane & 15) + (lane >> 4)) * 4; u32x2 p; p.x = (unsigned)__builtin_amdgcn_ds_bpermute(src, (int)w.x); p.y = (unsigned)__builtin_amdgcn_ds_bpermute(src, (int)w.y); return p; }
DI s16x8 frag_gather(const bf16_t* base  , int ld, int lane) {
    const u32x4 w = *(const u32x4*)(base + (size_t)(lane >> 2) * ld + 8 * (lane & 3)); const int src = (4 * (lane & 15) + (lane >> 4)) * 4; u32x4 p;
#pragma unroll
    for (int e = 0; e < 4; ++e) p[e] = (unsigned)__builtin_amdgcn_ds_bpermute(src, (int)w[e]);
    return __builtin_bit_cast(s16x8, p);
}
DI u32x2 quad_gather(const bf16_t* base  , int ld, int lane) {
    const u32x2 w = *(const u32x2*)(base + (size_t)(lane >> 2) * ld + 4 * (lane & 3)); const int src = (4 * (lane & 15) + (lane >> 4)) * 4; u32x2 p;
    p.x = (unsigned)__builtin_amdgcn_ds_bpermute(src, (int)w.x); p.y = (unsigned)__builtin_amdgcn_ds_bpermute(src, (int)w.y); return p;
}
DI void rwkv_sample_wave(Frame& F, int s, int h, int vq, LAS unsigned char* wl) {
    const int lane = F.lane, x = lane & 15, g = lane >> 4, mb = seq_base(s); lbf Sb = (lbf)wl;
    const RwMat G = rw_mats(F.ws, s, 0, h); bf16_t* YR = (bf16_t*)(F.ws + WS_YRAW);
    u32x4 fm[4][2], fr[2][2]; u32x2 ds[4], yl[2];
#pragma unroll
    for (int j = 0; j < 4; ++j) { fm[j][0] = frag_gload(G.p[0] + (size_t)(16 * j) * G.ld, G.ld, lane); fm[j][1] = frag_gload(G.p[0] + (size_t)(16 * j) * G.ld + 32, G.ld, lane);
        ds[j] = quad_gload(G.p[2] + (size_t)(16 * vq) * G.ld + 16 * j, G.ld, lane); }
#pragma unroll
    for (int j = 0; j < 2; ++j) { fr[j][0] = frag_gload(G.p[1] + (size_t)(16 * j) * G.ld, G.ld, lane); fr[j][1] = frag_gload(G.p[1] + (size_t)(16 * j) * G.ld + 32, G.ld, lane);
        yl[j] = quad_gload(G.p[3] + (size_t)(16 * j) * G.ld + 16 * vq, G.ld, lane); }
    f32x4 S[4];
    { const float* st = KIn{}[6] + ((size_t)((s - 4) * 16 + h) * 64 + 16 * vq + x) * 64;
#pragma unroll
      for (int j = 0; j < 4; ++j) S[j] = *(const f32x4*)(st + 16 * j + 4 * g); }
#pragma unroll
    for (int j = 0; j < 4; ++j) *(LAS u32x2*)(Sb + o64(x, 16 * j + 4 * g)) = pack4(S[j]);
    asm volatile("s_waitcnt lgkmcnt(0)" ::: "memory");
    const s16x8 s0 = *(const LAS s16x8*)(Sb + o64(x, 8 * g)), s1 = *(const LAS s16x8*)(Sb + o64(x, 32 + 8 * g));
    asm volatile("s_waitcnt lgkmcnt(0)" ::: "memory");
    float* so = F.out + O_SRS + ((size_t)((s - 4) * 16 + h) * 64 + 16 * vq + x) * 64;
#pragma unroll
    for (int j = 0; j < 4; ++j) { f32x4 n = unpack4(quad_gperm(ds[j], lane));
        n = __builtin_amdgcn_mfma_f32_16x16x32_bf16(frag_gperm(fm[j][0], lane), s0, n, 0, 0, 0); n = __builtin_amdgcn_mfma_f32_16x16x32_bf16(frag_gperm(fm[j][1], lane), s1, n, 0, 0, 0);
        *(f32x4*)(so + 16 * j + 4 * g) = n; }
#pragma unroll
    for (int j = 0; j < 2; ++j) { f32x4 y = unpack4(quad_gperm(yl[j], lane));
        y = __builtin_amdgcn_mfma_f32_16x16x32_bf16(s0, frag_gperm(fr[j][0], lane), y, 0, 0, 0); y = __builtin_amdgcn_mfma_f32_16x16x32_bf16(s1, frag_gperm(fr[j][1], lane), y, 0, 0, 0);
        *(u32x2*)(YR + (size_t)(mb + 16 * j + x) * 1024 + 64 * h + 16 * vq + 4 * g) = pack4(y); }
}
DI void rwkv_cscan_block(Frame& F, int s, int h) {
    const int tid = F.tid, lane = F.lane, wave = F.wave, x = lane & 15, g = lane >> 4;
    LAS unsigned char* L = F.lds;
    constexpr int BUFR = 4 * TILE64;
    __syncthreads();
    if (wave < 4) {
        const int vq = wave; lbf Sb = (lbf)(L + 2 * BUFR + wave * (16 * L64 * 2));
        f32x4 S[4];
#pragma unroll
        for (int j = 0; j < 4; ++j) S[j] = (f32x4){0.f, 0.f, 0.f, 0.f};
        bf16_t* yr = (bf16_t*)(F.ws + WS_YRAW) + (size_t)(s * 4096 + x) * 1024 + 64 * h + 16 * vq + 4 * g;
        LDSYNC();
        for (int c = 0; c < 64; ++c) {
            LAS unsigned char* B = L + (c & 1) * BUFR; lbf MT = (lbf)B, DS = (lbf)(B + TILE64), RQ = (lbf)(B + 2 * TILE64), YL = (lbf)(B + 3 * TILE64);
#pragma unroll
            for (int j = 0; j < 4; ++j) *(LAS u32x2*)(Sb + o64(x, 16 * j + 4 * g)) = pack4(S[j]);
            asm volatile("s_waitcnt lgkmcnt(0)" ::: "memory");
            const s16x8 s0 = *(const LAS s16x8*)(Sb + o64(x, 8 * g)), s1 = *(const LAS s16x8*)(Sb + o64(x, 32 + 8 * g));
#pragma unroll
            for (int j = 0; j < 4; ++j) {
                S[j] = unpack4(*(const LAS u32x2*)(DS + o64(16 * vq + x, 16 * j + 4 * g)));
                S[j] = __builtin_amdgcn_mfma_f32_16x16x32_bf16(*(const LAS s16x8*)(MT + o64(16 * j + x, 8 * g)), s0, S[j], 0, 0, 0);
                S[j] = __builtin_amdgcn_mfma_f32_16x16x32_bf16(*(const LAS s16x8*)(MT + o64(16 * j + x, 32 + 8 * g)), s1, S[j], 0, 0, 0); }
#pragma unroll
            for (int j = 0; j < 4; ++j) { f32x4 y = unpack4(*(const LAS u32x2*)(YL + o64(16 * j + x, 16 * vq + 4 * g)));
                y = __builtin_amdgcn_mfma_f32_16x16x32_bf16(s0, *(const LAS s16x8*)(RQ + o64(16 * j + x, 8 * g)), y, 0, 0, 0);
                y = __builtin_amdgcn_mfma_f32_16x16x32_bf16(s1, *(const LAS s16x8*)(RQ + o64(16 * j + x, 32 + 8 * g)), y, 0, 0, 0);
                *(u32x2*)(yr + (size_t)(64 * c + 16 * j) * 1024) = pack4(y); }
            LDSYNC();
        }
        float* so = F.out + O_SRP + ((size_t)(s * 16 + h) * 64 + 16 * vq + x) * 64;
#pragma unroll
        for (int j = 0; j < 4; ++j) *(f32x4*)(so + 16 * j + 4 * g) = S[j];
    } else {
        const int ht = tid - 256;
        const unsigned char* gsrc[8]; int lo[8];
#pragma unroll
        for (int i = 0; i < 8; ++i) { const int p = ht + 256 * i, q = p & 511, row = q >> 3, pc = q & 7, m = i >> 1;
            gsrc[i] = F.ws + WS_RWKS + (m == 0 ? 0 : m == 1 ? 3 * SLOT : m == 2 ? SLOT : 4 * SLOT) + ((size_t)(s * 4096 + row) * 1024 + 64 * h + 8 * pc) * 2; lo[i] = m * TILE64 + o64(row, 8 * pc) * 2; }
        u32x4 R0[8], R1[8], R2[8];
#define H_LD(RR, cc) do { const size_t co_ = (size_t)((cc) < 64 ? (cc) : 63) * 131072; \
_Pragma("unroll") for (int i = 0; i < 8; ++i) RR[i] = __builtin_nontemporal_load((const u32x4*)(gsrc[i] + co_)); } while (0)
#define H_ST(RR, k) do { LAS unsigned char* B_ = L + ((k) & 1) * BUFR; \
_Pragma("unroll") for (int i = 0; i < 8; ++i) *(LAS u32x4*)(B_ + lo[i]) = RR[i]; } while (0)
        H_LD(R0, 0); H_LD(R1, 1); H_LD(R2, 2);
        H_ST(R0, 0); H_LD(R0, 3);
        LDSYNC();
        for (int k = 1; k < 64; k += 3) {
            H_ST(R1, k); H_LD(R1, k + 3); LDSYNC();
            H_ST(R2, k + 1); H_LD(R2, k + 4); LDSYNC();
            H_ST(R0, k + 2); H_LD(R0, k + 5); LDSYNC();
        }
        LDSYNC();
#undef H_LD
#undef H_ST
    }
}
template <int NCH>
DI void gdn_cscan_item(Frame& F, int s, int h, int dq) {
    const int tid = F.tid, lane = F.lane, wave = F.wave, x = lane & 15, g = lane >> 4, nvalid = NCH > 1 ? 64 : 32, mb = seq_base(s);
    LAS unsigned char* L = F.lds;
    constexpr int O_QD = TILE128, O_KDT = 2 * TILE128, O_QK = 2 * TILE128 + TILE128T, O_UT = O_QK + TILE64, BUF = O_UT + 32 * L64 * 2  , WSZ = 16 * L128 * 2 + 16 * L64 * 2  ;
    static_assert(2 * BUF + 2 * WSZ <= LDS_BYTES, "LDS");
    __syncthreads();
    if (wave < 2) {
        const int dvl = 16 * wave, dv0 = 32 * dq + dvl;
        lbf ST = (lbf)(L + 2 * BUF + wave * WSZ), VN = ST + 16 * L128;
        bf16_t* OR = (bf16_t*)(F.ws + WS_ORAW);
        f32x4 S[8];
        if (NCH == 1) { const float* st = KIn{}[4] + ((size_t)((s - 4) * 8 + h) * 128) * 128 + dv0 + x;
#pragma unroll
            for (int i = 0; i < 8; ++i)
#pragma unroll
                for (int e = 0; e < 4; ++e) S[i][e] = st[(size_t)(16 * i + 4 * g + e) * 128]; }
        else {
#pragma unroll
            for (int i = 0; i < 8; ++i) S[i] = (f32x4){0.f, 0.f, 0.f, 0.f}; }
        const float egl_all = ((const float*)(F.ws + C_EGL))[gdn_ch_index(s, lane < NCH ? lane : NCH - 1, h)];
        LDSYNC();
        for (int c = 0; c < NCH; ++c) {
            LAS unsigned char* B = L + (c & 1) * BUF;
            lbf WN = (lbf)B, QD = (lbf)(B + O_QD), KDT = (lbf)(B + O_KDT), QK = (lbf)(B + O_QK), UT = (lbf)(B + O_UT);
            f32x4 vn[4];
#pragma unroll
            for (int i = 0; i < 8; ++i) *(LAS u32x2*)(ST + o128(x, 16 * i + 4 * g)) = pack4(S[i]);
#pragma unroll
            for (int i = 0; i < 4; ++i) vn[i] = unpack4(*(const LAS u32x2*)(UT + o64(dvl + x, 16 * i + 4 * g)));
            const float egl = __builtin_bit_cast(float, __builtin_amdgcn_readlane(__builtin_bit_cast(int, egl_all), c));
            asm volatile("s_waitcnt lgkmcnt(0)" ::: "memory");
            s16x8 sf[4];
#pragma unroll
            for (int ks = 0; ks < 4; ++ks) sf[ks] = *(const LAS s16x8*)(ST + o128(x, 32 * ks + 8 * g));
#pragma unroll
            for (int i = 0; i < 4; ++i)
#pragma unroll
                for (int ks = 0; ks < 4; ++ks) vn[i] = __builtin_amdgcn_mfma_f32_16x16x32_bf16(*(const LAS s16x8*)(WN + o128(16 * i + x, 32 * ks + 8 * g)), sf[ks], vn[i], 0, 0, 0);
#pragma unroll
            for (int i = 0; i < 4; ++i) *(LAS u32x2*)(VN + o64(x, 16 * i + 4 * g)) = pack4(vn[i]);
            asm volatile("s_waitcnt lgkmcnt(0)" ::: "memory");
            const s16x8 v0 = *(const LAS s16x8*)(VN + o64(x, 8 * g)), v1 = *(const LAS s16x8*)(VN + o64(x, 32 + 8 * g));
#pragma unroll
            for (int i = 0; i < 4; ++i) { f32x4 o = (f32x4){0.f, 0.f, 0.f, 0.f};
#pragma unroll
                for (int ks = 0; ks < 4; ++ks) o = __builtin_amdgcn_mfma_f32_16x16x32_bf16(sf[ks], *(const LAS s16x8*)(QD + o128(16 * i + x, 32 * ks + 8 * g)), o, 0, 0, 0);
                o = __builtin_amdgcn_mfma_f32_16x16x32_bf16(v0, *(const LAS s16x8*)(QK + o64(16 * i + x, 8 * g)), o, 0, 0, 0);
                o = __builtin_amdgcn_mfma_f32_16x16x32_bf16(v1, *(const LAS s16x8*)(QK + o64(16 * i + x, 32 + 8 * g)), o, 0, 0, 0);
                const int tt = 16 * i + x; if (tt < nvalid) *(u32x2*)(OR + (size_t)(mb + 64 * c + tt) * 1024 + 128 * h + dv0 + 4 * g) = pack4(o); }
#pragma unroll
            for (int i = 0; i < 8; ++i) { S[i] = S[i] * egl;
                S[i] = __builtin_amdgcn_mfma_f32_16x16x32_bf16(*(const LAS s16x8*)(KDT + o64(16 * i + x, 8 * g)), v0, S[i], 0, 0, 0);
                S[i] = __builtin_amdgcn_mfma_f32_16x16x32_bf16(*(const LAS s16x8*)(KDT + o64(16 * i + x, 32 + 8 * g)), v1, S[i], 0, 0, 0); }
            LDSYNC();
        }
        float* so = F.out + (NCH > 1 ? O_SGP + ((size_t)(s * 8 + h) * 128) * 128 : O_SGS + ((size_t)((s - 4) * 8 + h) * 128) * 128) + dv0 + x;
#pragma unroll
        for (int i = 0; i < 8; ++i)
#pragma unroll
            for (int e = 0; e < 4; ++e) so[(size_t)(16 * i + 4 * g + e) * 128] = S[i][e];
    } else {
        const int ht = tid - 128; int so[10], lo[10];
#pragma unroll
        for (int i = 0; i < 10; ++i) { const int p = ht + 384 * i;
            if (p < 2048) { const int q = p & 1023; so[i] = p * 16; lo[i] = (p >> 10) * O_QD + o128(q >> 4, (q & 15) * 8) * 2; }
            else if (p < 3072) { const int q = p - 2048; so[i] = p * 16; lo[i] = O_KDT + o64(q >> 3, (q & 7) * 8) * 2; }
            else if (p < 3584) { const int q = p - 3072; so[i] = GI_QK + q * 16; lo[i] = O_QK + o64(q >> 3, (q & 7) * 8) * 2; }
            else { const int q = p - 3584; so[i] = GI_UT + dq * 4096 + q * 16; lo[i] = O_UT + o64(q >> 3, (q & 7) * 8) * 2; } }
        const unsigned char* gb = F.ws + WS_GDNI;
        u32x4 R0[10], R1[10], R2[10];
#define H_LD(R, cc) do { const int cc_ = (cc) < NCH ? (cc) : NCH - 1; const unsigned char* b_ = gb + (size_t)gdn_ch_index(s, cc_, h) * GDNI_BLK; \
_Pragma("unroll") for (int i = 0; i < 10; ++i) R[i] = *(const u32x4*)(b_ + so[i]); } while (0)
#define H_ST(R, k) do { LAS unsigned char* B_ = L + ((k) & 1) * BUF; \
_Pragma("unroll") for (int i = 0; i < 10; ++i) *(LAS u32x4*)(B_ + lo[i]) = R[i]; } while (0)
        H_LD(R0, 0);
        if (NCH > 1) { H_LD(R1, 1); H_LD(R2, 2); }
        H_ST(R0, 0);
        if (NCH > 1) H_LD(R0, 3);
        LDSYNC();
        if (NCH > 1) {
            for (int k = 1; k < NCH; k += 3) {
                H_ST(R1, k); H_LD(R1, k + 3); LDSYNC();
                H_ST(R2, k + 1); H_LD(R2, k + 4); LDSYNC();
                H_ST(R0, k + 2); H_LD(R0, k + 5); LDSYNC();
            }
        }
        LDSYNC();
#undef H_LD
#undef H_ST
    }
}
DI void ph_pb(Frame& F) {
    bf16_t* PB = (bf16_t*)(F.ws + WS_GTAIL + GT_PB);
    for (int i = F.bid * 512 + F.tid; i < M * 32; i += F.G * 512) { const int m = i >> 5, c = (i & 31) * 8; const float* src = m < MP ? KIn{}[2] + (size_t)m * 256 + c : KIn{}[3] + (size_t)(m - MP) * 256 + c; float f[8]; ld8f(src, f); *(u32x4*)(PB + (size_t)m * 256 + c) = pack8(f); }
}
DI void ph_cscan(Frame& F) {
    if (F.G == 256) {
        if (F.bid < 128) { const int i = F.bid; gdn_cscan_item<64>(F, (i & 31) >> 3, i & 7, i >> 5); }
        else { Frame F2 = F; F2.bid = F.bid - 128; F2.G = 128; Frame F3 = F; F3.bid = (F.bid - 128) & 63; F3.G = 64;
            if (F.bid < 192) { const int i = F.bid - 128; rwkv_cscan_block(F, i >> 4, i & 15); { const int i2 = 192 + i; gdn_cscan_item<1>(F, 4 + (i2 >> 5), (i2 >> 2) & 7, i2 & 3); } }
            else { const int b_ = F.bid - 192; { const int j = b_ * 8 + F.wave; rwkv_sample_wave(F, 4 + (j >> 6), (j >> 2) & 15, j & 3, F.lds + F.wave * (16 * L64 * 2)); }
                   for (int i = b_; i < 192; i += 64) gdn_cscan_item<1>(F, 4 + (i >> 5), (i >> 2) & 7, i & 3); }
            __syncthreads();
            { const FStore f_{nullptr, (bf16_t*)(F.ws + WS_RWKS + 5 * SLOT), 1024}; const bf16_t* A_ = (const bf16_t*)(F.dob + DO_AG); const bf16_t* B_ = (const bf16_t*)(F.ws + C_G2T);
              run_gemm(F2, A_, B_, MP, 1024, 256, f_); __syncthreads(); sample_gemm(F2, A_, B_, 1024, 256, f_, 0); __syncthreads(); }
            if (F.bid >= 192) { conv_range(F3, 5, 10); ph_pb(F3); }
        }
    } else {
        for (int i = F.bid; i < 128; i += F.G) gdn_cscan_item<64>(F, (i & 31) >> 3, i & 7, i >> 5);
        for (int i = F.bid; i < 64; i += F.G) rwkv_cscan_block(F, i >> 4, i & 15);
        __syncthreads();
        for (int j = F.bid * 8 + F.wave; j < 512; j += F.G * 8) rwkv_sample_wave(F, 4 + (j >> 6), (j >> 2) & 15, j & 3, F.lds + F.wave * (16 * L64 * 2));
        for (int i = F.bid; i < 256; i += F.G) gdn_cscan_item<1>(F, 4 + (i >> 5), (i >> 2) & 7, i & 3);
        __syncthreads();
        { const FStore f_{nullptr, (bf16_t*)(F.ws + WS_RWKS + 5 * SLOT), 1024}; const bf16_t* A_ = (const bf16_t*)(F.dob + DO_AG); const bf16_t* B_ = (const bf16_t*)(F.ws + C_G2T);
          run_gemm(F, A_, B_, MP, 1024, 256, f_); __syncthreads(); sample_gemm(F, A_, B_, 1024, 256, f_, 0); __syncthreads(); }
        conv_range(F, 5, 10); ph_pb(F);
    }
}
DI void ph_post(Frame& F) {
    const KIn in{}; const int c8 = (F.tid & 127) * 8;
    const bf16_t* YR = (const bf16_t*)(F.ws + WS_YRAW); const bf16_t* ORW = (const bf16_t*)(F.ws + WS_ORAW); const bf16_t* S2 = (const bf16_t*)(F.ws + WS_RWKS + 2 * SLOT);
    bf16_t* OB = (bf16_t*)(F.ws + WS_RWKS + 3 * SLOT); const bf16_t* GATE = (const bf16_t*)(F.ws + WS_RWKS + 5 * SLOT); float* rso = (float*)(F.ws + C_RSO); const float* BON = (const float*)(F.ws + C_BONUS);
    float lg[8], lb[8]; ld8f(in[23] + c8, lg); ld8f(in[24] + c8, lb);
#define POST_ROW(m_, ry, rv, rg, ro, sb_) do { const size_t o_ = (size_t)(m_) * 1024 + c8; float y[8], v[8], g[8], ob[8]; unpack8(ry, y); unpack8(rv, v); unpack8(rg, g); float sm = 0.f; \
        _Pragma("unroll") for (int e = 0; e < 8; ++e) sm += y[e]; \
        sm = red8(sm) * (1.f / 64.f); float sv = 0.f; \
        _Pragma("unroll") for (int e = 0; e < 8; ++e) { y[e] -= sm; sv += y[e] * y[e]; } \
        sv = red8(sv) * (1.f / 64.f); const float rstd = rsqrtf(sv + 64e-5f); \
        _Pragma("unroll") for (int e = 0; e < 8; ++e) ob[e] = (y[e] * rstd * lg[e] + lb[e] + (sb_) * v[e]) * g[e]; \
        *(u32x4*)(OB + o_) = pack8(ob); \
        float oa[8]; unpack8(ro, oa); float so = 0.f; \
        _Pragma("unroll") for (int e = 0; e < 8; ++e) so += oa[e] * oa[e]; \
        so = red16(so); if ((F.tid & 15) == 0) rso[(m_) * 8 + (c8 >> 7)] = rsqrtf(so * (1.f / 128.f) + EPS); } while (0)
    const int mstep = F.G * 4;
    for (int m = F.bid * 4 + (F.tid >> 7); m < M; m += 2 * mstep) {
        const int m2 = m + mstep; const bool two = m2 < M; const int mb_ = two ? m2 : m; const size_t oa_ = (size_t)m * 1024 + c8, ob_ = (size_t)mb_ * 1024 + c8;
        const u32x4 y0 = *(const u32x4*)(YR + oa_), v0 = *(const u32x4*)(S2 + oa_), g0 = *(const u32x4*)(GATE + oa_), r0 = *(const u32x4*)(ORW + oa_);
        const u32x4 y1 = *(const u32x4*)(YR + ob_), v1 = *(const u32x4*)(S2 + ob_), g1 = *(const u32x4*)(GATE + ob_), r1 = *(const u32x4*)(ORW + ob_);
        const float sb0 = BON[(size_t)m * 16 + (c8 >> 6)], sb1 = BON[(size_t)mb_ * 16 + (c8 >> 6)];
        POST_ROW(m, y0, v0, g0, r0, sb0);
        if (two) POST_ROW(m2, y1, v1, g1, r1, sb1);
    }
#undef POST_ROW
}
DI void ph_final(Frame& F) {
    const float* ss3 = (const float*)(F.ws + C_SS3); const bf16_t* X3 = (const bf16_t*)(F.ws + WS_RWKS + 2 * SLOT); const int gw = F.bid * 8 + F.wave, NGW = F.G * 8;
    float g[4][8];
    { const float* gf = KIn{}[34];
#pragma unroll
      for (int j = 0; j < 4; ++j) ld8f(gf + 8 * (F.lane + 64 * j), g[j]); }
    for (int m = gw; m < M; m += 2 * NGW) { const int m2 = m + NGW; const bool two = m2 < M; const int mb_ = two ? m2 : m;
        u32x4 ra[4], rb[4];
#pragma unroll
        for (int j = 0; j < 4; ++j) { ra[j] = *(const u32x4*)(X3 + (size_t)m * DM + 8 * (F.lane + 64 * j)); rb[j] = *(const u32x4*)(X3 + (size_t)mb_ * DM + 8 * (F.lane + 64 * j)); }
        const float rsa = rsqrtf(ss3[m] * (1.f / DM) + EPS), rsb = rsqrtf(ss3[mb_] * (1.f / DM) + EPS);
#pragma unroll
        for (int j = 0; j < 4; ++j) { float v[8]; unpack8(ra[j], v);
#pragma unroll
            for (int e = 0; e < 8; ++e) v[e] = v[e] * rsa * g[j][e];
            st8f_nt(F.out + (size_t)m * DM + 8 * (F.lane + 64 * j), v); }
        if (two) {
#pragma unroll
            for (int j = 0; j < 4; ++j) { float v[8]; unpack8(rb[j], v);
#pragma unroll
                for (int e = 0; e < 8; ++e) v[e] = v[e] * rsb * g[j][e];
                st8f_nt(F.out + (size_t)m2 * DM + 8 * (F.lane + 64 * j), v); } }
    }
}

typedef __attribute__((address_space(1))) unsigned gu32;
#define XB_TMO      128
#define XB_XCNT(j)  (256  + 64 * (j))
#define XB_XSUB(j)  (1280 + 64 * (j))
#define XB_XGEN(j)  (2304 + 64 * (j))
#define XB_TOP      3328
#define XB_TOPGEN   3392
#define XCD_BAR_WORDS 3456
#define XB_SPIN_CAP (1u << 18)

__device__ __forceinline__ unsigned xb_ld(unsigned* p)              { return __hip_atomic_load(p, __ATOMIC_RELAXED, __HIP_MEMORY_SCOPE_AGENT); }
__device__ __forceinline__ unsigned xb_add(unsigned* p, unsigned v) { return __hip_atomic_fetch_add(p, v, __ATOMIC_RELAXED, __HIP_MEMORY_SCOPE_AGENT); }
__device__ __forceinline__ unsigned xb_xcc_id() { return (unsigned)__builtin_amdgcn_s_getreg((3 << 11) | 20) & 0xFu; }
#define XB_SPIN(cond, bar) do { unsigned _sp = 0; while (cond) { __builtin_amdgcn_s_sleep(1); \
    if ((++_sp & 255u) == 0u) { if (xb_ld(&(bar)[XB_TMO])) break; if (_sp > XB_SPIN_CAP) { atomicAdd(&(bar)[XB_TMO], 1u); break; } } } } while (0)

struct XcdBarrier {
    unsigned* bar; unsigned x;
    volatile LAS unsigned* st;
};

__device__ __forceinline__ XcdBarrier xcd_barrier_post(unsigned* bar, volatile LAS unsigned* st, int tid) {
    XcdBarrier b; b.bar = bar; b.x = xb_xcc_id(); b.st = st;
    if (tid == 0) (void)xb_add(&bar[XB_XCNT(b.x)], 1u);
    return b;
}
__device__ __forceinline__ void xcd_barrier_complete(unsigned* bar, unsigned x, unsigned& nloc, unsigned& nx) {
    const unsigned G = gridDim.x * gridDim.y * gridDim.z;
    unsigned sum, cnt, mine, sp = 0u;
    for (;;) {
        sum = 0u; cnt = 0u; mine = 0u;
#pragma unroll
        for (unsigned j = 0; j < 16; ++j) { const unsigned c = xb_ld(&bar[XB_XCNT(j)]); sum += c; cnt += (c > 0u) ? 1u : 0u; mine = (j == x) ? c : mine; }
        if (sum == G) break;
        __builtin_amdgcn_s_sleep(1);
        if ((++sp & 255u) == 0u) { if (xb_ld(&bar[XB_TMO])) break; if (sp > XB_SPIN_CAP) { atomicAdd(&bar[XB_TMO], 1u); break; } }
    }
    nloc = mine > 0u ? mine : 1u; nx = cnt > 0u ? cnt : 1u;
}

__device__ __forceinline__ void xcd_barrier(const XcdBarrier& b, int tid) {
    asm volatile("s_waitcnt vmcnt(0)" ::: "memory");
    __syncthreads();
    if (tid == 0) {
        unsigned* bar = b.bar;
        __builtin_amdgcn_s_waitcnt(0);
        unsigned nloc = b.st[0], nx = b.st[1];
        if (nloc == 0u) { xcd_barrier_complete(bar, b.x, nloc, nx); b.st[0] = nloc; b.st[1] = nx; }
        const unsigned old = xb_add(&bar[XB_XSUB(b.x)], 1u);
        const unsigned gen = old / nloc;
        if (old + 1u == (gen + 1u) * nloc) {
            __builtin_amdgcn_fence(__ATOMIC_RELEASE, "agent");
            asm volatile("s_waitcnt vmcnt(0)" ::: "memory");
            const unsigned og = xb_add(&bar[XB_TOP], 1u);
            const unsigned tg = og / nx;
            if (og + 1u == (tg + 1u) * nx) xb_add(&bar[XB_TOPGEN], 1u);
            else XB_SPIN(xb_ld(&bar[XB_TOPGEN]) == tg, bar);
            __builtin_amdgcn_fence(__ATOMIC_ACQUIRE, "agent");
            xb_add(&bar[XB_XGEN(b.x)], 1u);
            asm volatile("s_waitcnt vmcnt(0)" ::: "memory");
        } else {
            XB_SPIN(xb_ld(&bar[XB_XGEN(b.x)]) == gen, bar);
            __builtin_amdgcn_fence(__ATOMIC_ACQUIRE, "agent");
            asm volatile("s_waitcnt vmcnt(0)" ::: "memory");
        }
    }
    __syncthreads();
}

constexpr int N_PHASES = 16;
__global__ void __launch_bounds__(512, 2) mk_fwd(Args a) {
    extern __shared__ __attribute__((aligned(16))) unsigned char lds_raw[];
    cg::grid_group grid = cg::this_grid();
    const int wave0 = __builtin_amdgcn_readfirstlane(threadIdx.x >> 6);
    Frame F; F.lds = (LAS unsigned char*)lds_raw; F.tid = threadIdx.x; F.lane = F.tid & 63; F.wave = __builtin_amdgcn_readfirstlane(F.tid >> 6); F.G = gridDim.x; F.bid = blockIdx.x;
    F.out = a.out; F.ws = a.ws; F.dob = (unsigned char*)a.out;
    unsigned char* ws = a.ws; unsigned char* gt = ws + WS_GTAIL; float* nul = nullptr;
    volatile LAS unsigned* bst = (volatile LAS unsigned*)(F.lds + LDS_BYTES - 16);
    if (F.tid < 2) bst[F.tid] = 0u;
    __syncthreads();
    XcdBarrier bar; bar.bar = (unsigned*)ws; bar.x = 0; bar.st = bst;
    if (a.ph_hi - a.ph_lo > 1) bar = xcd_barrier_post((unsigned*)ws, bst, F.tid);
    bf16_t* PROJ = (bf16_t*)(ws + WS_PROJ);
    const int lo = a.ph_lo, hi = a.ph_hi;
    if (lo < 0) grid.sync();
#ifndef PHMASK
#define PHMASK 0xFFFF
#endif
#define IN(k) (((PHMASK >> (k)) & 1) && lo <= (k) && (k) < hi)
#define RG(A_, B_, N_, K_, f_, fb_) do { const bool sf_ = F.G == 256 && ((fb_) == 0 ? (F.bid & 1) != 0 : F.bid >= (fb_)); \
        _Pragma("unroll 1") for (int ps_ = 0; ps_ < 2; ++ps_) { \
            if ((ps_ == 0) == sf_) { sample_gemm_any(F, A_, B_, N_, K_, f_, fb_); REFRESH(); __syncthreads(); } \
            else { run_gemm(F, A_, B_, MP, N_, K_, f_); REFRESH(); __syncthreads(); } } } while (0)
#define REFRESH() do { int t_; asm volatile("v_mbcnt_lo_u32_b32 %0, -1, 0\n\tv_mbcnt_hi_u32_b32 %0, -1, %0\n\tv_lshl_add_u32 %0, %1, 6, %0" : "=&v"(t_) : "s"(wave0)); F.tid = t_; F.lane = t_ & 63; F.wave = __builtin_amdgcn_readfirstlane(t_ >> 6); } while (0)
#define SEAM(k) do { if (IN(k) && IN((k) + 1)) { REFRESH(); xcd_barrier(bar, F.tid); } { int t_; asm volatile("v_mbcnt_lo_u32_b32 %0, -1, 0\n\tv_mbcnt_hi_u32_b32 %0, -1, %0\n\tv_lshl_add_u32 %0, %1, 6, %0" : "=&v"(t_) : "s"(wave0)); F.tid = t_; F.lane = t_ & 63; F.wave = __builtin_amdgcn_readfirstlane(t_ >> 6); } } while (0)
    if (IN(0)) { ph0(F); } SEAM(0);
    if (IN(1)) { { const auto f_ = FStore{nul, PROJ, NAB}; RG((const bf16_t*)(ws + WS_RWKS), (const bf16_t*)(ws + WS_RWKS + 2 * SLOT), NAB, DM, f_, (F.G == 256 ? 128 : 0)); }
                 if (F.G != 256 || F.bid >= 128) { Frame F2 = F; if (F.G == 256) { F2.bid = F.bid - 128; F2.G = 128; } REFRESH(); __syncthreads(); conv_range(F2, 3, 5); } } SEAM(1);
    if (IN(2)) { ph2a(F); } SEAM(2);
    if (IN(5)) { ph_cprep_gdn(F); REFRESH(); ph_cprep_rwkv(F); REFRESH(); if (hi - lo > 1) xcd_barrier(bar, F.tid); REFRESH(); ph_cscan(F); } SEAM(5);
    if (IN(7)) { ph_post(F); } SEAM(7);
    if (IN(8)) { { const auto f_ = FGates{nul, (const bf16_t*)(ws + WS_ORAW), (const float*)(ws + C_RSO), KIn{}[13], (bf16_t*)(ws + WS_RWKS + 2 * SLOT), (bf16_t*)(ws + WS_RWKS), (bf16_t*)(ws + WS_RWKS + 4 * SLOT)}; RG((const bf16_t*)(F.dob + DO_H), (const bf16_t*)(F.dob + DO_WC), NC, DM, f_, 0); } } SEAM(8);
    if (IN(9)) { const bf16_t* OA_ = (const bf16_t*)(ws + WS_RWKS + 2 * SLOT); const bf16_t* OB_ = (const bf16_t*)(ws + WS_RWKS + 3 * SLOT); const bf16_t* GMA_ = (const bf16_t*)(ws + WS_RWKS); const bf16_t* GMB_ = (const bf16_t*)(ws + WS_RWKS + 4 * SLOT);
                 bf16_t* MG_ = (bf16_t*)(ws + WS_PROJ + 136314880);
                 const bool sf9_ = F.G == 256 && (F.bid & 1);
#pragma unroll 1
                 for (int ps_ = 0; ps_ < 2; ++ps_) {
                     if ((ps_ == 0) == sf9_) {
                         { const auto f_ = FUpA{nul, GMA_, (float*)(ws + WS_PROJ)}; sample_gemm(F, OA_, (const bf16_t*)(gt + GT_UPA), DM, 1024, f_, 0); REFRESH(); __syncthreads(); }
                         { const auto f_ = FUpB{nul, GMB_, (const float*)(ws + WS_PROJ), MG_}; sample_gemm(F, OB_, (const bf16_t*)(gt + GT_UPB), DM, 1024, f_, 0); REFRESH(); __syncthreads(); } }
                     else { run_gemm_up2(F, OA_, (const bf16_t*)(gt + GT_UPA), OB_, (const bf16_t*)(gt + GT_UPB), MP, DM, 1024, EpiUp2{GMA_, GMB_, MG_}); REFRESH(); __syncthreads(); } } } SEAM(9);
    if (IN(10)) { const bool cf_ = !(F.G == 256 && (F.bid & 1));
#pragma unroll 1
                 for (int pc_ = 0; pc_ < 2; ++pc_) {
                     if ((pc_ == 0) == cf_) { __syncthreads(); conv_range(F, 10, 12); __syncthreads(); REFRESH(); }
                     else { const auto f_ = FRes{(float*)(ws + C_SS1), KIn{}[0], KIn{}[1], (bf16_t*)(ws + WS_RWKS)}; RG((const bf16_t*)(ws + WS_PROJ + 136314880), (const bf16_t*)(gt + GT_WO), DM, DM, f_, 0); REFRESH(); __syncthreads(); } } } SEAM(10);
    if (IN(11)) { { const auto f_ = FFf1{nul, (const float*)(ws + C_SS1), PROJ}; RG((const bf16_t*)(ws + WS_RWKS), (const bf16_t*)(ws + WS_RWKS + 2 * SLOT), DFF, DM, f_, 0); } } SEAM(11);
    if (IN(12)) { const bool pf_ = F.G == 256 && (F.bid & 2);
#pragma unroll 1
                 for (int pq_ = 0; pq_ < 2; ++pq_) {
                     if ((pq_ == 0) == pf_) { const auto f_ = FStore{nul, (bf16_t*)(ws + WS_RWKS + 4 * SLOT), DM}; RG((const bf16_t*)(gt + GT_PB), (const bf16_t*)(gt + GT_PLE), DM, DPLE, f_, 0); REFRESH(); __syncthreads(); }
                     else { const auto f_ = FRes2{(float*)(ws + C_SS2), (bf16_t*)(ws + WS_RWKS)}; RG(PROJ, (const bf16_t*)(ws + WS_RWKS + 3 * SLOT), DM, DFF, f_, 0); REFRESH(); __syncthreads(); } } } SEAM(12);
    if (IN(14)) { { const auto f_ = FPg{(float*)(ws + C_SS3), (const float*)(ws + C_SS2), (const bf16_t*)(ws + WS_RWKS + 4 * SLOT), (bf16_t*)(ws + WS_RWKS + 2 * SLOT), (const bf16_t*)(ws + WS_RWKS)}; RG((const bf16_t*)(ws + WS_RWKS), (const bf16_t*)(gt + GT_PG), DM, DM, f_, 0); } } SEAM(14);
    if (IN(15)) { ph_final(F); }
#undef IN
#undef SEAM
}

#ifndef MK_MULTI
#define MK_MULTI 0
#endif
extern "C" void kernel_launch(void* const* d_in, const int* in_sizes, int n_in, void* d_out, int out_size, void* d_ws, size_t ws_size, hipStream_t stream) {
    static int grid = 0;
    if (grid == 0) {
        if (n_in != 35 || out_size != (int)O_END || ws_size < WS_NEED) { fprintf(stderr, "kernel_launch: unexpected problem: n_in %d out %d ws %zu (need %zu)\n", n_in, out_size, ws_size, (size_t)WS_NEED); grid = -1; return; }
        int dev = 0, cus = 0, per_cu = 0;
        hipGetDevice(&dev); hipDeviceGetAttribute(&cus, hipDeviceAttributeMultiprocessorCount, dev);
        if (hipFuncSetAttribute((const void*)mk_fwd, hipFuncAttributeMaxDynamicSharedMemorySize, LDS_BYTES) != hipSuccess) { fprintf(stderr, "kernel_launch: hipFuncSetAttribute failed\n"); grid = -1; return; }
        if (hipOccupancyMaxActiveBlocksPerMultiprocessor(&per_cu, (const void*)mk_fwd, 512, LDS_BYTES) != hipSuccess || per_cu < 1) { fprintf(stderr, "kernel_launch: occupancy query says %d\n", per_cu); per_cu = 1; }
        (void)hipGetLastError();
        grid = cus * per_cu; if (grid > 256) grid = 256;
        fprintf(stderr, "kernel_launch: cus %d per_cu %d grid %d ws %zu\n", cus, per_cu, grid, ws_size);
    }
    if (grid < 0) return;
    (void)hipMemsetAsync(d_ws, 0, 65536, stream);
    Args a{};
    for (int i = 0; i < 35; ++i) a.in[i] = (const float*)d_in[i];
    a.out = (float*)d_out; a.ws = (unsigned char*)d_ws;
#if MK_MULTI
    for (int ph = 0; ph < N_PHASES; ++ph) { a.ph_lo = ph; a.ph_hi = ph + 1; hipLaunchKernelGGL(mk_fwd, dim3(grid), dim3(512), LDS_BYTES, stream, a); }
#else
    a.ph_lo = 0; a.ph_hi = N_PHASES; void* args[] = {&a};
    hipError_t e = hipLaunchCooperativeKernel((const void*)mk_fwd, dim3(grid), dim3(512), args, LDS_BYTES, stream);
    if (e != hipSuccess) fprintf(stderr, "kernel_launch: cooperative launch failed: %s (grid %d)\n", hipGetErrorString(e), grid);
#endif
}
```
